# Optimizing an MI355X kernel written in HIP

```python
import math
import jax, jax.numpy as jnp
from jax import lax
import numpy as np

D_MODEL = 1024
BATCH = 4
SEQ = 4096
DEPTH = 4

D_MIX = D_MODEL
A_WIDTH = D_MIX // 2
A_GROUPS = 4
A_CH = A_WIDTH // A_GROUPS
CHUNK = 128
SB_WIDTH = D_MIX - A_WIDTH
SB_HEADS = 8
SB_HEAD_DIM = SB_WIDTH // SB_HEADS
QBLK = 128
IN_WIDTH = 2 * A_WIDTH + 3 * SB_WIDTH
MEM_LEN = 256
X_HEADS = 4
X_HEAD_DIM = D_MODEL // X_HEADS
N_GROUPS = 4
EXPERTS_PER_GROUP = 8
N_EXPERTS = N_GROUPS * EXPERTS_PER_GROUP
TOP_K = 2
D_EXPERT = D_MODEL // 2
MOE_BLOCK = 128
EPS = 1e-6

kernel_name = "hybrid_gmlp_stickbreak_hiermoe_trunk"


def rmsnorm(x, g):
    xf = x.astype(jnp.float32)
    y = xf * lax.rsqrt(jnp.mean(xf * xf, axis=-1, keepdims=True) + EPS)
    return (y * g.astype(jnp.float32)).astype(x.dtype)


def chunk_gmlp(u, v, v_gain, w_s, b_s):
    B, S = u.shape[0], u.shape[1]
    n_chunks = S // CHUNK
    u = jax.nn.gelu(u)
    v = rmsnorm(jax.nn.gelu(v), v_gain)
    vc = v.reshape(B, n_chunks, CHUNK, A_GROUPS, A_CH)
    mask = jnp.tril(jnp.ones((CHUNK, CHUNK), dtype=w_s.dtype))
    ws = w_s * mask[None]
    mixed = jnp.einsum('gts,bcsgd->bctgd', ws, vc) + b_s.T[None, None, :, :, None]
    return u * mixed.reshape(B, S, A_GROUPS, A_CH)


def stick_breaking_attention(q, k, v):
    B, S, H, Dh = q.shape
    nb = S // QBLK
    scale = 1.0 / math.sqrt(Dh)
    qb = q.reshape(B, nb, QBLK, H, Dh).transpose(1, 0, 3, 2, 4)
    kh = k.transpose(0, 2, 1, 3)
    vh = v.transpose(0, 2, 1, 3)
    key_pos = jnp.arange(S)

    def block(args):
        i, qi = args
        z = jnp.einsum('bhqd,bhkd->bhqk', qi, kh).astype(jnp.float32) * scale
        q_pos = i * QBLK + jnp.arange(QBLK)
        strict = key_pos[None, :] < q_pos[:, None]
        log_1mb = jnp.where(strict, jax.nn.log_sigmoid(-z), 0.0)
        after = lax.cumsum(log_1mb, axis=3, reverse=True) - log_1mb
        a = jnp.where(strict, jnp.exp(jax.nn.log_sigmoid(z) + after), 0.0)
        return jnp.einsum('bhqk,bhkd->bhqd', a.astype(vh.dtype), vh)

    out = lax.map(block, (jnp.arange(nb), qb))
    return out.transpose(1, 0, 3, 2, 4).reshape(B, S, H * Dh)


def memory_cross_attention(h, m, w_q, w_k, w_v, w_o):
    B, S, _ = h.shape
    M = m.shape[1]
    q = (h @ w_q).reshape(B, S, X_HEADS, X_HEAD_DIM)
    k = (m @ w_k).reshape(B, M, X_HEADS, X_HEAD_DIM)
    v = (m @ w_v).reshape(B, M, X_HEADS, X_HEAD_DIM)
    s = jnp.einsum('bshd,bmhd->bhsm', q, k).astype(jnp.float32) / math.sqrt(X_HEAD_DIM)
    p = jax.nn.softmax(s, axis=-1).astype(v.dtype)
    o = jnp.einsum('bhsm,bmhd->bshd', p, v).reshape(B, S, X_HEADS * X_HEAD_DIM)
    return o @ w_o


def hierarchical_moe(h, w_group, b_group, w_router, b_router, w1, w3, w2):
    B, S, D = h.shape
    t = h.reshape(-1, D)
    T = t.shape[0]
    g_logits = (t @ w_group).astype(jnp.float32) + b_group.astype(jnp.float32)
    p_group = jax.nn.softmax(g_logits, axis=-1)
    g_sel = jnp.argmax(g_logits, axis=-1)
    g_gate = jnp.take_along_axis(p_group, g_sel[:, None], axis=1)[:, 0]
    e_logits = ((t @ w_router).astype(jnp.float32) + b_router.astype(jnp.float32)).reshape(T, N_GROUPS, EXPERTS_PER_GROUP)
    e_sel_logits = jnp.take_along_axis(e_logits, g_sel[:, None, None], axis=1)[:, 0]
    top_v, top_i = lax.top_k(e_sel_logits, TOP_K)
    gates = g_gate[:, None] * jax.nn.softmax(top_v, axis=-1)
    eid = g_sel[:, None] * EXPERTS_PER_GROUP + top_i

    flat_e = eid.reshape(-1)
    N = T * TOP_K
    order = jnp.argsort(flat_e, stable=True)
    sorted_e = flat_e[order]
    counts = jnp.bincount(flat_e, length=N_EXPERTS)
    padded = ((counts + MOE_BLOCK - 1) // MOE_BLOCK) * MOE_BLOCK
    start = jnp.cumsum(counts) - counts
    pend = jnp.cumsum(padded)
    pstart = pend - padded
    dest = pstart[sorted_e] + (jnp.arange(N) - start[sorted_e])
    P = N + N_EXPERTS * MOE_BLOCK
    n_blocks = P // MOE_BLOCK
    buf = jnp.zeros((P, D), t.dtype).at[dest].set(t[order // TOP_K])
    blk_e = jnp.minimum(jnp.searchsorted(pend, jnp.arange(n_blocks) * MOE_BLOCK, side='right'), N_EXPERTS - 1)

    def expert_block(args):
        xb, e = args
        return (jax.nn.silu(xb @ w1[e]) * (xb @ w3[e])) @ w2[e]

    ybuf = lax.map(expert_block, (buf.reshape(n_blocks, MOE_BLOCK, D), blk_e)).reshape(P, D)
    y_assign = jnp.zeros((N, D), ybuf.dtype).at[order].set(ybuf[dest])
    y = jnp.einsum('tkd,tk->td', y_assign.reshape(T, TOP_K, D), gates.astype(ybuf.dtype))
    return y.reshape(B, S, D)


def setup_inputs(seed: int = 0) -> dict:
    key = jax.random.key(seed)
    ks = jax.random.split(key, 32)
    f32 = jnp.float32
    n = lambda k, shape, s: jax.random.normal(k, shape, f32) * s
    gain = lambda k, shape: 1.0 + 0.05 * jax.random.normal(k, shape, f32)
    L, D = DEPTH, D_MODEL
    return {
        "x": jax.random.normal(ks[0], (BATCH, SEQ, D), f32),
        "mem": jax.random.normal(ks[1], (BATCH, MEM_LEN, D), f32),
        "norm_mix": gain(ks[2], (L, D)),
        "w_in": n(ks[3], (L, D, IN_WIDTH), D ** -0.5),
        "v_norm": gain(ks[4], (L, A_GROUPS, A_CH)),
        "w_spatial": n(ks[5], (L, A_GROUPS, CHUNK, CHUNK), CHUNK ** -0.5),
        "b_spatial": gain(ks[6], (L, A_GROUPS, CHUNK)),
        "out_norm_a": gain(ks[7], (L, A_WIDTH)),
        "out_norm_b": gain(ks[8], (L, SB_WIDTH)),
        "w_out": n(ks[9], (L, D_MIX, D), D_MIX ** -0.5),
        "norm_cross": gain(ks[10], (L, D)),
        "norm_mem": gain(ks[11], (L, D)),
        "w_xq": n(ks[12], (L, D, D), D ** -0.5),
        "w_xk": n(ks[13], (L, D, D), D ** -0.5),
        "w_xv": n(ks[14], (L, D, D), D ** -0.5),
        "w_xo": n(ks[15], (L, D, D), D ** -0.5),
        "norm_moe": gain(ks[16], (L, D)),
        "w_group": n(ks[17], (L, D, N_GROUPS), D ** -0.5),
        "b_group": n(ks[18], (L, N_GROUPS), 0.01),
        "w_router": n(ks[19], (L, D, N_EXPERTS), D ** -0.5),
        "b_router": n(ks[20], (L, N_EXPERTS), 0.01),
        "w1": n(ks[21], (L, N_EXPERTS, D, D_EXPERT), D ** -0.5),
        "w3": n(ks[22], (L, N_EXPERTS, D, D_EXPERT), D ** -0.5),
        "w2": n(ks[23], (L, N_EXPERTS, D_EXPERT, D), D_EXPERT ** -0.5),
        "norm_final": gain(ks[24], (D,)),
    }


def reference(x, mem, norm_mix, w_in, v_norm, w_spatial, b_spatial, out_norm_a, out_norm_b, w_out,
              norm_cross, norm_mem, w_xq, w_xk, w_xv, w_xo, norm_moe, w_group, b_group, w_router,
              b_router, w1, w3, w2, norm_final):
    B, S, D = x.shape
    c1 = A_WIDTH
    c2 = 2 * A_WIDTH
    c3 = c2 + SB_WIDTH
    c4 = c3 + SB_WIDTH
    for l in range(DEPTH):
        h = rmsnorm(x, norm_mix[l])
        z = h @ w_in[l]
        u_a = z[..., :c1].reshape(B, S, A_GROUPS, A_CH)
        v_a = z[..., c1:c2].reshape(B, S, A_GROUPS, A_CH)
        q_b = z[..., c2:c3].reshape(B, S, SB_HEADS, SB_HEAD_DIM)
        k_b = z[..., c3:c4].reshape(B, S, SB_HEADS, SB_HEAD_DIM)
        v_b = z[..., c4:].reshape(B, S, SB_HEADS, SB_HEAD_DIM)
        y_a = chunk_gmlp(u_a, v_a, v_norm[l], w_spatial[l], b_spatial[l]).reshape(B, S, A_WIDTH)
        y_b = stick_breaking_attention(q_b, k_b, v_b)
        y = jnp.concatenate([rmsnorm(y_a, out_norm_a[l]), rmsnorm(y_b, out_norm_b[l])], axis=-1)
        x = x + y @ w_out[l]
        h = rmsnorm(x, norm_cross[l])
        m = rmsnorm(mem, norm_mem[l])
        x = x + memory_cross_attention(h, m, w_xq[l], w_xk[l], w_xv[l], w_xo[l])
        h = rmsnorm(x, norm_moe[l])
        x = x + hierarchical_moe(h, w_group[l], b_group[l], w_router[l], b_router[l], w1[l], w3[l], w2[l])
    return rmsnorm(x, norm_final)
```

```cpp
#include <hip/hip_runtime.h>
#include <stdint.h>
#include <stdio.h>

typedef unsigned short bf16_t;
typedef short bf16x8 __attribute__((ext_vector_type(8)));
typedef float f32x4 __attribute__((ext_vector_type(4)));
typedef float f32x16 __attribute__((ext_vector_type(16)));
typedef unsigned u32x2 __attribute__((ext_vector_type(2)));
typedef unsigned u32x4 __attribute__((ext_vector_type(4)));

constexpr int NB = 4, SEQ = 4096, T = NB * SEQ, DM = 1024, NL = 4;
constexpr int AW = 512, AG = 4, ACH = 128, CHUNK = 128;
constexpr int SBW = 512, SBH = 8, SBD = 64;
constexpr int INW = 2560;
constexpr int MEML = 256, MT = NB * MEML, XH = 4, XD = 256;
constexpr int NG = 4, EPG = 8, NE = 32, DE = 512;
constexpr float EPS = 1e-6f;
constexpr float LOG2E = 1.4426950408889634f;
constexpr float QSCALE = 0.125f * LOG2E;
constexpr float XSCALE = 0.0625f * LOG2E;
constexpr float RSTOP = 104.0f * LOG2E;

constexpr size_t MiB = 1u << 20;
constexpr size_t OFF_CTL = 0;
constexpr size_t OFF_WIN = 1 * MiB;
constexpr size_t SZ_WIN = (size_t)INW * DM * 2;
constexpr size_t OFF_WOUT = OFF_WIN + NL * SZ_WIN;
constexpr size_t SZ_SQ = (size_t)DM * DM * 2;
constexpr size_t OFF_WXQ = OFF_WOUT + NL * SZ_SQ;
constexpr size_t OFF_WXK = OFF_WXQ + NL * SZ_SQ;
constexpr size_t OFF_WXV = OFF_WXK + NL * SZ_SQ;
constexpr size_t OFF_WXO = OFF_WXV + NL * SZ_SQ;
constexpr size_t OFF_WR = OFF_WXO + NL * SZ_SQ;
constexpr size_t SZ_WR = (size_t)64 * DM * 2;
constexpr size_t OFF_WS = OFF_WR + NL * SZ_WR;
constexpr size_t SZ_WS = (size_t)AG * CHUNK * CHUNK * 2;
constexpr size_t OFF_W13 = OFF_WS + NL * SZ_WS;
constexpr size_t SZ_W13 = (size_t)1024 * DM * 2;
constexpr size_t OFF_W2 = OFF_W13 + (size_t)NL * NE * SZ_W13;
constexpr size_t SZ_W2 = (size_t)DM * DE * 2;
constexpr size_t OFF_XF = OFF_W2 + (size_t)NL * NE * SZ_W2;
constexpr size_t OFF_XB = OFF_XF + (size_t)T * DM * 4;
constexpr size_t OFF_SSX = OFF_XB + (size_t)T * DM * 2;
constexpr size_t OFF_U = OFF_SSX + (size_t)T * 4 * 4;
constexpr size_t SZ_H = (size_t)T * 512 * 2;
constexpr size_t OFF_Q = OFF_U + SZ_H;
constexpr size_t OFF_K = OFF_Q + SZ_H;
constexpr size_t OFF_VGT = OFF_K + SZ_H;
constexpr size_t OFF_VBT = OFF_VGT + SZ_H;
constexpr size_t OFF_Y = OFF_VBT + SZ_H;
constexpr size_t OFF_SSA = OFF_Y + (size_t)T * DM * 2;
constexpr size_t OFF_SSB = OFF_SSA + (size_t)T * 4 * 4;
constexpr size_t OFF_QX = OFF_SSB + (size_t)T * 8 * 4;
constexpr size_t OFF_OX = OFF_QX + (size_t)T * DM * 2;
constexpr size_t OFF_MB = OFF_OX + (size_t)T * DM * 2;
constexpr size_t OFF_SSM = OFF_MB + (size_t)MT * DM * 2;
constexpr size_t OFF_KX = OFF_SSM + (size_t)MT * 4;
constexpr size_t OFF_VXT = OFF_KX + (size_t)NL * MT * DM * 2;
constexpr size_t OFF_GATE = OFF_VXT + (size_t)NL * MT * DM * 2;
constexpr size_t OFF_PERM = OFF_GATE + (size_t)T * 2 * 4;
constexpr int ACT_ROWS = 2 * T + 64 * 256;
constexpr size_t OFF_ACT = OFF_PERM + (size_t)64 * T * 4;
constexpr size_t WS_NEED = OFF_ACT + (size_t)ACT_ROWS * DE * 2;
constexpr int CW_CNT = 1024;

__device__ __forceinline__ float bf2f(bf16_t h) { return __uint_as_float((unsigned)h << 16); }
__device__ __forceinline__ bf16_t f2bf(float f) { unsigned u = __float_as_uint(f); u += 0x7fffu + ((u >> 16) & 1u); return (bf16_t)(u >> 16); }
__device__ __forceinline__ unsigned pk2(float lo, float hi) { return (unsigned)f2bf(lo) | ((unsigned)f2bf(hi) << 16); }
__device__ __forceinline__ float gelu_tanh(float x) { const float t = 0.7978845608028654f * (x + 0.044715f * x * x * x); return x / (1.0f + __expf(-2.0f * t)); }
__device__ __forceinline__ float silu(float x) { return x / (1.0f + __expf(-x)); }
__device__ __forceinline__ float softplus2(float u) { return fmaxf(u, 0.f) + __log2f(1.0f + exp2f(-fabsf(u))); }
__device__ __forceinline__ float wave_sum(float v) {
#pragma unroll
    for (int o = 1; o < 64; o <<= 1) v += __shfl_xor(v, o);
    return v;
}
__device__ __forceinline__ float wave_max(float v) {
#pragma unroll
    for (int o = 1; o < 64; o <<= 1) v = fmaxf(v, __shfl_xor(v, o));
    return v;
}
__device__ __forceinline__ float rs4(const float* ss, int row) { const f32x4 v = *(const f32x4*)(ss + (size_t)row * 4); return rsqrtf(((v[0] + v[1]) + (v[2] + v[3])) * (1.0f / 1024.0f) + EPS); }

__global__ __launch_bounds__(256) void k_transpose(const float* __restrict__ src, bf16_t* __restrict__ dst, const float* __restrict__ gain, const float* __restrict__ gain2, int ksplit,
                                                   float scale, int K, int N, int src_ld, long ssi, long sso, long dsi, long dso, int gso, int G, int GS, int GO) {
    __shared__ float tile[64][65];
    const int ntn = N / 64, kt = blockIdx.x / ntn, nt = blockIdx.x % ntn;
    const float* s = src + (size_t)blockIdx.y * ssi + (size_t)blockIdx.z * sso;
    bf16_t* d = dst + (size_t)blockIdx.y * dsi + (size_t)blockIdx.z * dso;
    const int tx = threadIdx.x & 63, ty = threadIdx.x >> 6;
#pragma unroll 4
    for (int i = 0; i < 16; ++i) { const int k = ty + 4 * i; tile[k][tx] = s[(size_t)(kt * 64 + k) * src_ld + nt * 64 + tx]; }
    __syncthreads();
    const int kx = threadIdx.x & 31, ny = threadIdx.x >> 5, k0 = kt * 64 + 2 * kx;
    float ga = scale, gb = scale;
    if (gain) { const float* g1 = gain + (size_t)blockIdx.z * gso; const float* g2 = gain2 ? gain2 + (size_t)blockIdx.z * gso : g1;
        ga *= (k0 < ksplit) ? g1[k0] : g2[k0 - ksplit]; gb *= (k0 + 1 < ksplit) ? g1[k0 + 1] : g2[k0 + 1 - ksplit]; }
#pragma unroll
    for (int i = 0; i < 8; ++i) { const int n = ny + 8 * i, ng = nt * 64 + n, drow = (ng / G) * GS + GO + (ng % G);
        *(unsigned*)(d + (size_t)drow * K + k0) = pk2(tile[2 * kx][n] * ga, tile[2 * kx + 1][n] * gb); }
}
__global__ void k_prep_router(const float* __restrict__ w_router, const float* __restrict__ w_group, const float* __restrict__ norm_moe, bf16_t* __restrict__ WR) {
    const int idx = blockIdx.x * 256 + threadIdx.x; if (idx >= NL * 64 * DM) return;
    const int k = idx % DM, n = (idx / DM) % 64, l = idx / (64 * DM);
    float v = 0.f;
    if (n < 32) v = w_router[((size_t)l * DM + k) * NE + n]; else if (n < 36) v = w_group[((size_t)l * DM + k) * NG + (n - 32)];
    WR[idx] = f2bf(v * norm_moe[l * DM + k]);
}
__global__ void k_prep_spatial(const float* __restrict__ w_sp, bf16_t* __restrict__ WS) {
    const int idx = blockIdx.x * 256 + threadIdx.x; if (idx >= NL * AG * CHUNK * CHUNK) return;
    const int s = idx % CHUNK, t = (idx / CHUNK) % CHUNK;
    WS[idx] = (s <= t) ? f2bf(w_sp[idx]) : (bf16_t)0;
}
__global__ __launch_bounds__(256) void k_prep_rows(const float* __restrict__ x, bf16_t* __restrict__ xb, float* __restrict__ ss4, float* __restrict__ ss1, int R) {
    const int row = blockIdx.x * 4 + (threadIdx.x >> 6), lane = threadIdx.x & 63; if (row >= R) return;
    float tot = 0.f;
#pragma unroll
    for (int j = 0; j < 4; ++j) {
        const f32x4 v = *(const f32x4*)(x + (size_t)row * DM + j * 256 + lane * 4);
        u32x2 w; w.x = pk2(v[0], v[1]); w.y = pk2(v[2], v[3]);
        *(u32x2*)(xb + (size_t)row * DM + j * 256 + lane * 4) = w;
        const float s = wave_sum((v[0] * v[0] + v[1] * v[1]) + (v[2] * v[2] + v[3] * v[3]));
        if (ss4 && lane == 0) ss4[(size_t)row * 4 + j] = s;
        tot += s;
    }
    if (ss1 && lane == 0) ss1[row] = tot;
}

#define MFMA32(a, b, c) __builtin_amdgcn_mfma_f32_32x32x16_bf16((a), (b), (c), 0, 0, 0)
struct SUnit { int p0, q0, aux0, aux1, aux2; };
template <class Prob> __global__ __launch_bounds__(256) void k_sgemm(Prob pr) {
    __shared__ float red[4][64];
    const int tid = threadIdx.x, wave = tid >> 6, lane = tid & 63, c = lane & 31, h = lane >> 5;
    SUnit u;
    if (!pr.unit((int)blockIdx.x, (int)blockIdx.y, u)) return;
    int pb[2], qb[2];
#pragma unroll
    for (int i = 0; i < 2; ++i) { pb[i] = u.p0 + (Prob::PAIRED ? 32 * wave + 128 * i : 64 * wave + 32 * i); qb[i] = u.q0 + 32 * i; }
    const bf16_t* pa[2]; const bf16_t* qa[2];
#pragma unroll
    for (int i = 0; i < 2; ++i) { pa[i] = pr.prow(u, pb[i] + c) + 8 * h; qa[i] = pr.qrow(u, qb[i] + c) + 8 * h; }
    f32x16 acc[2][2];
#pragma unroll
    for (int i = 0; i < 2; ++i)
#pragma unroll
        for (int j = 0; j < 2; ++j)
#pragma unroll
            for (int r = 0; r < 16; ++r) acc[i][j][r] = 0.f;
    constexpr int K = Prob::K;
#pragma unroll 1
    for (int kh = 0; kh < 2; ++kh) {
        if (Prob::MIDK && kh == 1) {
            const float r0 = pr.midscale(u, qb[0] + c), r1 = pr.midscale(u, qb[1] + c);
#pragma unroll
            for (int i = 0; i < 2; ++i)
#pragma unroll
                for (int r = 0; r < 16; ++r) { acc[i][0][r] *= r0; acc[i][1][r] *= r1; }
        }
#pragma unroll 4
        for (int k = kh * (K / 2); k < (kh + 1) * (K / 2); k += 16) {
            const bf16x8 a0 = *(const bf16x8*)(pa[0] + k), a1 = *(const bf16x8*)(pa[1] + k), b0 = *(const bf16x8*)(qa[0] + k), b1 = *(const bf16x8*)(qa[1] + k);
            acc[0][0] = MFMA32(a0, b0, acc[0][0]); acc[0][1] = MFMA32(a0, b1, acc[0][1]); acc[1][0] = MFMA32(a1, b0, acc[1][0]); acc[1][1] = MFMA32(a1, b1, acc[1][1]);
        }
    }
    float ss[2] = {0.f, 0.f};
#pragma unroll
    for (int j = 0; j < 2; ++j)
#pragma unroll
        for (int g = 0; g < 4; ++g) {
            if (Prob::PAIRED) {
                const f32x4 va = {acc[0][j][4 * g], acc[0][j][4 * g + 1], acc[0][j][4 * g + 2], acc[0][j][4 * g + 3]};
                const f32x4 vb = {acc[1][j][4 * g], acc[1][j][4 * g + 1], acc[1][j][4 * g + 2], acc[1][j][4 * g + 3]};
                pr.epi2(u, pb[0] + 8 * g + 4 * h, qb[j] + c, va, vb);
            } else {
#pragma unroll
                for (int i = 0; i < 2; ++i) {
                    const f32x4 v = {acc[i][j][4 * g], acc[i][j][4 * g + 1], acc[i][j][4 * g + 2], acc[i][j][4 * g + 3]};
                    ss[j] += pr.epi(u, pb[i] + 8 * g + 4 * h, qb[j] + c, v);
                }
            }
        }
    if (Prob::ROWSS) {
#pragma unroll
        for (int j = 0; j < 2; ++j) { ss[j] += __shfl_xor(ss[j], 32); if (h == 0) red[wave][j * 32 + c] = ss[j]; }
        __syncthreads();
        if (tid < 64) pr.rowss(u, u.q0 + tid, (red[0][tid] + red[1][tid]) + (red[2][tid] + red[3][tid]));
    }
}

struct Ptrs {
    unsigned char* ws; const float* x_in; float* out; int l;
    __device__ __forceinline__ bf16_t* b(size_t off) const { return (bf16_t*)(ws + off); }
    __device__ __forceinline__ float* f(size_t off) const { return (float*)(ws + off); }
    __device__ __forceinline__ int* i(size_t off) const { return (int*)(ws + off); }
};
__device__ __forceinline__ void st4bf(bf16_t* p, f32x4 v) { u32x2 w; w.x = pk2(v[0], v[1]); w.y = pk2(v[2], v[3]); *(u32x2*)p = w; }

struct ProbIn { static constexpr int K = DM; static constexpr bool PAIRED = false, MIDK = false, ROWSS = false; Ptrs P;
    __device__ bool unit(int bx, int, SUnit& u) const { u.p0 = (bx % 6) * 256; u.q0 = (bx / 6) * 64; return true; }
    __device__ const bf16_t* prow(const SUnit&, int p) const { return P.b(OFF_WIN + P.l * SZ_WIN) + (size_t)p * DM; }
    __device__ const bf16_t* qrow(const SUnit&, int q) const { return P.b(OFF_XB) + (size_t)q * DM; }
    __device__ float midscale(const SUnit&, int) const { return 1.f; }
    __device__ float epi(const SUnit&, int p, int q, f32x4 v) const {
        const float rs = rs4(P.f(OFF_SSX), q); v = v * rs;
        if (p < 512) { for (int i = 0; i < 4; ++i) v[i] = gelu_tanh(v[i]); st4bf(P.b(OFF_U) + (size_t)q * 512 + p, v); }
        else if (p < 1024) st4bf(P.b(OFF_Q) + (size_t)q * 512 + (p - 512), v);
        else st4bf(P.b(OFF_K) + (size_t)q * 512 + (p - 1024), v);
        return 0.f; }
    __device__ void epi2(const SUnit&, int, int, f32x4, f32x4) const {}
    __device__ void rowss(const SUnit&, int, float) const {}
};
struct ProbInT { static constexpr int K = DM; static constexpr bool PAIRED = false, MIDK = false, ROWSS = false; Ptrs P;
    __device__ bool unit(int bx, int, SUnit& u) const { u.p0 = (bx % 64) * 256; u.q0 = (bx / 64) * 64; return true; }
    __device__ const bf16_t* prow(const SUnit&, int p) const { return P.b(OFF_XB) + (size_t)p * DM; }
    __device__ const bf16_t* qrow(const SUnit&, int q) const { return P.b(OFF_WIN + P.l * SZ_WIN) + (size_t)(1536 + q) * DM; }
    __device__ float midscale(const SUnit&, int) const { return 1.f; }
    __device__ float epi(const SUnit&, int p, int q, f32x4 v) const {
        for (int i = 0; i < 4; ++i) v[i] *= rs4(P.f(OFF_SSX), p + i);
        if (q < 512) { for (int i = 0; i < 4; ++i) v[i] = gelu_tanh(v[i]); st4bf(P.b(OFF_VGT) + (size_t)q * T + p, v); }
        else st4bf(P.b(OFF_VBT) + (size_t)(q - 512) * T + p, v);
        return 0.f; }
    __device__ void epi2(const SUnit&, int, int, f32x4, f32x4) const {}
    __device__ void rowss(const SUnit&, int, float) const {}
};
struct ProbMemK { static constexpr int K = DM; static constexpr bool PAIRED = false, MIDK = false, ROWSS = false; Ptrs P;
    __device__ bool unit(int bx, int by, SUnit& u) const { u.p0 = (bx % 4) * 256; u.q0 = (bx / 4) * 64; u.aux0 = by; return true; }
    __device__ const bf16_t* prow(const SUnit& u, int p) const { return P.b(OFF_WXK + u.aux0 * SZ_SQ) + (size_t)p * DM; }
    __device__ const bf16_t* qrow(const SUnit&, int q) const { return P.b(OFF_MB) + (size_t)q * DM; }
    __device__ float midscale(const SUnit&, int) const { return 1.f; }
    __device__ float epi(const SUnit& u, int p, int q, f32x4 v) const {
        const float rs = rsqrtf(P.f(OFF_SSM)[q] * (1.0f / 1024.0f) + EPS); v = v * rs;
        st4bf(P.b(OFF_KX) + ((size_t)u.aux0 * MT + q) * DM + p, v); return 0.f; }
    __device__ void epi2(const SUnit&, int, int, f32x4, f32x4) const {}
    __device__ void rowss(const SUnit&, int, float) const {}
};
struct ProbMemVT { static constexpr int K = DM; static constexpr bool PAIRED = false, MIDK = false, ROWSS = false; Ptrs P;
    __device__ bool unit(int bx, int by, SUnit& u) const { u.p0 = (bx % 4) * 256; u.q0 = (bx / 4) * 64; u.aux0 = by; return true; }
    __device__ const bf16_t* prow(const SUnit&, int p) const { return P.b(OFF_MB) + (size_t)p * DM; }
    __device__ const bf16_t* qrow(const SUnit& u, int q) const { return P.b(OFF_WXV + u.aux0 * SZ_SQ) + (size_t)q * DM; }
    __device__ float midscale(const SUnit&, int) const { return 1.f; }
    __device__ float epi(const SUnit& u, int p, int q, f32x4 v) const {
        for (int i = 0; i < 4; ++i) v[i] *= rsqrtf(P.f(OFF_SSM)[p + i] * (1.0f / 1024.0f) + EPS);
        st4bf(P.b(OFF_VXT) + ((size_t)u.aux0 * DM + q) * MT + p, v); return 0.f; }
    __device__ void epi2(const SUnit&, int, int, f32x4, f32x4) const {}
    __device__ void rowss(const SUnit&, int, float) const {}
};
__device__ __forceinline__ float resid_store(const Ptrs& P, const float* res, int tok, int col, f32x4 add) {
    const f32x4 r = *(const f32x4*)(res + (size_t)tok * DM + col);
    const f32x4 xn = r + add;
    *(f32x4*)(P.f(OFF_XF) + (size_t)tok * DM + col) = xn;
    st4bf(P.b(OFF_XB) + (size_t)tok * DM + col, xn);
    return (xn[0] * xn[0] + xn[1] * xn[1]) + (xn[2] * xn[2] + xn[3] * xn[3]);
}
struct ProbOut { static constexpr int K = DM; static constexpr bool PAIRED = false, MIDK = true, ROWSS = true; Ptrs P;
    __device__ float rsa(int q) const { const f32x4 v = *(const f32x4*)(P.f(OFF_SSA) + (size_t)q * 4); return rsqrtf(((v[0] + v[1]) + (v[2] + v[3])) * (1.0f / 512.0f) + EPS); }
    __device__ float rsb(int q) const { const f32x4 v = *(const f32x4*)(P.f(OFF_SSB) + (size_t)q * 8), w = *(const f32x4*)(P.f(OFF_SSB) + (size_t)q * 8 + 4);
        return rsqrtf((((v[0] + v[1]) + (v[2] + v[3])) + ((w[0] + w[1]) + (w[2] + w[3]))) * (1.0f / 512.0f) + EPS); }
    __device__ bool unit(int bx, int, SUnit& u) const { u.p0 = (bx % 4) * 256; u.q0 = (bx / 4) * 64; return true; }
    __device__ const bf16_t* prow(const SUnit&, int p) const { return P.b(OFF_WOUT + P.l * SZ_SQ) + (size_t)p * DM; }
    __device__ const bf16_t* qrow(const SUnit&, int q) const { return P.b(OFF_Y) + (size_t)q * DM; }
    __device__ float midscale(const SUnit&, int q) const { return rsa(q) / rsb(q); }
    __device__ float epi(const SUnit&, int p, int q, f32x4 v) const { const float* res = (P.l == 0) ? P.x_in : P.f(OFF_XF); return resid_store(P, res, q, p, v * rsb(q)); }
    __device__ void epi2(const SUnit&, int, int, f32x4, f32x4) const {}
    __device__ void rowss(const SUnit& u, int q, float s) const { P.f(OFF_SSX)[(size_t)q * 4 + u.p0 / 256] = s; }
};
struct ProbXq { static constexpr int K = DM; static constexpr bool PAIRED = false, MIDK = false, ROWSS = false; Ptrs P;
    __device__ bool unit(int bx, int, SUnit& u) const { u.p0 = (bx % 4) * 256; u.q0 = (bx / 4) * 64; return true; }
    __device__ const bf16_t* prow(const SUnit&, int p) const { return P.b(OFF_WXQ + P.l * SZ_SQ) + (size_t)p * DM; }
    __device__ const bf16_t* qrow(const SUnit&, int q) const { return P.b(OFF_XB) + (size_t)q * DM; }
    __device__ float midscale(const SUnit&, int) const { return 1.f; }
    __device__ float epi(const SUnit&, int p, int q, f32x4 v) const { st4bf(P.b(OFF_QX) + (size_t)q * DM + p, v * rs4(P.f(OFF_SSX), q)); return 0.f; }
    __device__ void epi2(const SUnit&, int, int, f32x4, f32x4) const {}
    __device__ void rowss(const SUnit&, int, float) const {}
};
struct ProbXo { static constexpr int K = DM; static constexpr bool PAIRED = false, MIDK = false, ROWSS = true; Ptrs P;
    __device__ bool unit(int bx, int, SUnit& u) const { u.p0 = (bx % 4) * 256; u.q0 = (bx / 4) * 64; return true; }
    __device__ const bf16_t* prow(const SUnit&, int p) const { return P.b(OFF_WXO + P.l * SZ_SQ) + (size_t)p * DM; }
    __device__ const bf16_t* qrow(const SUnit&, int q) const { return P.b(OFF_OX) + (size_t)q * DM; }
    __device__ float midscale(const SUnit&, int) const { return 1.f; }
    __device__ float epi(const SUnit&, int p, int q, f32x4 v) const { return resid_store(P, P.f(OFF_XF), q, p, v); }
    __device__ void epi2(const SUnit&, int, int, f32x4, f32x4) const {}
    __device__ void rowss(const SUnit& u, int q, float s) const { P.f(OFF_SSX)[(size_t)q * 4 + u.p0 / 256] = s; }
};
template <int TQ> __device__ __forceinline__ bool moe_decode(const int* cnt, int sg_lo, int sg_hi, int qt_flat, int& sg, int& qt, int& n, int& rowbase) {
    int rb = 0, base = 0; bool found = false;
    for (int s = 0; s < 64; ++s) {
        const int c = cnt[s];
        if (s >= sg_lo && s < sg_hi && !found) { const int nt = (c + TQ - 1) / TQ; if (qt_flat < base + nt) { sg = s; qt = qt_flat - base; n = c; rowbase = rb; found = true; } base += nt; }
        rb += (c + 255) & ~255;
    }
    return found;
}
struct ProbMoe1 { static constexpr int K = DM; static constexpr bool PAIRED = true, MIDK = false, ROWSS = false; Ptrs P;
    __device__ bool unit(int bx, int, SUnit& u) const { int sg, qt, n, rb; if (!moe_decode<64>(P.i(OFF_CTL) + CW_CNT + P.l * 64, 0, 64, bx / 4, sg, qt, n, rb)) return false;
        u.p0 = (bx % 4) * 256; u.q0 = qt * 64; u.aux0 = sg; u.aux1 = n; u.aux2 = rb; return true; }
    __device__ const bf16_t* prow(const SUnit& u, int p) const { return P.b(OFF_W13 + ((size_t)P.l * NE + (u.aux0 & 31)) * SZ_W13) + (size_t)p * DM; }
    __device__ int tok(const SUnit& u, int q) const { return P.i(OFF_PERM)[(size_t)u.aux0 * T + (q < u.aux1 ? q : u.aux1 - 1)]; }
    __device__ const bf16_t* qrow(const SUnit& u, int q) const { return P.b(OFF_XB) + (size_t)tok(u, q) * DM; }
    __device__ float midscale(const SUnit&, int) const { return 1.f; }
    __device__ float epi(const SUnit&, int, int, f32x4) const { return 0.f; }
    __device__ void epi2(const SUnit& u, int p, int q, f32x4 a, f32x4 b) const {
        const float rs = rs4(P.f(OFF_SSX), tok(u, q)); f32x4 r;
        for (int i = 0; i < 4; ++i) r[i] = silu(a[i] * rs) * (b[i] * rs);
        st4bf(P.b(OFF_ACT) + (size_t)(u.aux2 + q) * DE + (p >> 8) * 128 + (p & 127), r); }
    __device__ void rowss(const SUnit&, int, float) const {}
};
template <int SLOT> struct ProbMoe2 { static constexpr int K = DE; static constexpr bool PAIRED = false, MIDK = false, ROWSS = (SLOT == 1); Ptrs P;
    __device__ bool unit(int bx, int, SUnit& u) const { int sg, qt, n, rb; if (!moe_decode<64>(P.i(OFF_CTL) + CW_CNT + P.l * 64, SLOT * 32, SLOT * 32 + 32, bx / 4, sg, qt, n, rb)) return false;
        u.p0 = (bx % 4) * 256; u.q0 = qt * 64; u.aux0 = sg; u.aux1 = n; u.aux2 = rb; return true; }
    __device__ const bf16_t* prow(const SUnit& u, int p) const { return P.b(OFF_W2 + ((size_t)P.l * NE + (u.aux0 & 31)) * SZ_W2) + (size_t)p * DE; }
    __device__ const bf16_t* qrow(const SUnit& u, int q) const { return P.b(OFF_ACT) + (size_t)(u.aux2 + q) * DE; }
    __device__ float midscale(const SUnit&, int) const { return 1.f; }
    __device__ float epi(const SUnit& u, int p, int q, f32x4 v) const {
        if (q >= u.aux1) return 0.f;
        const int tok = P.i(OFF_PERM)[(size_t)u.aux0 * T + q]; const float g = P.f(OFF_GATE)[(size_t)tok * 2 + SLOT]; v = v * g;
        if (SLOT == 0) { float* xp = P.f(OFF_XF) + (size_t)tok * DM + p; *(f32x4*)xp = *(const f32x4*)xp + v; return 0.f; }
        return resid_store(P, P.f(OFF_XF), tok, p, v); }
    __device__ void epi2(const SUnit&, int, int, f32x4, f32x4) const {}
    __device__ void rowss(const SUnit& u, int q, float s) const { if (q < u.aux1) { const int tok = P.i(OFF_PERM)[(size_t)u.aux0 * T + q]; P.f(OFF_SSX)[(size_t)tok * 4 + u.p0 / 256] = s; } }
};

__global__ __launch_bounds__(256) void k_attn_naive(Ptrs P) {
    const int idx = blockIdx.x * 256 + threadIdx.x, h = idx & 7, tok = idx >> 3, b = tok / SEQ, t = tok % SEQ;
    const bf16_t* Qp = P.b(OFF_Q) + (size_t)tok * 512 + h * 64;
    float q[64], o[64];
#pragma unroll
    for (int d = 0; d < 64; ++d) { q[d] = bf2f(Qp[d]); o[d] = 0.f; }
    float R = 0.f;
    for (int s = t - 1; s >= 0; --s) {
        const bf16_t* kr = P.b(OFF_K) + (size_t)(b * SEQ + s) * 512 + h * 64;
        float u = 0.f;
#pragma unroll
        for (int d = 0; d < 64; ++d) u += q[d] * bf2f(kr[d]);
        const float sp = softplus2(u), a = exp2f(u - sp - R);
        const bf16_t* vc = P.b(OFF_VBT) + (size_t)(h * 64) * T + b * SEQ + s;
#pragma unroll
        for (int d = 0; d < 64; ++d) o[d] += a * bf2f(vc[(size_t)d * T]);
        R += sp; if (R > RSTOP) break;
    }
    float ss = 0.f;
#pragma unroll
    for (int d = 0; d < 64; ++d) { const bf16_t ob = f2bf(o[d]); P.b(OFF_Y)[(size_t)tok * DM + 512 + h * 64 + d] = ob; const float of = bf2f(ob); ss += of * of; }
    P.f(OFF_SSB)[(size_t)tok * 8 + h] = ss;
}
__global__ __launch_bounds__(256) void k_gmlp_naive(Ptrs P, const float* __restrict__ v_norm, const float* __restrict__ b_sp) {
    __shared__ bf16_t vgs[128][130];
    __shared__ float rs[128];
    __shared__ float part[128][2];
    const int g = blockIdx.x & 3, bc = blockIdx.x >> 2, tok0 = bc * 128, tid = threadIdx.x, l = P.l;
    for (int idx = tid; idx < 128 * 128; idx += 256) { const int c = idx >> 7, s = idx & 127; vgs[s][c] = P.b(OFF_VGT)[(size_t)(g * 128 + c) * T + tok0 + s]; }
    __syncthreads();
    if (tid < 128) { float s2 = 0.f; for (int c = 0; c < 128; ++c) { const float v = bf2f(vgs[tid][c]); s2 += v * v; } rs[tid] = rsqrtf(s2 * (1.0f / 128.0f) + EPS); }
    __syncthreads();
    const int c = tid & 127, th = tid >> 7;
    const float gain = v_norm[(size_t)l * AW + g * 128 + c];
    const bf16_t* W = P.b(OFF_WS + l * SZ_WS) + (size_t)g * CHUNK * CHUNK;
    for (int t = th * 64; t < th * 64 + 64; ++t) {
        float acc = 0.f;
        for (int s = 0; s <= t; ++s) acc += bf2f(W[t * 128 + s]) * rs[s] * bf2f(vgs[s][c]);
        const float mixed = gain * acc + b_sp[(size_t)l * AG * CHUNK + g * CHUNK + t];
        const float y = bf2f(P.b(OFF_U)[(size_t)(tok0 + t) * 512 + g * 128 + c]) * mixed;
        const bf16_t yb = f2bf(y); P.b(OFF_Y)[(size_t)(tok0 + t) * DM + g * 128 + c] = yb;
        const float yf = bf2f(yb); const float sq = wave_sum(yf * yf);
        if ((tid & 63) == 0) part[t][(tid >> 6) & 1] = sq;
    }
    __syncthreads();
    if (tid < 128) P.f(OFF_SSA)[(size_t)(tok0 + tid) * 4 + g] = part[tid][0] + part[tid][1];
}
__global__ __launch_bounds__(256) void k_xattn_naive(Ptrs P) {
    __shared__ float qs[16][256];
    __shared__ float pp[16][256];
    const int h = blockIdx.x & 3, tok0 = (blockIdx.x >> 2) * 16, b = tok0 / SEQ, tid = threadIdx.x, l = P.l;
    for (int i = 0; i < 16; ++i) qs[i][tid] = bf2f(P.b(OFF_QX)[(size_t)(tok0 + i) * DM + h * 256 + tid]);
    __syncthreads();
    {
        const bf16_t* kr = P.b(OFF_KX) + ((size_t)l * MT + b * MEML + tid) * DM + h * 256;
        float s[16];
#pragma unroll
        for (int i = 0; i < 16; ++i) s[i] = 0.f;
        for (int d = 0; d < 256; d += 8) {
            const bf16x8 kv = *(const bf16x8*)(kr + d);
#pragma unroll
            for (int j = 0; j < 8; ++j) { const float kf = bf2f((bf16_t)kv[j]);
#pragma unroll
                for (int i = 0; i < 16; ++i) s[i] += qs[i][d + j] * kf; }
        }
#pragma unroll
        for (int i = 0; i < 16; ++i) pp[i][tid] = s[i];
    }
    __syncthreads();
    {
        const int wave = tid >> 6, lane = tid & 63;
        for (int i = wave * 4; i < wave * 4 + 4; ++i) {
            float v[4]; float m = -INFINITY;
#pragma unroll
            for (int j = 0; j < 4; ++j) { v[j] = pp[i][lane + 64 * j]; m = fmaxf(m, v[j]); }
            m = wave_max(m); float sum = 0.f;
#pragma unroll
            for (int j = 0; j < 4; ++j) { v[j] = exp2f(v[j] - m); sum += v[j]; }
            sum = wave_sum(sum); const float inv = 1.0f / sum;
#pragma unroll
            for (int j = 0; j < 4; ++j) pp[i][lane + 64 * j] = v[j] * inv;
        }
    }
    __syncthreads();
    {
        const bf16_t* vr = P.b(OFF_VXT) + ((size_t)l * DM + h * 256 + tid) * MT + b * MEML;
        float o[16];
#pragma unroll
        for (int i = 0; i < 16; ++i) o[i] = 0.f;
        for (int m = 0; m < 256; m += 8) {
            const bf16x8 vv = *(const bf16x8*)(vr + m);
#pragma unroll
            for (int j = 0; j < 8; ++j) { const float vf = bf2f((bf16_t)vv[j]);
#pragma unroll
                for (int i = 0; i < 16; ++i) o[i] += pp[i][m + j] * vf; }
        }
#pragma unroll
        for (int i = 0; i < 16; ++i) P.b(OFF_OX)[(size_t)(tok0 + i) * DM + h * 256 + tid] = f2bf(o[i]);
    }
}
__global__ __launch_bounds__(256) void k_router_naive(Ptrs P, const float* __restrict__ b_group, const float* __restrict__ b_router) {
    __shared__ float lg[4][64];
    const int tid = threadIdx.x, w = tid >> 6, n = tid & 63, tok = blockIdx.x * 4 + w, l = P.l;
    if (n < 36) {
        const bf16_t* xr = P.b(OFF_XB) + (size_t)tok * DM; const bf16_t* wr = P.b(OFF_WR + l * SZ_WR) + (size_t)n * DM;
        float dot = 0.f;
        for (int k = 0; k < DM; k += 8) { const bf16x8 a = *(const bf16x8*)(xr + k), bb = *(const bf16x8*)(wr + k);
#pragma unroll
            for (int j = 0; j < 8; ++j) dot += bf2f((bf16_t)a[j]) * bf2f((bf16_t)bb[j]); }
        lg[w][n] = dot * rs4(P.f(OFF_SSX), tok) + (n < 32 ? b_router[l * NE + n] : b_group[l * NG + (n - 32)]);
    }
    __syncthreads();
    if (n == 0) {
        int gs = 0; float gm = lg[w][32];
        for (int i = 1; i < 4; ++i) if (lg[w][32 + i] > gm) { gm = lg[w][32 + i]; gs = i; }
        float den = 0.f; for (int i = 0; i < 4; ++i) den += __expf(lg[w][32 + i] - gm);
        const float pg = 1.0f / den;
        int i1 = 0; float v1 = lg[w][gs * 8];
        for (int i = 1; i < 8; ++i) if (lg[w][gs * 8 + i] > v1) { v1 = lg[w][gs * 8 + i]; i1 = i; }
        int i2 = -1; float v2 = -INFINITY;
        for (int i = 0; i < 8; ++i) if (i != i1 && lg[w][gs * 8 + i] > v2) { v2 = lg[w][gs * 8 + i]; i2 = i; }
        const float w1 = 1.0f / (1.0f + __expf(v2 - v1)), w2 = 1.0f - w1;
        const int e1 = gs * 8 + i1, e2 = gs * 8 + i2;
        int* cnt = P.i(OFF_CTL) + CW_CNT + l * 64;
        const int p1 = atomicAdd(cnt + e1, 1), p2 = atomicAdd(cnt + 32 + e2, 1);
        P.i(OFF_PERM)[(size_t)e1 * T + p1] = tok; P.i(OFF_PERM)[(size_t)(32 + e2) * T + p2] = tok;
        P.f(OFF_GATE)[(size_t)tok * 2] = pg * w1; P.f(OFF_GATE)[(size_t)tok * 2 + 1] = pg * w2;
    }
}
__global__ __launch_bounds__(256) void k_final(Ptrs P, const float* __restrict__ norm_final) {
    const int row = blockIdx.x * 4 + (threadIdx.x >> 6), lane = threadIdx.x & 63;
    const float rs = rs4(P.f(OFF_SSX), row);
#pragma unroll
    for (int j = 0; j < 4; ++j) {
        const f32x4 v = *(const f32x4*)(P.f(OFF_XF) + (size_t)row * DM + j * 256 + lane * 4), g = *(const f32x4*)(norm_final + j * 256 + lane * 4);
        *(f32x4*)(P.out + (size_t)row * DM + j * 256 + lane * 4) = v * rs * g;
    }
}

extern "C" void kernel_launch(void* const* d_in, const int* in_sizes, int n_in, void* d_out, int out_size, void* d_ws, size_t ws_size, hipStream_t stream) {
    if (n_in != 25 || ws_size < WS_NEED || out_size != T * DM) { fprintf(stderr, "kernel_launch: unexpected shapes (n_in %d, ws %zu need %zu, out %d)\n", n_in, ws_size, (size_t)WS_NEED, out_size); return; }
    const float* x = (const float*)d_in[0]; const float* mem = (const float*)d_in[1]; const float* norm_mix = (const float*)d_in[2]; const float* w_in = (const float*)d_in[3];
    const float* v_norm = (const float*)d_in[4]; const float* w_sp = (const float*)d_in[5]; const float* b_sp = (const float*)d_in[6]; const float* on_a = (const float*)d_in[7];
    const float* on_b = (const float*)d_in[8]; const float* w_out = (const float*)d_in[9]; const float* norm_cross = (const float*)d_in[10]; const float* norm_mem = (const float*)d_in[11];
    const float* w_xq = (const float*)d_in[12]; const float* w_xk = (const float*)d_in[13]; const float* w_xv = (const float*)d_in[14]; const float* w_xo = (const float*)d_in[15];
    const float* norm_moe = (const float*)d_in[16]; const float* w_group = (const float*)d_in[17]; const float* b_group = (const float*)d_in[18]; const float* w_router = (const float*)d_in[19];
    const float* b_router = (const float*)d_in[20]; const float* w1 = (const float*)d_in[21]; const float* w3 = (const float*)d_in[22]; const float* w2 = (const float*)d_in[23]; const float* norm_final = (const float*)d_in[24];
    unsigned char* ws = (unsigned char*)d_ws;
    hipMemsetAsync(ws + OFF_CTL, 0, 1 * MiB, stream);
    auto B = [&](size_t off) { return (bf16_t*)(ws + off); };
    const int HUGE_G = 1 << 30;
    const long s_in = (long)DM * INW, d_inw = (long)INW * DM, s_sq = (long)DM * DM;
    k_transpose<<<dim3(16 * 8, 1, NL), 256, 0, stream>>>(w_in + 0, B(OFF_WIN), norm_mix, nullptr, DM, 1.f, DM, 512, INW, 0, s_in, 0, d_inw, DM, HUGE_G, 0, 0);
    k_transpose<<<dim3(16 * 8, 1, NL), 256, 0, stream>>>(w_in + 512, B(OFF_WIN), norm_mix, nullptr, DM, 1.f, DM, 512, INW, 0, s_in, 0, d_inw, DM, HUGE_G, 0, 1536);
    k_transpose<<<dim3(16 * 8, 1, NL), 256, 0, stream>>>(w_in + 1024, B(OFF_WIN), norm_mix, nullptr, DM, QSCALE, DM, 512, INW, 0, s_in, 0, d_inw, DM, HUGE_G, 0, 512);
    k_transpose<<<dim3(16 * 8, 1, NL), 256, 0, stream>>>(w_in + 1536, B(OFF_WIN), norm_mix, nullptr, DM, 1.f, DM, 512, INW, 0, s_in, 0, d_inw, DM, HUGE_G, 0, 1024);
    k_transpose<<<dim3(16 * 8, 1, NL), 256, 0, stream>>>(w_in + 2048, B(OFF_WIN), norm_mix, nullptr, DM, 1.f, DM, 512, INW, 0, s_in, 0, d_inw, DM, HUGE_G, 0, 2048);
    k_transpose<<<dim3(16 * 16, 1, NL), 256, 0, stream>>>(w_out, B(OFF_WOUT), on_a, on_b, 512, 1.f, DM, DM, DM, 0, s_sq, 0, s_sq, 512, HUGE_G, 0, 0);
    k_transpose<<<dim3(16 * 16, 1, NL), 256, 0, stream>>>(w_xq, B(OFF_WXQ), norm_cross, nullptr, DM, XSCALE, DM, DM, DM, 0, s_sq, 0, s_sq, DM, HUGE_G, 0, 0);
    k_transpose<<<dim3(16 * 16, 1, NL), 256, 0, stream>>>(w_xk, B(OFF_WXK), norm_mem, nullptr, DM, 1.f, DM, DM, DM, 0, s_sq, 0, s_sq, DM, HUGE_G, 0, 0);
    k_transpose<<<dim3(16 * 16, 1, NL), 256, 0, stream>>>(w_xv, B(OFF_WXV), norm_mem, nullptr, DM, 1.f, DM, DM, DM, 0, s_sq, 0, s_sq, DM, HUGE_G, 0, 0);
    k_transpose<<<dim3(16 * 16, 1, NL), 256, 0, stream>>>(w_xo, B(OFF_WXO), nullptr, nullptr, DM, 1.f, DM, DM, DM, 0, s_sq, 0, s_sq, DM, HUGE_G, 0, 0);
    k_transpose<<<dim3(16 * 8, NE, NL), 256, 0, stream>>>(w1, B(OFF_W13), norm_moe, nullptr, DM, 1.f, DM, DE, DE, (long)DM * DE, (long)NE * DM * DE, (long)1024 * DM, (long)NE * 1024 * DM, DM, 128, 256, 0);
    k_transpose<<<dim3(16 * 8, NE, NL), 256, 0, stream>>>(w3, B(OFF_W13), norm_moe, nullptr, DM, 1.f, DM, DE, DE, (long)DM * DE, (long)NE * DM * DE, (long)1024 * DM, (long)NE * 1024 * DM, DM, 128, 256, 128);
    k_transpose<<<dim3(8 * 16, NE, NL), 256, 0, stream>>>(w2, B(OFF_W2), nullptr, nullptr, DE, 1.f, DE, DM, DM, (long)DE * DM, (long)NE * DE * DM, (long)DM * DE, (long)NE * DM * DE, DM, HUGE_G, 0, 0);
    k_prep_router<<<NL * 64 * DM / 256, 256, 0, stream>>>(w_router, w_group, norm_moe, B(OFF_WR));
    k_prep_spatial<<<NL * AG * CHUNK * CHUNK / 256, 256, 0, stream>>>(w_sp, B(OFF_WS));
    k_prep_rows<<<T / 4, 256, 0, stream>>>(x, B(OFF_XB), (float*)(ws + OFF_SSX), nullptr, T);
    k_prep_rows<<<MT / 4, 256, 0, stream>>>(mem, B(OFF_MB), nullptr, (float*)(ws + OFF_SSM), MT);
    Ptrs P; P.ws = ws; P.x_in = x; P.out = (float*)d_out; P.l = 0;
    k_sgemm<ProbMemK><<<dim3(4 * 16, NL), 256, 0, stream>>>(ProbMemK{P});
    k_sgemm<ProbMemVT><<<dim3(4 * 16, NL), 256, 0, stream>>>(ProbMemVT{P});
    for (int l = 0; l < NL; ++l) {
        P.l = l;
        k_sgemm<ProbIn><<<6 * 256, 256, 0, stream>>>(ProbIn{P});
        k_sgemm<ProbInT><<<64 * 16, 256, 0, stream>>>(ProbInT{P});
        k_attn_naive<<<T * SBH / 256, 256, 0, stream>>>(P);
        k_gmlp_naive<<<(T / CHUNK) * AG, 256, 0, stream>>>(P, v_norm, b_sp);
        k_sgemm<ProbOut><<<4 * 256, 256, 0, stream>>>(ProbOut{P});
        k_sgemm<ProbXq><<<4 * 256, 256, 0, stream>>>(ProbXq{P});
        k_xattn_naive<<<(T / 16) * XH, 256, 0, stream>>>(P);
        k_sgemm<ProbXo><<<4 * 256, 256, 0, stream>>>(ProbXo{P});
        k_router_naive<<<T / 4, 256, 0, stream>>>(P, b_group, b_router);
        k_sgemm<ProbMoe1><<<4 * (2 * T / 64 + 64), 256, 0, stream>>>(ProbMoe1{P});
        k_sgemm<ProbMoe2<0>><<<4 * (T / 64 + 32), 256, 0, stream>>>(ProbMoe2<0>{P});
        k_sgemm<ProbMoe2<1>><<<4 * (T / 64 + 32), 256, 0, stream>>>(ProbMoe2<1>{P});
    }
    k_final<<<T / 4, 256, 0, stream>>>(P, norm_final);
}
```

```cpp
#include <hip/hip_runtime.h>
#include <stdint.h>
#include <stdio.h>

typedef unsigned short bf16_t;
typedef short bf16x8 __attribute__((ext_vector_type(8)));
typedef float f32x4 __attribute__((ext_vector_type(4)));
typedef float f32x16 __attribute__((ext_vector_type(16)));
typedef unsigned u32x2 __attribute__((ext_vector_type(2)));
typedef unsigned u32x4 __attribute__((ext_vector_type(4)));

constexpr int NB = 4, SEQ = 4096, T = NB * SEQ, DM = 1024, NL = 4;
constexpr int AW = 512, AG = 4, ACH = 128, CHUNK = 128;
constexpr int SBW = 512, SBH = 8, SBD = 64;
constexpr int INW = 2560;
constexpr int MEML = 256, MT = NB * MEML, XH = 4, XD = 256;
constexpr int NG = 4, EPG = 8, NE = 32, DE = 512;
constexpr float EPS = 1e-6f;
constexpr float LOG2E = 1.4426950408889634f;
constexpr float QSCALE = 0.125f * LOG2E;
constexpr float XSCALE = 0.0625f * LOG2E;
constexpr float RSTOP = 104.0f * LOG2E;

constexpr size_t MiB = 1u << 20;
constexpr size_t OFF_CTL = 0;
constexpr size_t OFF_WIN = 1 * MiB;
constexpr size_t SZ_WIN = (size_t)INW * DM * 2;
constexpr size_t OFF_WOUT = OFF_WIN + NL * SZ_WIN;
constexpr size_t SZ_SQ = (size_t)DM * DM * 2;
constexpr size_t OFF_WXQ = OFF_WOUT + NL * SZ_SQ;
constexpr size_t OFF_WXK = OFF_WXQ + NL * SZ_SQ;
constexpr size_t OFF_WXV = OFF_WXK + NL * SZ_SQ;
constexpr size_t OFF_WXO = OFF_WXV + NL * SZ_SQ;
constexpr size_t OFF_WR = OFF_WXO + NL * SZ_SQ;
constexpr size_t SZ_WR = (size_t)64 * DM * 2;
constexpr size_t OFF_WS = OFF_WR + NL * SZ_WR;
constexpr size_t SZ_WS = (size_t)AG * CHUNK * CHUNK * 2;
constexpr size_t OFF_W13 = OFF_WS + NL * SZ_WS;
constexpr size_t SZ_W13 = (size_t)1024 * DM * 2;
constexpr size_t OFF_W2 = OFF_W13 + (size_t)NL * NE * SZ_W13;
constexpr size_t SZ_W2 = (size_t)DM * DE * 2;
constexpr size_t OFF_XF = OFF_W2 + (size_t)NL * NE * SZ_W2;
constexpr size_t OFF_XB = OFF_XF + (size_t)T * DM * 4;
constexpr size_t OFF_SSX = OFF_XB + (size_t)T * DM * 2;
constexpr size_t OFF_U = OFF_SSX + (size_t)T * 16 * 4;
constexpr size_t SZ_H = (size_t)T * 512 * 2;
constexpr size_t OFF_Q = OFF_U + SZ_H;
constexpr size_t OFF_K = OFF_Q + SZ_H;
constexpr size_t OFF_VGT = OFF_K + SZ_H;
constexpr size_t OFF_VBT = OFF_VGT + SZ_H;
constexpr size_t OFF_Y = OFF_VBT + SZ_H;
constexpr size_t OFF_SSA = OFF_Y + (size_t)T * DM * 2;
constexpr size_t OFF_SSB = OFF_SSA + (size_t)T * 4 * 4;
constexpr size_t OFF_QX = OFF_SSB + (size_t)T * 8 * 4;
constexpr size_t OFF_OX = OFF_QX + (size_t)T * DM * 2;
constexpr size_t OFF_MB = OFF_OX + (size_t)T * DM * 2;
constexpr size_t OFF_SSM = OFF_MB + (size_t)MT * DM * 2;
constexpr size_t OFF_KX = OFF_SSM + (size_t)MT * 4;
constexpr size_t OFF_VXT = OFF_KX + (size_t)NL * MT * DM * 2;
constexpr size_t OFF_GATE = OFF_VXT + (size_t)NL * MT * DM * 2;
constexpr size_t OFF_PERM = OFF_GATE + (size_t)T * 2 * 4;
constexpr int ACT_ROWS = 2 * T + 64 * 256;
constexpr size_t OFF_ACT = OFF_PERM + (size_t)64 * T * 4;
constexpr size_t WS_NEED = OFF_ACT + (size_t)ACT_ROWS * DE * 2;
constexpr int CW_CNT = 1024;

__device__ __forceinline__ float bf2f(bf16_t h) { return __uint_as_float((unsigned)h << 16); }
__device__ __forceinline__ bf16_t f2bf(float f) { unsigned u = __float_as_uint(f); u += 0x7fffu + ((u >> 16) & 1u); return (bf16_t)(u >> 16); }
__device__ __forceinline__ unsigned pk2(float lo, float hi) { return (unsigned)f2bf(lo) | ((unsigned)f2bf(hi) << 16); }
__device__ __forceinline__ float gelu_tanh(float x) { const float t = 0.7978845608028654f * (x + 0.044715f * x * x * x); return x / (1.0f + __expf(-2.0f * t)); }
__device__ __forceinline__ float silu(float x) { return x / (1.0f + __expf(-x)); }
__device__ __forceinline__ float softplus2(float u) { return fmaxf(u, 0.f) + __log2f(1.0f + exp2f(-fabsf(u))); }
__device__ __forceinline__ float wave_sum(float v) {
#pragma unroll
    for (int o = 1; o < 64; o <<= 1) v += __shfl_xor(v, o);
    return v;
}
__device__ __forceinline__ float wave_max(float v) {
#pragma unroll
    for (int o = 1; o < 64; o <<= 1) v = fmaxf(v, __shfl_xor(v, o));
    return v;
}
__device__ __forceinline__ float rs4(const float* ss, int row) { const f32x4* p = (const f32x4*)(ss + (size_t)row * 16); const f32x4 a = p[0], b = p[1], c = p[2], d = p[3];
    return rsqrtf(((((a[0] + a[1]) + (a[2] + a[3])) + ((b[0] + b[1]) + (b[2] + b[3]))) + (((c[0] + c[1]) + (c[2] + c[3])) + ((d[0] + d[1]) + (d[2] + d[3])))) * (1.0f / 1024.0f) + EPS); }

__global__ __launch_bounds__(256) void k_transpose(const float* __restrict__ src, bf16_t* __restrict__ dst, const float* __restrict__ gain, const float* __restrict__ gain2, int ksplit,
                                                   float scale, int K, int N, int src_ld, long ssi, long sso, long dsi, long dso, int gso, int G, int GS, int GO) {
    __shared__ float tile[64][65];
    const int ntn = N / 64, kt = blockIdx.x / ntn, nt = blockIdx.x % ntn;
    const float* s = src + (size_t)blockIdx.y * ssi + (size_t)blockIdx.z * sso;
    bf16_t* d = dst + (size_t)blockIdx.y * dsi + (size_t)blockIdx.z * dso;
    const int tx = threadIdx.x & 63, ty = threadIdx.x >> 6;
#pragma unroll 4
    for (int i = 0; i < 16; ++i) { const int k = ty + 4 * i; tile[k][tx] = s[(size_t)(kt * 64 + k) * src_ld + nt * 64 + tx]; }
    __syncthreads();
    const int kx = threadIdx.x & 31, ny = threadIdx.x >> 5, k0 = kt * 64 + 2 * kx;
    float ga = scale, gb = scale;
    if (gain) { const float* g1 = gain + (size_t)blockIdx.z * gso; const float* g2 = gain2 ? gain2 + (size_t)blockIdx.z * gso : g1;
        ga *= (k0 < ksplit) ? g1[k0] : g2[k0 - ksplit]; gb *= (k0 + 1 < ksplit) ? g1[k0 + 1] : g2[k0 + 1 - ksplit]; }
#pragma unroll
    for (int i = 0; i < 8; ++i) { const int n = ny + 8 * i, ng = nt * 64 + n, drow = (ng / G) * GS + GO + (ng % G);
        *(unsigned*)(d + (size_t)drow * K + k0) = pk2(tile[2 * kx][n] * ga, tile[2 * kx + 1][n] * gb); }
}
__global__ void k_prep_router(const float* __restrict__ w_router, const float* __restrict__ w_group, const float* __restrict__ norm_moe, bf16_t* __restrict__ WR) {
    const int idx = blockIdx.x * 256 + threadIdx.x; if (idx >= NL * 64 * DM) return;
    const int k = idx % DM, n = (idx / DM) % 64, l = idx / (64 * DM);
    float v = 0.f;
    if (n < 32) v = w_router[((size_t)l * DM + k) * NE + n]; else if (n < 36) v = w_group[((size_t)l * DM + k) * NG + (n - 32)];
    WR[idx] = f2bf(v * norm_moe[l * DM + k]);
}
__global__ void k_prep_spatial(const float* __restrict__ w_sp, bf16_t* __restrict__ WS) {
    const int idx = blockIdx.x * 256 + threadIdx.x; if (idx >= NL * AG * CHUNK * CHUNK) return;
    const int s = idx % CHUNK, t = (idx / CHUNK) % CHUNK;
    WS[idx] = (s <= t) ? f2bf(w_sp[idx]) : (bf16_t)0;
}
__global__ __launch_bounds__(256) void k_prep_rows(const float* __restrict__ x, bf16_t* __restrict__ xb, float* __restrict__ ss4, float* __restrict__ ss1, int R) {
    const int row = blockIdx.x * 4 + (threadIdx.x >> 6), lane = threadIdx.x & 63; if (row >= R) return;
    float tot = 0.f;
#pragma unroll
    for (int j = 0; j < 4; ++j) {
        const f32x4 v = *(const f32x4*)(x + (size_t)row * DM + j * 256 + lane * 4);
        u32x2 w; w.x = pk2(v[0], v[1]); w.y = pk2(v[2], v[3]);
        *(u32x2*)(xb + (size_t)row * DM + j * 256 + lane * 4) = w;
        float s = (v[0] * v[0] + v[1] * v[1]) + (v[2] * v[2] + v[3] * v[3]);
        s += __shfl_xor(s, 1); s += __shfl_xor(s, 2); s += __shfl_xor(s, 4); s += __shfl_xor(s, 8);
        if (ss4 && (lane & 15) == 0) ss4[(size_t)row * 16 + j * 4 + (lane >> 4)] = s;
        s += __shfl_xor(s, 16); s += __shfl_xor(s, 32);
        tot += s;
    }
    if (ss1 && lane == 0) ss1[row] = tot;
}

#define MFMA32(a, b, c) __builtin_amdgcn_mfma_f32_32x32x16_bf16((a), (b), (c), 0, 0, 0)
struct SUnit { int p0, q0, aux0, aux1, aux2; };
template <class Prob> __global__ __launch_bounds__(256) void k_sgemm(Prob pr) {
    const int tid = threadIdx.x, wave = tid >> 6, lane = tid & 63, c = lane & 31, h = lane >> 5;
    SUnit u;
    if (!pr.unit((int)blockIdx.x, (int)blockIdx.y, u)) return;
    int pb[2], qb[2];
#pragma unroll
    for (int i = 0; i < 2; ++i) { pb[i] = u.p0 + (Prob::PAIRED ? 32 * wave + 128 * i : 64 * wave + 32 * i); qb[i] = u.q0 + 32 * i; }
    const bf16_t* pa[2]; const bf16_t* qa[2];
#pragma unroll
    for (int i = 0; i < 2; ++i) { pa[i] = pr.prow(u, pb[i] + c) + 8 * h; qa[i] = pr.qrow(u, qb[i] + c) + 8 * h; }
    f32x16 acc[2][2];
#pragma unroll
    for (int i = 0; i < 2; ++i)
#pragma unroll
        for (int j = 0; j < 2; ++j)
#pragma unroll
            for (int r = 0; r < 16; ++r) acc[i][j][r] = 0.f;
    constexpr int K = Prob::K;
#pragma unroll 1
    for (int kh = 0; kh < 2; ++kh) {
        if (Prob::MIDK && kh == 1) {
            const float r0 = pr.midscale(u, qb[0] + c), r1 = pr.midscale(u, qb[1] + c);
#pragma unroll
            for (int i = 0; i < 2; ++i)
#pragma unroll
                for (int r = 0; r < 16; ++r) { acc[i][0][r] *= r0; acc[i][1][r] *= r1; }
        }
#pragma unroll 4
        for (int k = kh * (K / 2); k < (kh + 1) * (K / 2); k += 16) {
            const bf16x8 a0 = *(const bf16x8*)(pa[0] + k), a1 = *(const bf16x8*)(pa[1] + k), b0 = *(const bf16x8*)(qa[0] + k), b1 = *(const bf16x8*)(qa[1] + k);
            acc[0][0] = MFMA32(a0, b0, acc[0][0]); acc[0][1] = MFMA32(a0, b1, acc[0][1]); acc[1][0] = MFMA32(a1, b0, acc[1][0]); acc[1][1] = MFMA32(a1, b1, acc[1][1]);
        }
    }
    float ss[2] = {0.f, 0.f};
#pragma unroll
    for (int j = 0; j < 2; ++j)
#pragma unroll
        for (int g = 0; g < 4; ++g) {
            if (Prob::PAIRED) {
                const f32x4 va = {acc[0][j][4 * g], acc[0][j][4 * g + 1], acc[0][j][4 * g + 2], acc[0][j][4 * g + 3]};
                const f32x4 vb = {acc[1][j][4 * g], acc[1][j][4 * g + 1], acc[1][j][4 * g + 2], acc[1][j][4 * g + 3]};
                pr.epi2(u, pb[0] + 8 * g + 4 * h, qb[j] + c, va, vb);
            } else {
#pragma unroll
                for (int i = 0; i < 2; ++i) {
                    const f32x4 v = {acc[i][j][4 * g], acc[i][j][4 * g + 1], acc[i][j][4 * g + 2], acc[i][j][4 * g + 3]};
                    ss[j] += pr.epi(u, pb[i] + 8 * g + 4 * h, qb[j] + c, v);
                }
            }
        }
    if (Prob::ROWSS) {
#pragma unroll
        for (int j = 0; j < 2; ++j) { ss[j] += __shfl_xor(ss[j], 32); if (h == 0) pr.rowss(u, qb[j] + c, wave, ss[j]); }
    }
}

struct Ptrs {
    unsigned char* ws; const float* x_in; float* out; int l;
    __device__ __forceinline__ bf16_t* b(size_t off) const { return (bf16_t*)(ws + off); }
    __device__ __forceinline__ float* f(size_t off) const { return (float*)(ws + off); }
    __device__ __forceinline__ int* i(size_t off) const { return (int*)(ws + off); }
};
__device__ __forceinline__ void st4bf(bf16_t* p, f32x4 v) { u32x2 w; w.x = pk2(v[0], v[1]); w.y = pk2(v[2], v[3]); *(u32x2*)p = w; }

struct ProbIn { static constexpr int K = DM; static constexpr bool PAIRED = false, MIDK = false, ROWSS = false; Ptrs P;
    __device__ bool unit(int bx, int, SUnit& u) const { u.p0 = (bx % 6) * 256; u.q0 = (bx / 6) * 64; return true; }
    __device__ const bf16_t* prow(const SUnit&, int p) const { return P.b(OFF_WIN + P.l * SZ_WIN) + (size_t)p * DM; }
    __device__ const bf16_t* qrow(const SUnit&, int q) const { return P.b(OFF_XB) + (size_t)q * DM; }
    __device__ float midscale(const SUnit&, int) const { return 1.f; }
    __device__ float epi(const SUnit&, int p, int q, f32x4 v) const {
        const float rs = rs4(P.f(OFF_SSX), q); v = v * rs;
        if (p < 512) { for (int i = 0; i < 4; ++i) v[i] = gelu_tanh(v[i]); st4bf(P.b(OFF_U) + (size_t)q * 512 + p, v); }
        else if (p < 1024) st4bf(P.b(OFF_Q) + (size_t)q * 512 + (p - 512), v);
        else st4bf(P.b(OFF_K) + (size_t)q * 512 + (p - 1024), v);
        return 0.f; }
    __device__ void epi2(const SUnit&, int, int, f32x4, f32x4) const {}
    __device__ void rowss(const SUnit&, int, int, float) const {}
};
struct ProbInT { static constexpr int K = DM; static constexpr bool PAIRED = false, MIDK = false, ROWSS = false; Ptrs P;
    __device__ bool unit(int bx, int, SUnit& u) const { u.p0 = (bx % 64) * 256; u.q0 = (bx / 64) * 64; return true; }
    __device__ const bf16_t* prow(const SUnit&, int p) const { return P.b(OFF_XB) + (size_t)p * DM; }
    __device__ const bf16_t* qrow(const SUnit&, int q) const { return P.b(OFF_WIN + P.l * SZ_WIN) + (size_t)(1536 + q) * DM; }
    __device__ float midscale(const SUnit&, int) const { return 1.f; }
    __device__ float epi(const SUnit&, int p, int q, f32x4 v) const {
        for (int i = 0; i < 4; ++i) v[i] *= rs4(P.f(OFF_SSX), p + i);
        if (q < 512) { for (int i = 0; i < 4; ++i) v[i] = gelu_tanh(v[i]); st4bf(P.b(OFF_VGT) + (size_t)q * T + p, v); }
        else st4bf(P.b(OFF_VBT) + (size_t)(q - 512) * T + p, v);
        return 0.f; }
    __device__ void epi2(const SUnit&, int, int, f32x4, f32x4) const {}
    __device__ void rowss(const SUnit&, int, int, float) const {}
};
struct ProbMemK { static constexpr int K = DM; static constexpr bool PAIRED = false, MIDK = false, ROWSS = false; Ptrs P;
    __device__ bool unit(int bx, int by, SUnit& u) const { u.p0 = (bx % 4) * 256; u.q0 = (bx / 4) * 64; u.aux0 = by; return true; }
    __device__ const bf16_t* prow(const SUnit& u, int p) const { return P.b(OFF_WXK + u.aux0 * SZ_SQ) + (size_t)p * DM; }
    __device__ const bf16_t* qrow(const SUnit&, int q) const { return P.b(OFF_MB) + (size_t)q * DM; }
    __device__ float midscale(const SUnit&, int) const { return 1.f; }
    __device__ float epi(const SUnit& u, int p, int q, f32x4 v) const {
        const float rs = rsqrtf(P.f(OFF_SSM)[q] * (1.0f / 1024.0f) + EPS); v = v * rs;
        st4bf(P.b(OFF_KX) + ((size_t)u.aux0 * MT + q) * DM + p, v); return 0.f; }
    __device__ void epi2(const SUnit&, int, int, f32x4, f32x4) const {}
    __device__ void rowss(const SUnit&, int, int, float) const {}
};
struct ProbMemVT { static constexpr int K = DM; static constexpr bool PAIRED = false, MIDK = false, ROWSS = false; Ptrs P;
    __device__ bool unit(int bx, int by, SUnit& u) const { u.p0 = (bx % 4) * 256; u.q0 = (bx / 4) * 64; u.aux0 = by; return true; }
    __device__ const bf16_t* prow(const SUnit&, int p) const { return P.b(OFF_MB) + (size_t)p * DM; }
    __device__ const bf16_t* qrow(const SUnit& u, int q) const { return P.b(OFF_WXV + u.aux0 * SZ_SQ) + (size_t)q * DM; }
    __device__ float midscale(const SUnit&, int) const { return 1.f; }
    __device__ float epi(const SUnit& u, int p, int q, f32x4 v) const {
        for (int i = 0; i < 4; ++i) v[i] *= rsqrtf(P.f(OFF_SSM)[p + i] * (1.0f / 1024.0f) + EPS);
        st4bf(P.b(OFF_VXT) + ((size_t)u.aux0 * DM + q) * MT + p, v); return 0.f; }
    __device__ void epi2(const SUnit&, int, int, f32x4, f32x4) const {}
    __device__ void rowss(const SUnit&, int, int, float) const {}
};
__device__ __forceinline__ float resid_store(const Ptrs& P, const float* res, int tok, int col, f32x4 add) {
    const f32x4 r = *(const f32x4*)(res + (size_t)tok * DM + col);
    const f32x4 xn = r + add;
    *(f32x4*)(P.f(OFF_XF) + (size_t)tok * DM + col) = xn;
    st4bf(P.b(OFF_XB) + (size_t)tok * DM + col, xn);
    return (xn[0] * xn[0] + xn[1] * xn[1]) + (xn[2] * xn[2] + xn[3] * xn[3]);
}
struct ProbOut { static constexpr int K = DM; static constexpr bool PAIRED = false, MIDK = true, ROWSS = true; Ptrs P;
    __device__ float rsa(int q) const { const f32x4 v = *(const f32x4*)(P.f(OFF_SSA) + (size_t)q * 4); return rsqrtf(((v[0] + v[1]) + (v[2] + v[3])) * (1.0f / 512.0f) + EPS); }
    __device__ float rsb(int q) const { const f32x4 v = *(const f32x4*)(P.f(OFF_SSB) + (size_t)q * 8), w = *(const f32x4*)(P.f(OFF_SSB) + (size_t)q * 8 + 4);
        return rsqrtf((((v[0] + v[1]) + (v[2] + v[3])) + ((w[0] + w[1]) + (w[2] + w[3]))) * (1.0f / 512.0f) + EPS); }
    __device__ bool unit(int bx, int, SUnit& u) const { u.p0 = (bx % 4) * 256; u.q0 = (bx / 4) * 64; return true; }
    __device__ const bf16_t* prow(const SUnit&, int p) const { return P.b(OFF_WOUT + P.l * SZ_SQ) + (size_t)p * DM; }
    __device__ const bf16_t* qrow(const SUnit&, int q) const { return P.b(OFF_Y) + (size_t)q * DM; }
    __device__ float midscale(const SUnit&, int q) const { return rsa(q) / rsb(q); }
    __device__ float epi(const SUnit&, int p, int q, f32x4 v) const { const float* res = (P.l == 0) ? P.x_in : P.f(OFF_XF); return resid_store(P, res, q, p, v * rsb(q)); }
    __device__ void epi2(const SUnit&, int, int, f32x4, f32x4) const {}
    __device__ void rowss(const SUnit& u, int q, int w, float s) const { P.f(OFF_SSX)[(size_t)q * 16 + (u.p0 / 256) * 4 + w] = s; }
};
struct ProbXq { static constexpr int K = DM; static constexpr bool PAIRED = false, MIDK = false, ROWSS = false; Ptrs P;
    __device__ bool unit(int bx, int, SUnit& u) const { u.p0 = (bx % 4) * 256; u.q0 = (bx / 4) * 64; return true; }
    __device__ const bf16_t* prow(const SUnit&, int p) const { return P.b(OFF_WXQ + P.l * SZ_SQ) + (size_t)p * DM; }
    __device__ const bf16_t* qrow(const SUnit&, int q) const { return P.b(OFF_XB) + (size_t)q * DM; }
    __device__ float midscale(const SUnit&, int) const { return 1.f; }
    __device__ float epi(const SUnit&, int p, int q, f32x4 v) const { st4bf(P.b(OFF_QX) + (size_t)q * DM + p, v * rs4(P.f(OFF_SSX), q)); return 0.f; }
    __device__ void epi2(const SUnit&, int, int, f32x4, f32x4) const {}
    __device__ void rowss(const SUnit&, int, int, float) const {}
};
struct ProbXo { static constexpr int K = DM; static constexpr bool PAIRED = false, MIDK = false, ROWSS = true; Ptrs P;
    __device__ bool unit(int bx, int, SUnit& u) const { u.p0 = (bx % 4) * 256; u.q0 = (bx / 4) * 64; return true; }
    __device__ const bf16_t* prow(const SUnit&, int p) const { return P.b(OFF_WXO + P.l * SZ_SQ) + (size_t)p * DM; }
    __device__ const bf16_t* qrow(const SUnit&, int q) const { return P.b(OFF_OX) + (size_t)q * DM; }
    __device__ float midscale(const SUnit&, int) const { return 1.f; }
    __device__ float epi(const SUnit&, int p, int q, f32x4 v) const { return resid_store(P, P.f(OFF_XF), q, p, v); }
    __device__ void epi2(const SUnit&, int, int, f32x4, f32x4) const {}
    __device__ void rowss(const SUnit& u, int q, int w, float s) const { P.f(OFF_SSX)[(size_t)q * 16 + (u.p0 / 256) * 4 + w] = s; }
};
template <int TQ> __device__ __forceinline__ bool moe_decode(const int* cnt, int sg_lo, int sg_hi, int qt_flat, int& sg, int& qt, int& n, int& rowbase) {
    int rb = 0, base = 0; bool found = false;
    for (int s = 0; s < 64; ++s) {
        const int c = cnt[s];
        if (s >= sg_lo && s < sg_hi && !found) { const int nt = (c + TQ - 1) / TQ; if (qt_flat < base + nt) { sg = s; qt = qt_flat - base; n = c; rowbase = rb; found = true; } base += nt; }
        rb += (c + 255) & ~255;
    }
    return found;
}
struct ProbMoe1 { static constexpr int K = DM; static constexpr bool PAIRED = true, MIDK = false, ROWSS = false; Ptrs P;
    __device__ bool unit(int bx, int, SUnit& u) const { int sg, qt, n, rb; if (!moe_decode<64>(P.i(OFF_CTL) + CW_CNT + P.l * 64, 0, 64, bx / 4, sg, qt, n, rb)) return false;
        u.p0 = (bx % 4) * 256; u.q0 = qt * 64; u.aux0 = sg; u.aux1 = n; u.aux2 = rb; return true; }
    __device__ const bf16_t* prow(const SUnit& u, int p) const { return P.b(OFF_W13 + ((size_t)P.l * NE + (u.aux0 & 31)) * SZ_W13) + (size_t)p * DM; }
    __device__ int tok(const SUnit& u, int q) const { return P.i(OFF_PERM)[(size_t)u.aux0 * T + (q < u.aux1 ? q : u.aux1 - 1)]; }
    __device__ const bf16_t* qrow(const SUnit& u, int q) const { return P.b(OFF_XB) + (size_t)tok(u, q) * DM; }
    __device__ float midscale(const SUnit&, int) const { return 1.f; }
    __device__ float epi(const SUnit&, int, int, f32x4) const { return 0.f; }
    __device__ void epi2(const SUnit& u, int p, int q, f32x4 a, f32x4 b) const {
        const float rs = rs4(P.f(OFF_SSX), tok(u, q)); f32x4 r;
        for (int i = 0; i < 4; ++i) r[i] = silu(a[i] * rs) * (b[i] * rs);
        st4bf(P.b(OFF_ACT) + (size_t)(u.aux2 + q) * DE + (p >> 8) * 128 + (p & 127), r); }
    __device__ void rowss(const SUnit&, int, int, float) const {}
};
template <int SLOT> struct ProbMoe2 { static constexpr int K = DE; static constexpr bool PAIRED = false, MIDK = false, ROWSS = (SLOT == 1); Ptrs P;
    __device__ bool unit(int bx, int, SUnit& u) const { int sg, qt, n, rb; if (!moe_decode<64>(P.i(OFF_CTL) + CW_CNT + P.l * 64, SLOT * 32, SLOT * 32 + 32, bx / 4, sg, qt, n, rb)) return false;
        u.p0 = (bx % 4) * 256; u.q0 = qt * 64; u.aux0 = sg; u.aux1 = n; u.aux2 = rb; return true; }
    __device__ const bf16_t* prow(const SUnit& u, int p) const { return P.b(OFF_W2 + ((size_t)P.l * NE + (u.aux0 & 31)) * SZ_W2) + (size_t)p * DE; }
    __device__ const bf16_t* qrow(const SUnit& u, int q) const { return P.b(OFF_ACT) + (size_t)(u.aux2 + q) * DE; }
    __device__ float midscale(const SUnit&, int) const { return 1.f; }
    __device__ float epi(const SUnit& u, int p, int q, f32x4 v) const {
        if (q >= u.aux1) return 0.f;
        const int tok = P.i(OFF_PERM)[(size_t)u.aux0 * T + q]; const float g = P.f(OFF_GATE)[(size_t)tok * 2 + SLOT]; v = v * g;
        if (SLOT == 0) { float* xp = P.f(OFF_XF) + (size_t)tok * DM + p; *(f32x4*)xp = *(const f32x4*)xp + v; return 0.f; }
        return resid_store(P, P.f(OFF_XF), tok, p, v); }
    __device__ void epi2(const SUnit&, int, int, f32x4, f32x4) const {}
    __device__ void rowss(const SUnit& u, int q, int w, float s) const { if (q < u.aux1) { const int tok = P.i(OFF_PERM)[(size_t)u.aux0 * T + q]; P.f(OFF_SSX)[(size_t)tok * 16 + (u.p0 / 256) * 4 + w] = s; } }
};

__global__ __launch_bounds__(256) void k_attn_naive(Ptrs P) {
    const int idx = blockIdx.x * 256 + threadIdx.x, h = idx & 7, tok = idx >> 3, b = tok / SEQ, t = tok % SEQ;
    const bf16_t* Qp = P.b(OFF_Q) + (size_t)tok * 512 + h * 64;
    float q[64], o[64];
#pragma unroll
    for (int d = 0; d < 64; ++d) { q[d] = bf2f(Qp[d]); o[d] = 0.f; }
    float R = 0.f;
    for (int s = t - 1; s >= 0; --s) {
        const bf16_t* kr = P.b(OFF_K) + (size_t)(b * SEQ + s) * 512 + h * 64;
        float u = 0.f;
#pragma unroll
        for (int d = 0; d < 64; ++d) u += q[d] * bf2f(kr[d]);
        const float sp = softplus2(u), a = exp2f(u - sp - R);
        const bf16_t* vc = P.b(OFF_VBT) + (size_t)(h * 64) * T + b * SEQ + s;
#pragma unroll
        for (int d = 0; d < 64; ++d) o[d] += a * bf2f(vc[(size_t)d * T]);
        R += sp; if (R > RSTOP) break;
    }
    float ss = 0.f;
#pragma unroll
    for (int d = 0; d < 64; ++d) { const bf16_t ob = f2bf(o[d]); P.b(OFF_Y)[(size_t)tok * DM + 512 + h * 64 + d] = ob; const float of = bf2f(ob); ss += of * of; }
    P.f(OFF_SSB)[(size_t)tok * 8 + h] = ss;
}
__global__ __launch_bounds__(256) void k_gmlp_naive(Ptrs P, const float* __restrict__ v_norm, const float* __restrict__ b_sp) {
    __shared__ bf16_t vgs[128][130];
    __shared__ float rs[128];
    __shared__ float part[128][2];
    const int g = blockIdx.x & 3, bc = blockIdx.x >> 2, tok0 = bc * 128, tid = threadIdx.x, l = P.l;
    for (int idx = tid; idx < 128 * 128; idx += 256) { const int c = idx >> 7, s = idx & 127; vgs[s][c] = P.b(OFF_VGT)[(size_t)(g * 128 + c) * T + tok0 + s]; }
    __syncthreads();
    if (tid < 128) { float s2 = 0.f; for (int c = 0; c < 128; ++c) { const float v = bf2f(vgs[tid][c]); s2 += v * v; } rs[tid] = rsqrtf(s2 * (1.0f / 128.0f) + EPS); }
    __syncthreads();
    const int c = tid & 127, th = tid >> 7;
    const float gain = v_norm[(size_t)l * AW + g * 128 + c];
    const bf16_t* W = P.b(OFF_WS + l * SZ_WS) + (size_t)g * CHUNK * CHUNK;
    for (int t = th * 64; t < th * 64 + 64; ++t) {
        float acc = 0.f;
        for (int s = 0; s <= t; ++s) acc += bf2f(W[t * 128 + s]) * rs[s] * bf2f(vgs[s][c]);
        const float mixed = gain * acc + b_sp[(size_t)l * AG * CHUNK + g * CHUNK + t];
        const float y = bf2f(P.b(OFF_U)[(size_t)(tok0 + t) * 512 + g * 128 + c]) * mixed;
        const bf16_t yb = f2bf(y); P.b(OFF_Y)[(size_t)(tok0 + t) * DM + g * 128 + c] = yb;
        const float yf = bf2f(yb); const float sq = wave_sum(yf * yf);
        if ((tid & 63) == 0) part[t][(tid >> 6) & 1] = sq;
    }
    __syncthreads();
    if (tid < 128) P.f(OFF_SSA)[(size_t)(tok0 + tid) * 4 + g] = part[tid][0] + part[tid][1];
}
__global__ __launch_bounds__(256) void k_xattn_naive(Ptrs P) {
    __shared__ float qs[16][256];
    __shared__ float pp[16][256];
    const int h = blockIdx.x & 3, tok0 = (blockIdx.x >> 2) * 16, b = tok0 / SEQ, tid = threadIdx.x, l = P.l;
    for (int i = 0; i < 16; ++i) qs[i][tid] = bf2f(P.b(OFF_QX)[(size_t)(tok0 + i) * DM + h * 256 + tid]);
    __syncthreads();
    {
        const bf16_t* kr = P.b(OFF_KX) + ((size_t)l * MT + b * MEML + tid) * DM + h * 256;
        float s[16];
#pragma unroll
        for (int i = 0; i < 16; ++i) s[i] = 0.f;
        for (int d = 0; d < 256; d += 8) {
            const bf16x8 kv = *(const bf16x8*)(kr + d);
#pragma unroll
            for (int j = 0; j < 8; ++j) { const float kf = bf2f((bf16_t)kv[j]);
#pragma unroll
                for (int i = 0; i < 16; ++i) s[i] += qs[i][d + j] * kf; }
        }
#pragma unroll
        for (int i = 0; i < 16; ++i) pp[i][tid] = s[i];
    }
    __syncthreads();
    {
        const int wave = tid >> 6, lane = tid & 63;
        for (int i = wave * 4; i < wave * 4 + 4; ++i) {
            float v[4]; float m = -INFINITY;
#pragma unroll
            for (int j = 0; j < 4; ++j) { v[j] = pp[i][lane + 64 * j]; m = fmaxf(m, v[j]); }
            m = wave_max(m); float sum = 0.f;
#pragma unroll
            for (int j = 0; j < 4; ++j) { v[j] = exp2f(v[j] - m); sum += v[j]; }
            sum = wave_sum(sum); const float inv = 1.0f / sum;
#pragma unroll
            for (int j = 0; j < 4; ++j) pp[i][lane + 64 * j] = v[j] * inv;
        }
    }
    __syncthreads();
    {
        const bf16_t* vr = P.b(OFF_VXT) + ((size_t)l * DM + h * 256 + tid) * MT + b * MEML;
        float o[16];
#pragma unroll
        for (int i = 0; i < 16; ++i) o[i] = 0.f;
        for (int m = 0; m < 256; m += 8) {
            const bf16x8 vv = *(const bf16x8*)(vr + m);
#pragma unroll
            for (int j = 0; j < 8; ++j) { const float vf = bf2f((bf16_t)vv[j]);
#pragma unroll
                for (int i = 0; i < 16; ++i) o[i] += pp[i][m + j] * vf; }
        }
#pragma unroll
        for (int i = 0; i < 16; ++i) P.b(OFF_OX)[(size_t)(tok0 + i) * DM + h * 256 + tid] = f2bf(o[i]);
    }
}
__global__ __launch_bounds__(256) void k_router_naive(Ptrs P, const float* __restrict__ b_group, const float* __restrict__ b_router) {
    __shared__ float lg[4][64];
    const int tid = threadIdx.x, w = tid >> 6, n = tid & 63, tok = blockIdx.x * 4 + w, l = P.l;
    if (n < 36) {
        const bf16_t* xr = P.b(OFF_XB) + (size_t)tok * DM; const bf16_t* wr = P.b(OFF_WR + l * SZ_WR) + (size_t)n * DM;
        float dot = 0.f;
        for (int k = 0; k < DM; k += 8) { const bf16x8 a = *(const bf16x8*)(xr + k), bb = *(const bf16x8*)(wr + k);
#pragma unroll
            for (int j = 0; j < 8; ++j) dot += bf2f((bf16_t)a[j]) * bf2f((bf16_t)bb[j]); }
        lg[w][n] = dot * rs4(P.f(OFF_SSX), tok) + (n < 32 ? b_router[l * NE + n] : b_group[l * NG + (n - 32)]);
    }
    __syncthreads();
    if (n == 0) {
        int gs = 0; float gm = lg[w][32];
        for (int i = 1; i < 4; ++i) if (lg[w][32 + i] > gm) { gm = lg[w][32 + i]; gs = i; }
        float den = 0.f; for (int i = 0; i < 4; ++i) den += __expf(lg[w][32 + i] - gm);
        const float pg = 1.0f / den;
        int i1 = 0; float v1 = lg[w][gs * 8];
        for (int i = 1; i < 8; ++i) if (lg[w][gs * 8 + i] > v1) { v1 = lg[w][gs * 8 + i]; i1 = i; }
        int i2 = -1; float v2 = -INFINITY;
        for (int i = 0; i < 8; ++i) if (i != i1 && lg[w][gs * 8 + i] > v2) { v2 = lg[w][gs * 8 + i]; i2 = i; }
        const float w1 = 1.0f / (1.0f + __expf(v2 - v1)), w2 = 1.0f - w1;
        const int e1 = gs * 8 + i1, e2 = gs * 8 + i2;
        int* cnt = P.i(OFF_CTL) + CW_CNT + l * 64;
        const int p1 = atomicAdd(cnt + e1, 1), p2 = atomicAdd(cnt + 32 + e2, 1);
        P.i(OFF_PERM)[(size_t)e1 * T + p1] = tok; P.i(OFF_PERM)[(size_t)(32 + e2) * T + p2] = tok;
        P.f(OFF_GATE)[(size_t)tok * 2] = pg * w1; P.f(OFF_GATE)[(size_t)tok * 2 + 1] = pg * w2;
    }
}
__global__ __launch_bounds__(256) void k_final(Ptrs P, const float* __restrict__ norm_final) {
    const int row = blockIdx.x * 4 + (threadIdx.x >> 6), lane = threadIdx.x & 63;
    const float rs = rs4(P.f(OFF_SSX), row);
#pragma unroll
    for (int j = 0; j < 4; ++j) {
        const f32x4 v = *(const f32x4*)(P.f(OFF_XF) + (size_t)row * DM + j * 256 + lane * 4), g = *(const f32x4*)(norm_final + j * 256 + lane * 4);
        *(f32x4*)(P.out + (size_t)row * DM + j * 256 + lane * 4) = v * rs * g;
    }
}


#define LAS __attribute__((address_space(3)))
#define GAS __attribute__((address_space(1)))
constexpr int NWAVES = 8;
constexpr int RING_BYTES = 131072;
constexpr int L_MISC = RING_BYTES;
constexpr int L_SC = RING_BYTES + 1024;
constexpr int L_ROWST = RING_BYTES + 2048;
constexpr int L_TOKL = RING_BYTES + 4096;
constexpr int L_SEG = RING_BYTES + 8192;
constexpr int LDS_BYTES = RING_BYTES + 12288;
constexpr int CW_BAR = 4096;

#define XB_TMO      128
#define XB_XCNT(j)  (256  + 64 * (j))
#define XB_XSUB(j)  (1280 + 64 * (j))
#define XB_XGEN(j)  (2304 + 64 * (j))
#define XB_TOP      3328
#define XB_TOPGEN   3392
#define XCD_BAR_WORDS 3456
#define XB_SPIN_CAP (1u << 18)
__device__ __forceinline__ unsigned xb_ld(unsigned* p)              { return __hip_atomic_load(p, __ATOMIC_RELAXED, __HIP_MEMORY_SCOPE_AGENT); }
__device__ __forceinline__ unsigned xb_add(unsigned* p, unsigned v) { return __hip_atomic_fetch_add(p, v, __ATOMIC_RELAXED, __HIP_MEMORY_SCOPE_AGENT); }
__device__ __forceinline__ unsigned xb_xcc_id() { return (unsigned)__builtin_amdgcn_s_getreg((3 << 11) | 20) & 0xFu; }
#define XB_SPIN(cond, bar) do { unsigned _sp = 0; while (cond) { __builtin_amdgcn_s_sleep(1); \
    if ((++_sp & 255u) == 0u) { if (xb_ld(&(bar)[XB_TMO])) break; if (_sp > XB_SPIN_CAP) { atomicAdd(&(bar)[XB_TMO], 1u); break; } } } } while (0)
struct XcdBarrier { unsigned* bar; unsigned x; volatile LAS unsigned* st; };
__device__ __forceinline__ XcdBarrier xcd_barrier_post(unsigned* bar, volatile LAS unsigned* st) {
    XcdBarrier b; b.bar = bar; b.x = xb_xcc_id(); b.st = st;
    if (threadIdx.x == 0) (void)xb_add(&bar[XB_XCNT(b.x)], 1u);
    return b;
}
__device__ __forceinline__ void xcd_barrier_complete(unsigned* bar, unsigned x, unsigned& nloc, unsigned& nx) {
    const unsigned G = gridDim.x * gridDim.y * gridDim.z;
    unsigned sum, cnt, mine, sp = 0u;
    for (;;) {
        sum = 0u; cnt = 0u; mine = 0u;
#pragma unroll
        for (unsigned j = 0; j < 16; ++j) { const unsigned c = xb_ld(&bar[XB_XCNT(j)]); sum += c; cnt += (c > 0u) ? 1u : 0u; mine = (j == x) ? c : mine; }
        if (sum == G) break;
        __builtin_amdgcn_s_sleep(1);
        if ((++sp & 255u) == 0u) { if (xb_ld(&bar[XB_TMO])) break; if (sp > XB_SPIN_CAP) { atomicAdd(&bar[XB_TMO], 1u); break; } }
    }
    nloc = mine > 0u ? mine : 1u; nx = cnt > 0u ? cnt : 1u;
}
__device__ __forceinline__ void xcd_barrier(const XcdBarrier& b) {
    asm volatile("s_waitcnt vmcnt(0)" ::: "memory");
    __syncthreads();
    if (threadIdx.x == 0) {
        unsigned* bar = b.bar;
        __builtin_amdgcn_s_waitcnt(0);
        unsigned nloc = b.st[0], nx = b.st[1];
        if (nloc == 0u) { xcd_barrier_complete(bar, b.x, nloc, nx); b.st[0] = nloc; b.st[1] = nx; }
        const unsigned old = xb_add(&bar[XB_XSUB(b.x)], 1u);
        const unsigned gen = old / nloc;
        if (old + 1u == (gen + 1u) * nloc) {
            __builtin_amdgcn_fence(__ATOMIC_RELEASE, "agent");
            asm volatile("s_waitcnt vmcnt(0)" ::: "memory");
            const unsigned og = xb_add(&bar[XB_TOP], 1u);
            const unsigned tg = og / nx;
            if (og + 1u == (tg + 1u) * nx) xb_add(&bar[XB_TOPGEN], 1u);
            else XB_SPIN(xb_ld(&bar[XB_TOPGEN]) == tg, bar);
            __builtin_amdgcn_fence(__ATOMIC_ACQUIRE, "agent");
            xb_add(&bar[XB_XGEN(b.x)], 1u);
            asm volatile("s_waitcnt vmcnt(0)" ::: "memory");
        } else {
            XB_SPIN(xb_ld(&bar[XB_XGEN(b.x)]) == gen, bar);
            __builtin_amdgcn_fence(__ATOMIC_ACQUIRE, "agent");
            asm volatile("s_waitcnt vmcnt(0)" ::: "memory");
        }
    }
    __syncthreads();
}

namespace g8 {
constexpr int BM = 256, BK = 64, HALF = 128, HTB = HALF * BK * 2, STAGE_BYTES = 8 * HTB;
__host__ __device__ __forceinline__ int lds_byte(int r, int c) { const int st = (r >> 4) * 2 + (c >> 5), rr = r & 15, cc = c & 31, ob = rr * 64 + cc * 2; return st * 1024 + (ob ^ (((ob >> 9) & 1) << 5)); }
__host__ __device__ __forceinline__ void stage_rc(int b, int& R, int& C) { const int st = b / 1024, sb = b % 1024, swz = sb ^ (((sb >> 9) & 1) << 5); R = (st >> 1) * 16 + swz / 64; C = (st & 1) * 32 + (swz % 64) / 2; }
enum Kind { K_IN = 0, K_INT, K_MEMK, K_MEMVT, K_OUT, K_XQ, K_XO, K_MOE1, K_MOE2A, K_MOE2B };
struct Unit { const GAS char* A; const GAS char* B; int q0, p0, kind, a0, a1, a2, slot; };

template <bool GATHER, class Sched, class Epi>
__device__ __forceinline__ void gemm_phase(LAS unsigned char* lds, const int K, const Sched& S, const Epi& E, const int tid) {
    const int wid = __builtin_amdgcn_readfirstlane(tid >> 6), lane = tid & 63, wr = wid >> 2, wc = wid & 3, fr = lane & 15, fq = lane >> 4;
    const int nt = K / BK;
    int sR[2], sC[2]; unsigned voff[2];
#pragma unroll
    for (int i = 0; i < 2; ++i) { int R, C; stage_rc(tid * 16 + i * 8192, R, C); sR[i] = R; sC[i] = C; voff[i] = (unsigned)(R * K + C) * 2u; }
    const size_t kstep = (size_t)(BK * 2);
    const size_t hstep = (size_t)HALF * K * 2;
    const unsigned ldsw = (unsigned)wid * 1024u;
    const int aoff = lds_byte(wr * 64 + fr, fq * 8), boff = lds_byte(wc * 32 + fr, fq * 8);
#define G8_SA(b, h) (((b) * 2 + (h)) * HTB)
#define G8_SB(b, h) ((4 + (b) * 2 + (h)) * HTB)
#define G8_STAGE(bufoff, gbase, vo0, vo1) do { \
        __builtin_amdgcn_global_load_lds((const GAS unsigned*)((const GAS char*)(gbase) + (vo0)), (LAS unsigned*)(lds + (bufoff) + ldsw), 16, 0, 0); \
        __builtin_amdgcn_global_load_lds((const GAS unsigned*)((const GAS char*)(gbase) + (vo1)), (LAS unsigned*)(lds + (bufoff) + ldsw + 8192), 16, 0, 0); } while (0)
#define G8_STA(bufoff, base, h, g0, g1) do { if (GATHER) { G8_STAGE(bufoff, base, g0, g1); } else { G8_STAGE(bufoff, (base) + (h) * hstep, voff[0], voff[1]); } } while (0)
#define G8_STB(bufoff, base) G8_STAGE(bufoff, base, voff[0], voff[1])
#define G8_LDA(dst, b, h) do { _Pragma("unroll") for (int m = 0; m < 4; ++m) _Pragma("unroll") for (int k = 0; k < 2; ++k) dst[m][k] = *(const LAS bf16x8*)(lds + G8_SA(b, h) + aoff + m * 2048 + k * 1024); } while (0)
#define G8_LDB(dst, b, h) do { _Pragma("unroll") for (int n = 0; n < 2; ++n) _Pragma("unroll") for (int k = 0; k < 2; ++k) dst[n][k] = *(const LAS bf16x8*)(lds + G8_SB(b, h) + boff + n * 2048 + k * 1024); } while (0)
#define G8_MMA(ai, bj, At, Bt) do { __builtin_amdgcn_s_setprio(1); _Pragma("unroll") for (int m = 0; m < 4; ++m) _Pragma("unroll") for (int n = 0; n < 2; ++n) _Pragma("unroll") for (int k = 0; k < 2; ++k) \
        acc[ai][bj][m][n] = __builtin_amdgcn_mfma_f32_16x16x32_bf16(Bt[n][k], At[m][k], acc[ai][bj][m][n], 0, 0, 0); __builtin_amdgcn_s_setprio(0); } while (0)
#define G8_WAIT_V(n) asm volatile("s_waitcnt vmcnt(" #n ")" ::: "memory")
#define G8_WAIT_L(n) asm volatile("s_waitcnt lgkmcnt(" #n ")" ::: "memory")
#define G8_BAR __builtin_amdgcn_s_barrier()
#define G8_SCHED __builtin_amdgcn_sched_barrier(0)
    Unit cur, nxt; int ui = 0;
    if (!S.next(0, cur)) return;
    f32x4 acc[2][2][4][2];
#pragma unroll
    for (int a = 0; a < 2; ++a)
#pragma unroll
        for (int b = 0; b < 2; ++b)
#pragma unroll
            for (int m = 0; m < 4; ++m)
#pragma unroll
                for (int n = 0; n < 2; ++n) acc[a][b][m][n] = (f32x4){0.f, 0.f, 0.f, 0.f};
    bf16x8 At[4][2], B0[2][2], B1[2][2];
    const GAS char* cA = cur.A; const GAS char* cB = cur.B;
    unsigned g00 = 0, g01 = 0, g10 = 0, g11 = 0;
    if (GATHER) { const LAS int* tl = E.tokl(cur.slot); g00 = (unsigned)tl[sR[0]] * (unsigned)(K * 2) + sC[0] * 2; g01 = (unsigned)tl[sR[1]] * (unsigned)(K * 2) + sC[1] * 2;
                  g10 = (unsigned)tl[sR[0] + 128] * (unsigned)(K * 2) + sC[0] * 2; g11 = (unsigned)tl[sR[1] + 128] * (unsigned)(K * 2) + sC[1] * 2; G8_WAIT_L(0); }
    G8_STB(G8_SB(0, 0), cB); G8_STB(G8_SB(0, 1), cB + hstep); G8_STA(G8_SA(0, 0), cA, 0, g00, g01); G8_STA(G8_SA(0, 1), cA, 1, g10, g11);
    if (wr == 1) G8_BAR;
    G8_WAIT_V(2); G8_BAR;
    G8_STB(G8_SB(1, 0), cB + kstep); G8_STA(G8_SA(1, 0), cA + kstep, 0, g00, g01); G8_STB(G8_SB(1, 1), cB + hstep + kstep);
    G8_WAIT_V(6); G8_BAR;
    for (;;) {
        const bool has_next = S.next(ui + 1, nxt);
        const GAS char* nA = has_next ? nxt.A : cA; const GAS char* nB = has_next ? nxt.B : cB;
        for (int t = 0; t < nt; t += 2) {
            const bool last = (t == nt - 2);
            if (Epi::MIDK) { if (t == nt / 2) E.midk(acc, cur, wr, fr); }
            const GAS char* a1 = cA + (size_t)(t + 1) * kstep;
            const GAS char* a2 = last ? nA : cA + (size_t)(t + 2) * kstep; const GAS char* b2 = last ? nB : cB + (size_t)(t + 2) * kstep;
            const GAS char* a3 = a2 + kstep; const GAS char* b3 = b2 + kstep;
            G8_LDB(B0, 0, 0); G8_LDB(B1, 0, 1); G8_SCHED; G8_LDA(At, 0, 0); G8_STA(G8_SA(1, 1), a1, 1, g10, g11);
            if (GATHER) { if (last && has_next) { const LAS int* tl = E.tokl(nxt.slot); g00 = (unsigned)tl[sR[0]] * (unsigned)(K * 2) + sC[0] * 2; g01 = (unsigned)tl[sR[1]] * (unsigned)(K * 2) + sC[1] * 2;
                  g10 = (unsigned)tl[sR[0] + 128] * (unsigned)(K * 2) + sC[0] * 2; g11 = (unsigned)tl[sR[1] + 128] * (unsigned)(K * 2) + sC[1] * 2; } }
            G8_WAIT_V(8); G8_WAIT_L(0); G8_BAR; G8_MMA(0, 0, At, B0); G8_MMA(0, 1, At, B1); G8_BAR; G8_SCHED;
            G8_LDA(At, 0, 1); G8_STB(G8_SB(0, 0), b2); G8_STB(G8_SB(0, 1), b2 + hstep); G8_STA(G8_SA(0, 0), a2, 0, g00, g01);
            G8_WAIT_V(8); G8_WAIT_L(0); G8_BAR; G8_MMA(1, 0, At, B0); G8_MMA(1, 1, At, B1); G8_BAR; G8_SCHED;
            G8_LDB(B0, 1, 0); G8_LDB(B1, 1, 1); G8_SCHED; G8_LDA(At, 1, 0); G8_STA(G8_SA(0, 1), a2, 1, g10, g11);
            G8_WAIT_V(8); G8_WAIT_L(0); G8_BAR; G8_MMA(0, 0, At, B0); G8_MMA(0, 1, At, B1); G8_BAR; G8_SCHED;
            G8_LDA(At, 1, 1); G8_STB(G8_SB(1, 0), b3); G8_STB(G8_SB(1, 1), b3 + hstep); G8_STA(G8_SA(1, 0), a3, 0, g00, g01);
            G8_WAIT_V(8); G8_WAIT_L(0); G8_BAR; G8_MMA(1, 0, At, B0); G8_MMA(1, 1, At, B1); G8_BAR; G8_SCHED;
        }
        if (wr == 0) G8_BAR;
        E(acc, cur, wid, wr, wc, fr, fq, tid);
        if (!has_next) break;
#pragma unroll
        for (int a = 0; a < 2; ++a)
#pragma unroll
            for (int b = 0; b < 2; ++b)
#pragma unroll
                for (int m = 0; m < 4; ++m)
#pragma unroll
                    for (int n = 0; n < 2; ++n) acc[a][b][m][n] = (f32x4){0.f, 0.f, 0.f, 0.f};
        cur = nxt; cA = nA; cB = nB; ++ui;
        if (wr == 1) G8_BAR;
    }
    G8_WAIT_V(0);
    G8_BAR;
#undef G8_SA
#undef G8_SB
#undef G8_STAGE
#undef G8_STA
#undef G8_STB
#undef G8_LDA
#undef G8_LDB
#undef G8_MMA
#undef G8_WAIT_V
#undef G8_WAIT_L
#undef G8_BAR
#undef G8_SCHED
}
}

struct MArgs { const float* in[25]; float* out; unsigned char* ws; int ph_lo, ph_hi, li, pad; };
typedef GAS bf16_t gbf; typedef GAS float gfl; typedef GAS int gint;
struct GP {
    GAS unsigned char* ws; const gfl* x_in; gfl* out; int l;
    __device__ __forceinline__ gbf* b(size_t off) const { return (gbf*)(ws + off); }
    __device__ __forceinline__ gfl* f(size_t off) const { return (gfl*)(ws + off); }
    __device__ __forceinline__ gint* i(size_t off) const { return (gint*)(ws + off); }
};
struct Frame {
    LAS unsigned char* lds; GP P; int tid, lane, wave, vcu, G;
};
__device__ __forceinline__ void gst4bf(gbf* p, f32x4 v) { u32x2 w; w.x = pk2(v[0], v[1]); w.y = pk2(v[2], v[3]); *(GAS u32x2*)p = w; }
__device__ __forceinline__ float gresid_store(const GP& P, const gfl* res, int tok, int col, f32x4 add) {
    const unsigned o = (unsigned)tok * DM + col;
    const f32x4 r = *(const GAS f32x4*)(res + o);
    const f32x4 xn = r + add;
    *(GAS f32x4*)(P.f(OFF_XF) + o) = xn;
    gst4bf(P.b(OFF_XB) + o, xn);
    return (xn[0] * xn[0] + xn[1] * xn[1]) + (xn[2] * xn[2] + xn[3] * xn[3]);
}
__device__ __forceinline__ int xcd_remap(int L, int nwg) { const int q = nwg / 8, r = nwg % 8, x = L % 8, off = L / 8; return (x < r ? x * (q + 1) : r * (q + 1) + (x - r) * q) + off; }
__device__ __forceinline__ float rsum16(const gfl* ss, int row) { const GAS f32x4* p = (const GAS f32x4*)(ss + (unsigned)row * 16); const f32x4 a = p[0], b = p[1], c = p[2], d = p[3];
    return ((((a[0] + a[1]) + (a[2] + a[3])) + ((b[0] + b[1]) + (b[2] + b[3]))) + (((c[0] + c[1]) + (c[2] + c[3])) + ((d[0] + d[1]) + (d[2] + d[3])))); }

struct DenseSched {
    GP P; int type, G, c;
    __device__ __forceinline__ bool next(int i, g8::Unit& u) const {
        const int L = i * G + c; const int l = P.l;
        u.a0 = 0; u.a1 = 0; u.a2 = 0; u.slot = 0;
        if (type == 1) {
            const int nwg = (l == 0) ? 768 : 640; if (L >= nwg) return false;
            const int w = xcd_remap(L, nwg);
            if (w < 384) { const int gid = w / 48, r = w % 48, pm = gid * 8 + (r % 8), pn = r / 8;
                u.kind = g8::K_IN; u.q0 = pm * 256; u.p0 = pn * 256; u.A = (const GAS char*)(P.b(OFF_XB) + (size_t)u.q0 * DM); u.B = (const GAS char*)(P.b(OFF_WIN + l * SZ_WIN) + (size_t)u.p0 * DM); }
            else if (w < 640) { const int v = w - 384, ch = v % 4, tk = v / 4;
                u.kind = g8::K_INT; u.q0 = ch * 256; u.p0 = tk * 256; u.A = (const GAS char*)(P.b(OFF_WIN + l * SZ_WIN) + (size_t)(1536 + u.q0) * DM); u.B = (const GAS char*)(P.b(OFF_XB) + (size_t)u.p0 * DM); }
            else { const int v = w - 640, ll = v / 32, r = v % 32; u.a0 = ll;
                if (r < 16) { u.kind = g8::K_MEMK; u.q0 = (r % 4) * 256; u.p0 = (r / 4) * 256; u.A = (const GAS char*)(P.b(OFF_MB) + (size_t)u.q0 * DM); u.B = (const GAS char*)(P.b(OFF_WXK + ll * SZ_SQ) + (size_t)u.p0 * DM); }
                else { const int r2 = r - 16; u.kind = g8::K_MEMVT; u.q0 = (r2 % 4) * 256; u.p0 = (r2 / 4) * 256; u.A = (const GAS char*)(P.b(OFF_WXV + ll * SZ_SQ) + (size_t)u.q0 * DM); u.B = (const GAS char*)(P.b(OFF_MB) + (size_t)u.p0 * DM); } }
            return true;
        }
        if (L >= 256) return false;
        const int w = xcd_remap(L, 256), gid = w / 32, r = w % 32, pm = gid * 8 + (r % 8), pn = r / 8;
        u.q0 = pm * 256; u.p0 = pn * 256;
        if (type == 3) { u.kind = g8::K_OUT; u.A = (const GAS char*)(P.b(OFF_Y) + (size_t)u.q0 * DM); u.B = (const GAS char*)(P.b(OFF_WOUT + l * SZ_SQ) + (size_t)u.p0 * DM); }
        else if (type == 4) { u.kind = g8::K_XQ; u.A = (const GAS char*)(P.b(OFF_XB) + (size_t)u.q0 * DM); u.B = (const GAS char*)(P.b(OFF_WXQ + l * SZ_SQ) + (size_t)u.p0 * DM); }
        else { u.kind = g8::K_XO; u.A = (const GAS char*)(P.b(OFF_OX) + (size_t)u.q0 * DM); u.B = (const GAS char*)(P.b(OFF_WXO + l * SZ_SQ) + (size_t)u.p0 * DM); }
        return true;
    }
};
struct MoeSched {
    GP P; int type, G, c, sg_lo, sg_hi; const LAS int* seg;
    __device__ __forceinline__ bool decode(int i, int& sg, int& qt, int& pt) const {
        const int ntile = seg[128 + sg_hi], nwg = ntile * 4, L = i * G + c; if (L >= nwg) return false;
        const int w = xcd_remap(L, nwg);
        int s = sg_lo; while (s + 1 < sg_hi && seg[128 + s + 1] * 4 <= w) ++s;
        const int nts = seg[128 + s + 1] - seg[128 + s], r = w - seg[128 + s] * 4; sg = s; pt = r / nts; qt = r % nts; return true;
    }
    __device__ __forceinline__ bool next(int i, g8::Unit& u) const {
        int sg, qt, pt; if (!decode(i, sg, qt, pt)) return false;
        const int l = P.l, e = sg & 31;
        u.a0 = sg; u.a1 = seg[sg] - qt * 256; u.a2 = seg[64 + sg] + qt * 256; u.slot = i; u.q0 = qt * 256; u.p0 = pt * 256;
        if (type == 8) { u.kind = g8::K_MOE1; u.A = (const GAS char*)P.b(OFF_XB); u.B = (const GAS char*)(P.b(OFF_W13 + ((size_t)l * NE + e) * SZ_W13) + (size_t)u.p0 * DM); }
        else { u.kind = (type == 9) ? g8::K_MOE2A : g8::K_MOE2B; u.A = (const GAS char*)(P.b(OFF_ACT) + (size_t)u.a2 * DE); u.B = (const GAS char*)(P.b(OFF_W2 + ((size_t)l * NE + e) * SZ_W2) + (size_t)u.p0 * DE); }
        return true;
    }
};

template <bool MIDK_, unsigned KSET> struct Epi {
    static constexpr bool MIDK = MIDK_;
    GP P; LAS unsigned char* lds;
    __device__ __forceinline__ const LAS int* tokl(int slot) const { return (const LAS int*)(lds + L_TOKL) + (slot & 3) * 256; }
    __device__ __forceinline__ void midk(f32x4 (&acc)[2][2][4][2], const g8::Unit&, int wr, int fr) const {
        const LAS float* rst = (const LAS float*)(lds + L_ROWST);
#pragma unroll
        for (int ai = 0; ai < 2; ++ai)
#pragma unroll
            for (int m = 0; m < 4; ++m) { const float ratio = rst[2 * (ai * 128 + wr * 64 + m * 16 + fr)];
#pragma unroll
                for (int bj = 0; bj < 2; ++bj)
#pragma unroll
                    for (int n = 0; n < 2; ++n) acc[ai][bj][m][n] = acc[ai][bj][m][n] * ratio; }
    }
    __device__ __forceinline__ void operator()(f32x4 (&acc)[2][2][4][2], const g8::Unit& u, int wid, int wr, int wc, int fr, int fq, int tid) const {
        asm volatile("" : "+v"(fr), "+v"(fq), "+v"(tid));
        LAS float* sc = (LAS float*)(lds + L_SC);
        const int kind = u.kind;
        if (tid < 256) {
            float s = 1.f;
            if (kind == g8::K_IN || kind == g8::K_XQ) s = rsqrtf(rsum16(P.f(OFF_SSX), u.q0 + tid) * (1.0f / 1024.0f) + EPS);
            else if (kind == g8::K_INT) s = rsqrtf(rsum16(P.f(OFF_SSX), u.p0 + tid) * (1.0f / 1024.0f) + EPS);
            else if (kind == g8::K_MEMK) s = rsqrtf(P.f(OFF_SSM)[u.q0 + tid] * (1.0f / 1024.0f) + EPS);
            else if (kind == g8::K_MEMVT) s = rsqrtf(P.f(OFF_SSM)[u.p0 + tid] * (1.0f / 1024.0f) + EPS);
            else if (kind == g8::K_MOE1) s = rsqrtf(rsum16(P.f(OFF_SSX), tokl(u.slot)[tid]) * (1.0f / 1024.0f) + EPS);
            else if (kind == g8::K_MOE2A || kind == g8::K_MOE2B) s = P.f(OFF_GATE)[(unsigned)tokl(u.slot)[tid] * 2 + (kind == g8::K_MOE2B ? 1 : 0)];
            sc[tid] = s;
        }
        asm volatile("s_waitcnt vmcnt(0) lgkmcnt(0)" ::: "memory"); __builtin_amdgcn_s_barrier(); asm volatile("" ::: "memory");
#define EPI_CASE(K) if ((KSET >> (K)) & 1u) { if (kind == (K)) { apply<(K)>(acc, u, wr, wc, fr, fq); return; } }
        EPI_CASE(g8::K_IN) EPI_CASE(g8::K_INT) EPI_CASE(g8::K_MEMK) EPI_CASE(g8::K_MEMVT) EPI_CASE(g8::K_OUT) EPI_CASE(g8::K_XQ) EPI_CASE(g8::K_XO) EPI_CASE(g8::K_MOE1) EPI_CASE(g8::K_MOE2A) EPI_CASE(g8::K_MOE2B)
#undef EPI_CASE
    }
    template <int KIND> __device__ __forceinline__ void apply(f32x4 (&acc)[2][2][4][2], const g8::Unit& u, int wr, int wc, int fr, int fq) const {
        const LAS float* sc = (const LAS float*)(lds + L_SC);
        const int cb = wc * 32 + 4 * fq;
        gbf* dst = nullptr; unsigned pitch = 0; bool act = false;
        if constexpr (KIND == g8::K_IN) { const int pt = u.p0 >> 9; dst = (pt == 0 ? P.b(OFF_U) : pt == 1 ? P.b(OFF_Q) : P.b(OFF_K)) + (size_t)u.q0 * 512 + (u.p0 & 511); pitch = 512; act = (pt == 0); }
        else if constexpr (KIND == g8::K_INT) { act = u.q0 < 512; dst = (act ? P.b(OFF_VGT) : P.b(OFF_VBT)) + (size_t)(u.q0 & 511) * T + u.p0; pitch = T; }
        else if constexpr (KIND == g8::K_MEMK) { dst = P.b(OFF_KX) + ((size_t)u.a0 * MT + u.q0) * DM + u.p0; pitch = DM; }
        else if constexpr (KIND == g8::K_MEMVT) { dst = P.b(OFF_VXT) + ((size_t)u.a0 * DM + u.q0) * MT + u.p0; pitch = MT; }
        else if constexpr (KIND == g8::K_XQ) { dst = P.b(OFF_QX) + (size_t)u.q0 * DM + u.p0; pitch = DM; }
        else if constexpr (KIND == g8::K_MOE1) { dst = P.b(OFF_ACT) + (size_t)u.a2 * DE + (u.p0 >> 8) * 128; pitch = DE; }
        const gfl* res = P.f(OFF_XF); if constexpr (KIND == g8::K_OUT) { if (P.l == 0) res = P.x_in; }
#pragma unroll
        for (int ai = 0; ai < 2; ++ai)
#pragma unroll
            for (int m = 0; m < 4; ++m) {
                const int r = ai * 128 + wr * 64 + m * 16 + fr, q = u.q0 + r;
                float ss = 0.f;
                float rowsc = 1.f; if constexpr (KIND == g8::K_IN || KIND == g8::K_MEMK || KIND == g8::K_XQ || KIND == g8::K_MOE1 || KIND == g8::K_MOE2A || KIND == g8::K_MOE2B) rowsc = sc[r];
                if constexpr (KIND == g8::K_OUT) rowsc = ((const LAS float*)(lds + L_ROWST))[2 * r + 1];
                int tok = q; bool rowok = true;
                if constexpr (KIND == g8::K_MOE2A || KIND == g8::K_MOE2B) { rowok = r < u.a1; tok = tokl(u.slot)[r]; }
#pragma unroll
                for (int bj = 0; bj < 2; ++bj)
#pragma unroll
                    for (int n = 0; n < 2; ++n) {
                        const int c = cb + bj * 128 + n * 16;
                        f32x4 v = acc[ai][bj][m][n];
                        if constexpr (KIND == g8::K_IN || KIND == g8::K_MEMK || KIND == g8::K_XQ) { v = v * rowsc;
                            if (KIND == g8::K_IN && act) { v[0] = gelu_tanh(v[0]); v[1] = gelu_tanh(v[1]); v[2] = gelu_tanh(v[2]); v[3] = gelu_tanh(v[3]); }
                            gst4bf(dst + ((unsigned)r * pitch + c), v);
                        } else if constexpr (KIND == g8::K_INT || KIND == g8::K_MEMVT) { const f32x4 s4 = *(const LAS f32x4*)(sc + c); v = v * s4;
                            if (KIND == g8::K_INT && act) { v[0] = gelu_tanh(v[0]); v[1] = gelu_tanh(v[1]); v[2] = gelu_tanh(v[2]); v[3] = gelu_tanh(v[3]); }
                            gst4bf(dst + ((unsigned)r * pitch + c), v);
                        } else if constexpr (KIND == g8::K_OUT || KIND == g8::K_XO) { ss += gresid_store(P, res, q, u.p0 + c, v * rowsc);
                        } else if constexpr (KIND == g8::K_MOE1) {
                            if (bj == 0) { const f32x4 a = v, b = acc[ai][1][m][n]; f32x4 o;
                                o[0] = silu(a[0] * rowsc) * (b[0] * rowsc); o[1] = silu(a[1] * rowsc) * (b[1] * rowsc); o[2] = silu(a[2] * rowsc) * (b[2] * rowsc); o[3] = silu(a[3] * rowsc) * (b[3] * rowsc);
                                gst4bf(dst + ((unsigned)r * pitch + c), o); }
                        } else {
                            if (rowok) { v = v * rowsc;
                                if constexpr (KIND == g8::K_MOE2A) { gfl* xp = P.f(OFF_XF) + ((unsigned)tok * DM + u.p0 + c); *(GAS f32x4*)xp = *(const GAS f32x4*)xp + v; }
                                else ss += gresid_store(P, res, tok, u.p0 + c, v); }
                        }
                    }
                if constexpr (KIND == g8::K_OUT || KIND == g8::K_XO || KIND == g8::K_MOE2B) {
                    ss += __shfl_xor(ss, 16); ss += __shfl_xor(ss, 32);
                    if (fq == 0 && rowok) P.f(OFF_SSX)[(unsigned)tok * 16 + (u.p0 >> 8) * 4 + wc] = ss;
                }
                asm volatile("" ::: "memory");
            }
    }
};

__device__ __forceinline__ bf16x8 pack8(float a0, float a1, float a2, float a3, float a4, float a5, float a6, float a7) {
    u32x4 w; w.x = pk2(a0, a1); w.y = pk2(a2, a3); w.z = pk2(a4, a5); w.w = pk2(a6, a7); return __builtin_bit_cast(bf16x8, w);
}
__device__ __forceinline__ void attn_wave_unit(const GP& P, int b, int hh, int qblk, LAS unsigned char* stg, int lane) {
    const int c = lane & 31, hi = lane >> 5, t0 = qblk * 32;
    const int pic = (c & ~12) | ((c & 4) << 1) | ((c & 8) >> 1);
    const gbf* Qp = P.b(OFF_Q) + ((size_t)b * SEQ + t0 + c) * 512 + hh * 64 + 8 * hi;
    bf16x8 qf[4];
#pragma unroll
    for (int s = 0; s < 4; ++s) qf[s] = *(const GAS bf16x8*)(Qp + 16 * s);
    const gbf* Kb = P.b(OFF_K) + ((size_t)b * SEQ + pic) * 512 + hh * 64 + 8 * hi;
    const gbf* Vb = P.b(OFF_VBT) + ((size_t)hh * 64 + c) * T + (size_t)b * SEQ + 8 * hi;
    f32x16 o0, o1;
#pragma unroll
    for (int r = 0; r < 16; ++r) { o0[r] = 0.f; o1[r] = 0.f; }
    float R = 0.f;
    for (int key0 = t0; key0 >= 0; key0 -= 32) {
        bf16x8 kf[4];
#pragma unroll
        for (int s = 0; s < 4; ++s) kf[s] = *(const GAS bf16x8*)(Kb + (size_t)key0 * 512 + 16 * s);
        bf16x8 vf[2][2];
#pragma unroll
        for (int s = 0; s < 2; ++s)
#pragma unroll
            for (int d = 0; d < 2; ++d) vf[s][d] = *(const GAS bf16x8*)(Vb + (size_t)d * 32 * T + key0 + 16 * s);
        f32x16 x;
#pragma unroll
        for (int r = 0; r < 16; ++r) x[r] = 0.f;
#pragma unroll
        for (int s = 0; s < 4; ++s) x = MFMA32(kf[s], qf[s], x);
        const bool diag = (key0 == t0);
        float sp[16];
#pragma unroll
        for (int r = 0; r < 16; ++r) {
            const int krel = 16 * (r >> 3) + 8 * hi + (r & 7);
            const bool ok = !diag || (krel < c);
            const float u = x[r], s = softplus2(u);
            sp[r] = ok ? s : 0.f; x[r] = ok ? (u - s) : -INFINITY;
        }
        float sA = 0.f, sB = 0.f;
#pragma unroll
        for (int r = 7; r >= 0; --r) { const float t = sp[r]; sp[r] = sA; sA += t; }
#pragma unroll
        for (int r = 15; r >= 8; --r) { const float t = sp[r]; sp[r] = sB; sB += t; }
        const float sAp = __shfl_xor(sA, 32), sBp = __shfl_xor(sB, 32);
        const float baseA = R + ((hi ? 0.f : sAp) + sB + sBp), baseB = R + (hi ? 0.f : sBp);
        float a[16];
#pragma unroll
        for (int r = 0; r < 8; ++r) a[r] = exp2f(x[r] - (baseA + sp[r]));
#pragma unroll
        for (int r = 8; r < 16; ++r) a[r] = exp2f(x[r] - (baseB + sp[r]));
        R += (sA + sAp) + (sB + sBp);
        const bf16x8 pa0 = pack8(a[0], a[1], a[2], a[3], a[4], a[5], a[6], a[7]), pa1 = pack8(a[8], a[9], a[10], a[11], a[12], a[13], a[14], a[15]);
        o0 = MFMA32(pa0, vf[0][0], o0); o1 = MFMA32(pa0, vf[0][1], o1);
        o0 = MFMA32(pa1, vf[1][0], o0); o1 = MFMA32(pa1, vf[1][1], o1);
        if (__all(R > RSTOP)) break;
    }
    LAS bf16_t* st = (LAS bf16_t*)stg;
#pragma unroll
    for (int r = 0; r < 16; ++r) { const int row = (r & 3) + 8 * (r >> 2) + 4 * hi; st[row * 64 + c] = f2bf(o0[r]); st[row * 64 + 32 + c] = f2bf(o1[r]); }
    asm volatile("s_waitcnt lgkmcnt(0)" ::: "memory");
#pragma unroll
    for (int i = 0; i < 4; ++i) {
        const int row = i * 8 + (lane >> 3), ch = lane & 7; const u32x4 v = *(const LAS u32x4*)(st + row * 64 + ch * 8);
        const size_t tok = (size_t)b * SEQ + t0 + row;
        *(GAS u32x4*)(P.b(OFF_Y) + tok * DM + 512 + hh * 64 + ch * 8) = v;
        float ss = 0.f;
#pragma unroll
        for (int j = 0; j < 4; ++j) { const float lo = __uint_as_float(v[j] << 16), hi2 = __uint_as_float(v[j] & 0xffff0000u); ss += lo * lo + hi2 * hi2; }
        ss += __shfl_xor(ss, 1); ss += __shfl_xor(ss, 2); ss += __shfl_xor(ss, 4);
        if (ch == 0) P.f(OFF_SSB)[tok * 8 + hh] = ss;
    }
    asm volatile("s_waitcnt lgkmcnt(0)" ::: "memory");
}
__device__ __forceinline__ void gmlp_wave_unit(const GP& P, const gfl* v_norm, const gfl* b_sp, int bc, int g, int tblk, LAS unsigned char* stg, int lane) {
    const int c = lane & 31, hi = lane >> 5, tok0 = bc * 128, l = P.l;
    const gbf* Wp = P.b(OFF_WS + l * SZ_WS) + ((size_t)g * CHUNK + tblk * 32 + c) * CHUNK + 8 * hi;
    const gbf* Vp = P.b(OFF_VGT) + ((size_t)g * 128 + c) * T + tok0 + 8 * hi;
    f32x16 acc[4];
#pragma unroll
    for (int cb = 0; cb < 4; ++cb)
#pragma unroll
        for (int r = 0; r < 16; ++r) acc[cb][r] = 0.f;
    const int nks = 2 * (tblk + 1);
    for (int ks = 0; ks < nks; ++ks) {
        bf16x8 vf[4];
#pragma unroll
        for (int cb = 0; cb < 4; ++cb) vf[cb] = *(const GAS bf16x8*)(Vp + (size_t)cb * 32 * T + 16 * ks);
        const bf16x8 wf = *(const GAS bf16x8*)(Wp + 16 * ks);
        float ssq[8];
#pragma unroll
        for (int j = 0; j < 8; ++j) { ssq[j] = 0.f;
#pragma unroll
            for (int cb = 0; cb < 4; ++cb) { const float f = bf2f((bf16_t)vf[cb][j]); ssq[j] += f * f; } }
#pragma unroll
        for (int j = 0; j < 8; ++j) { ssq[j] += __shfl_xor(ssq[j], 1); ssq[j] += __shfl_xor(ssq[j], 2); ssq[j] += __shfl_xor(ssq[j], 4); ssq[j] += __shfl_xor(ssq[j], 8); ssq[j] += __shfl_xor(ssq[j], 16); }
        float w[8];
#pragma unroll
        for (int j = 0; j < 8; ++j) w[j] = bf2f((bf16_t)wf[j]) * rsqrtf(ssq[j] * (1.0f / 128.0f) + EPS);
        const bf16x8 ws = pack8(w[0], w[1], w[2], w[3], w[4], w[5], w[6], w[7]);
#pragma unroll
        for (int cb = 0; cb < 4; ++cb) acc[cb] = MFMA32(ws, vf[cb], acc[cb]);
    }
    LAS float* st = (LAS float*)stg;
    const int row = lane >> 1, half = lane & 1, t = tblk * 32 + row;
    const float bt = b_sp[(size_t)l * AG * CHUNK + g * CHUNK + t];
    float ss = 0.f;
#pragma unroll
    for (int cb = 0; cb < 4; ++cb) {
        const float gain = v_norm[(size_t)l * AW + g * 128 + cb * 32 + c];
#pragma unroll
        for (int r = 0; r < 16; ++r) st[((r & 3) + 8 * (r >> 2) + 4 * hi) * 36 + c] = gain * acc[cb][r];
        asm volatile("s_waitcnt lgkmcnt(0)" ::: "memory");
        const size_t tok = (size_t)tok0 + t; const int col = g * 128 + cb * 32 + half * 16;
        const u32x4 u0 = *(const GAS u32x4*)(P.b(OFF_U) + tok * 512 + col), u1 = *(const GAS u32x4*)(P.b(OFF_U) + tok * 512 + col + 8);
        float mx[16];
#pragma unroll
        for (int j = 0; j < 4; ++j) { const f32x4 mv = *(const LAS f32x4*)(st + row * 36 + half * 16 + 4 * j); mx[4 * j] = mv[0] + bt; mx[4 * j + 1] = mv[1] + bt; mx[4 * j + 2] = mv[2] + bt; mx[4 * j + 3] = mv[3] + bt; }
        asm volatile("s_waitcnt lgkmcnt(0)" ::: "memory");
        u32x4 y0, y1;
#pragma unroll
        for (int j = 0; j < 4; ++j) {
            const float ua = __uint_as_float(u0[j] << 16), ub = __uint_as_float(u0[j] & 0xffff0000u), uc = __uint_as_float(u1[j] << 16), ud = __uint_as_float(u1[j] & 0xffff0000u);
            const unsigned w0 = pk2(ua * mx[2 * j], ub * mx[2 * j + 1]), w1 = pk2(uc * mx[8 + 2 * j], ud * mx[8 + 2 * j + 1]);
            y0[j] = w0; y1[j] = w1;
            const float f0 = __uint_as_float(w0 << 16), f1 = __uint_as_float(w0 & 0xffff0000u), f2 = __uint_as_float(w1 << 16), f3 = __uint_as_float(w1 & 0xffff0000u);
            ss += (f0 * f0 + f1 * f1) + (f2 * f2 + f3 * f3);
        }
        *(GAS u32x4*)(P.b(OFF_Y) + tok * DM + col) = y0; *(GAS u32x4*)(P.b(OFF_Y) + tok * DM + col + 8) = y1;
    }
    ss += __shfl_xor(ss, 1);
    if (half == 0) P.f(OFF_SSA)[((size_t)tok0 + t) * 4 + g] = ss;
}
__device__ __forceinline__ void xattn_wave_unit(const GP& P, int tokblk, int hh, LAS unsigned char* stg, int lane) {
    const int c = lane & 31, hi = lane >> 5, tok0 = tokblk * 32, b = tok0 / SEQ, l = P.l;
    const int pic = (c & ~12) | ((c & 4) << 1) | ((c & 8) >> 1);
    const gbf* Qp = P.b(OFF_QX) + ((size_t)tok0 + c) * DM + hh * 256 + 8 * hi;
    const gbf* Kp = P.b(OFF_KX) + ((size_t)l * MT + b * MEML + pic) * DM + hh * 256 + 8 * hi;
    f32x16 x[8];
#pragma unroll
    for (int mb = 0; mb < 8; ++mb)
#pragma unroll
        for (int r = 0; r < 16; ++r) x[mb][r] = 0.f;
#pragma unroll 2
    for (int s = 0; s < 16; ++s) {
        const bf16x8 qf = *(const GAS bf16x8*)(Qp + 16 * s);
#pragma unroll
        for (int mb = 0; mb < 8; ++mb) { const bf16x8 kf = *(const GAS bf16x8*)(Kp + (size_t)mb * 32 * DM + 16 * s); x[mb] = MFMA32(kf, qf, x[mb]); }
    }
    float m = -INFINITY;
#pragma unroll
    for (int mb = 0; mb < 8; ++mb)
#pragma unroll
        for (int r = 0; r < 16; ++r) m = fmaxf(m, x[mb][r]);
    m = fmaxf(m, __shfl_xor(m, 32));
    float sum = 0.f;
#pragma unroll
    for (int mb = 0; mb < 8; ++mb)
#pragma unroll
        for (int r = 0; r < 16; ++r) { x[mb][r] = exp2f(x[mb][r] - m); sum += x[mb][r]; }
    sum += __shfl_xor(sum, 32);
    const float inv = 1.0f / sum;
    bf16x8 pa[8][2];
#pragma unroll
    for (int mb = 0; mb < 8; ++mb)
#pragma unroll
        for (int s = 0; s < 2; ++s)
            pa[mb][s] = pack8(x[mb][8 * s] * inv, x[mb][8 * s + 1] * inv, x[mb][8 * s + 2] * inv, x[mb][8 * s + 3] * inv, x[mb][8 * s + 4] * inv, x[mb][8 * s + 5] * inv, x[mb][8 * s + 6] * inv, x[mb][8 * s + 7] * inv);
    const gbf* Vp = P.b(OFF_VXT) + ((size_t)l * DM + hh * 256 + c) * MT + b * MEML + 8 * hi;
    LAS bf16_t* st = (LAS bf16_t*)stg;
#pragma unroll 1
    for (int dp = 0; dp < 4; ++dp) {
        f32x16 o0, o1;
#pragma unroll
        for (int r = 0; r < 16; ++r) { o0[r] = 0.f; o1[r] = 0.f; }
#pragma unroll
        for (int mb = 0; mb < 8; ++mb)
#pragma unroll
            for (int s = 0; s < 2; ++s) {
                const bf16x8 v0 = *(const GAS bf16x8*)(Vp + (size_t)(2 * dp) * 32 * MT + 32 * mb + 16 * s), v1 = *(const GAS bf16x8*)(Vp + (size_t)(2 * dp + 1) * 32 * MT + 32 * mb + 16 * s);
                o0 = MFMA32(pa[mb][s], v0, o0); o1 = MFMA32(pa[mb][s], v1, o1);
            }
#pragma unroll
        for (int r = 0; r < 16; ++r) { const int row = (r & 3) + 8 * (r >> 2) + 4 * hi; st[row * 64 + c] = f2bf(o0[r]); st[row * 64 + 32 + c] = f2bf(o1[r]); }
        asm volatile("s_waitcnt lgkmcnt(0)" ::: "memory");
#pragma unroll
        for (int i = 0; i < 4; ++i) { const int row = i * 8 + (lane >> 3), ch = lane & 7; const u32x4 v = *(const LAS u32x4*)(st + row * 64 + ch * 8);
            *(GAS u32x4*)(P.b(OFF_OX) + ((size_t)tok0 + row) * DM + hh * 256 + dp * 64 + ch * 8) = v; }
        asm volatile("s_waitcnt lgkmcnt(0)" ::: "memory");
    }
}
__device__ __forceinline__ void router_wave_unit(const GP& P, const gfl* b_group, const gfl* b_router, int tokblk, LAS unsigned char* stg, int lane) {
    const int c = lane & 31, hi = lane >> 5, tok0 = tokblk * 32, l = P.l;
    const gbf* Xp = P.b(OFF_XB) + ((size_t)tok0 + c) * DM + 8 * hi;
    const gbf* Wp = P.b(OFF_WR + l * SZ_WR) + (size_t)c * DM + 8 * hi;
    f32x16 d0, d1;
#pragma unroll
    for (int r = 0; r < 16; ++r) { d0[r] = 0.f; d1[r] = 0.f; }
#pragma unroll 4
    for (int s = 0; s < 64; ++s) {
        const bf16x8 a = *(const GAS bf16x8*)(Xp + 16 * s), w0 = *(const GAS bf16x8*)(Wp + 16 * s), w1 = *(const GAS bf16x8*)(Wp + (size_t)32 * DM + 16 * s);
        d0 = MFMA32(a, w0, d0); d1 = MFMA32(a, w1, d1);
    }
    LAS float* st = (LAS float*)stg;
#pragma unroll
    for (int r = 0; r < 16; ++r) { const int row = (r & 3) + 8 * (r >> 2) + 4 * hi; st[row * 40 + c] = d0[r]; if (c < 4) st[row * 40 + 32 + c] = d1[r]; }
    asm volatile("s_waitcnt lgkmcnt(0)" ::: "memory");
    if (lane < 32) {
        const int tok = tok0 + lane; const float rs = rsqrtf(rsum16(P.f(OFF_SSX), tok) * (1.0f / 1024.0f) + EPS);
        float gl[4];
#pragma unroll
        for (int i = 0; i < 4; ++i) gl[i] = st[lane * 40 + 32 + i] * rs + b_group[l * NG + i];
        int gs = 0; float gm = gl[0];
#pragma unroll
        for (int i = 1; i < 4; ++i) if (gl[i] > gm) { gm = gl[i]; gs = i; }
        float den = 0.f;
#pragma unroll
        for (int i = 0; i < 4; ++i) den += __expf(gl[i] - gm);
        const float pg = 1.0f / den;
        float v1 = -INFINITY, v2 = -INFINITY; int i1 = 0, i2 = 0;
#pragma unroll
        for (int i = 0; i < 8; ++i) { const float e = st[lane * 40 + gs * 8 + i] * rs + b_router[l * NE + gs * 8 + i];
            if (e > v1) { v2 = v1; i2 = i1; v1 = e; i1 = i; } else if (e > v2) { v2 = e; i2 = i; } }
        const float w1 = 1.0f / (1.0f + __expf(v2 - v1)), w2 = 1.0f - w1;
        const int e1 = gs * 8 + i1, e2 = gs * 8 + i2;
        int* cnt = (int*)(P.i(OFF_CTL) + CW_CNT + l * 64);
        const int p1 = atomicAdd(cnt + e1, 1), p2 = atomicAdd(cnt + 32 + e2, 1);
        P.i(OFF_PERM)[(size_t)e1 * T + p1] = tok; P.i(OFF_PERM)[(size_t)(32 + e2) * T + p2] = tok;
        P.f(OFF_GATE)[(size_t)tok * 2] = pg * w1; P.f(OFF_GATE)[(size_t)tok * 2 + 1] = pg * w2;
    }
    asm volatile("s_waitcnt lgkmcnt(0)" ::: "memory");
}

__device__ __forceinline__ void transpose_item(bool active, const gfl* s, gbf* d, const gfl* g1, const gfl* g2, int ksplit, float scale, int K, int src_ld, int kt, int nt, int G, int GS, int GO, LAS float* tile, int t256) {
    const int tx = t256 & 63, ty = t256 >> 6;
    if (active) {
#pragma unroll 4
        for (int i = 0; i < 16; ++i) { const int k = ty + 4 * i; tile[k * 65 + tx] = s[(size_t)(kt * 64 + k) * src_ld + nt * 64 + tx]; }
    }
    __syncthreads();
    if (active) {
        const int kx = t256 & 31, ny = t256 >> 5, k0 = kt * 64 + 2 * kx;
        float ga = scale, gb = scale;
        if (g1) { ga *= (k0 < ksplit) ? g1[k0] : g2[k0 - ksplit]; gb *= (k0 + 1 < ksplit) ? g1[k0 + 1] : g2[k0 + 1 - ksplit]; }
#pragma unroll
        for (int i = 0; i < 8; ++i) { const int n = ny + 8 * i, ng = nt * 64 + n, drow = (ng / G) * GS + GO + (ng % G);
            *(GAS unsigned*)(d + (size_t)drow * K + k0) = pk2(tile[(2 * kx) * 65 + n] * ga, tile[(2 * kx + 1) * 65 + n] * gb); }
    }
    __syncthreads();
}
constexpr int TI_PER_LAYER = 640 + 256 + 1024 + 3 * 4096;
__device__ __forceinline__ void prologue_phase(const Frame& F, const MArgs& a) {
    const gfl* x = (const gfl*)a.in[0]; const gfl* mem = (const gfl*)a.in[1]; const gfl* norm_mix = (const gfl*)a.in[2]; const gfl* w_in = (const gfl*)a.in[3]; const gfl* w_sp = (const gfl*)a.in[5];
    const gfl* on_a = (const gfl*)a.in[7]; const gfl* on_b = (const gfl*)a.in[8]; const gfl* w_out = (const gfl*)a.in[9]; const gfl* norm_cross = (const gfl*)a.in[10]; const gfl* norm_mem = (const gfl*)a.in[11];
    const gfl* w_xq = (const gfl*)a.in[12]; const gfl* w_xk = (const gfl*)a.in[13]; const gfl* w_xv = (const gfl*)a.in[14]; const gfl* w_xo = (const gfl*)a.in[15]; const gfl* norm_moe = (const gfl*)a.in[16];
    const gfl* w_group = (const gfl*)a.in[17]; const gfl* w_router = (const gfl*)a.in[19]; const gfl* w1 = (const gfl*)a.in[21]; const gfl* w3 = (const gfl*)a.in[22]; const gfl* w2 = (const gfl*)a.in[23];
    const GP& P = F.P; const int half = F.tid >> 8, t256 = F.tid & 255;
    LAS float* tile = (LAS float*)(F.lds) + half * (64 * 65 + 64);
    const int HG = 1 << 30, NIT = NL * TI_PER_LAYER;
    for (int base = F.vcu * 2; base < NIT; base += F.G * 2) {
        const int it = base + half; const bool act = it < NIT;
        const int l = act ? it / TI_PER_LAYER : 0; int r = act ? it % TI_PER_LAYER : 0;
        const gfl* s; gbf* d; const gfl* g1 = nullptr; const gfl* g2 = nullptr; int ksplit = DM, K = DM, src_ld, kt, nt, G = HG, GS = 0, GO = 0; float scale = 1.f;
        if (r < 640) { const int grp = r / 128, q = r % 128; kt = q / 8; nt = q % 8; src_ld = INW; g1 = norm_mix + l * DM; g2 = g1;
            s = w_in + (size_t)l * DM * INW + grp * 512; d = P.b(OFF_WIN + l * SZ_WIN);
            GO = (grp == 0) ? 0 : (grp == 1) ? 1536 : (grp == 2) ? 512 : (grp == 3) ? 1024 : 2048; if (grp == 2) scale = QSCALE; }
        else if (r < 896) { const int q = r - 640; kt = q / 16; nt = q % 16; src_ld = DM; s = w_out + (size_t)l * DM * DM; d = P.b(OFF_WOUT + l * SZ_SQ); g1 = on_a + l * 512; g2 = on_b + l * 512; ksplit = 512; }
        else if (r < 1920) { const int m = (r - 896) / 256, q = (r - 896) % 256; kt = q / 16; nt = q % 16; src_ld = DM;
            if (m == 0) { s = w_xq + (size_t)l * DM * DM; d = P.b(OFF_WXQ + l * SZ_SQ); g1 = norm_cross + l * DM; scale = XSCALE; }
            else if (m == 1) { s = w_xk + (size_t)l * DM * DM; d = P.b(OFF_WXK + l * SZ_SQ); g1 = norm_mem + l * DM; }
            else if (m == 2) { s = w_xv + (size_t)l * DM * DM; d = P.b(OFF_WXV + l * SZ_SQ); g1 = norm_mem + l * DM; }
            else { s = w_xo + (size_t)l * DM * DM; d = P.b(OFF_WXO + l * SZ_SQ); }
            g2 = g1; }
        else { const int q0 = r - 1920, m = q0 / 4096, e = (q0 % 4096) / 128, q = q0 % 128;
            if (m < 2) { kt = q / 8; nt = q % 8; src_ld = DE; s = (m == 0 ? w1 : w3) + ((size_t)l * NE + e) * DM * DE; d = P.b(OFF_W13 + ((size_t)l * NE + e) * SZ_W13); g1 = norm_moe + l * DM; g2 = g1; G = 128; GS = 256; GO = m * 128; }
            else { K = DE; kt = q / 16; nt = q % 16; src_ld = DM; s = w2 + ((size_t)l * NE + e) * DE * DM; d = P.b(OFF_W2 + ((size_t)l * NE + e) * SZ_W2); } }
        transpose_item(act, s, d, g1, g2, ksplit, scale, K, src_ld, kt, nt, G, GS, GO, tile, t256);
    }
    const int gt = F.vcu * 512 + F.tid, NT_ = F.G * 512;
    for (int idx = gt; idx < NL * 64 * DM; idx += NT_) { const int k = idx % DM, n = (idx / DM) % 64, l = idx / (64 * DM); float v = 0.f;
        if (n < 32) v = w_router[((size_t)l * DM + k) * NE + n]; else if (n < 36) v = w_group[((size_t)l * DM + k) * NG + (n - 32)];
        P.b(OFF_WR)[idx] = f2bf(v * norm_moe[l * DM + k]); }
    for (int idx = gt; idx < NL * AG * CHUNK * CHUNK; idx += NT_) { const int s_ = idx % CHUNK, t_ = (idx / CHUNK) % CHUNK; P.b(OFF_WS)[idx] = (s_ <= t_) ? f2bf(w_sp[idx]) : (bf16_t)0; }
    const int gw = F.vcu * 8 + F.wave, NW_ = F.G * 8, lane = F.lane;
    for (int row = gw; row < T + MT; row += NW_) {
        const bool ism = row >= T; const int rr = ism ? row - T : row; const gfl* src = ism ? mem : x; gbf* dst = ism ? P.b(OFF_MB) : P.b(OFF_XB); float tot = 0.f;
#pragma unroll
        for (int j = 0; j < 4; ++j) {
            const f32x4 v = *(const GAS f32x4*)(src + (size_t)rr * DM + j * 256 + lane * 4);
            u32x2 w; w.x = pk2(v[0], v[1]); w.y = pk2(v[2], v[3]); *(GAS u32x2*)(dst + (size_t)rr * DM + j * 256 + lane * 4) = w;
            float s = (v[0] * v[0] + v[1] * v[1]) + (v[2] * v[2] + v[3] * v[3]);
            s += __shfl_xor(s, 1); s += __shfl_xor(s, 2); s += __shfl_xor(s, 4); s += __shfl_xor(s, 8);
            if (!ism && (lane & 15) == 0) P.f(OFF_SSX)[(size_t)rr * 16 + j * 4 + (lane >> 4)] = s;
            s += __shfl_xor(s, 16); s += __shfl_xor(s, 32); tot += s;
        }
        if (ism && lane == 0) P.f(OFF_SSM)[rr] = tot;
    }
}

constexpr int N_PHASES = 42;
#ifndef CT_MASK
#define CT_MASK 0xFFF
#endif
#define CT(t) (((CT_MASK) >> (t)) & 1)
__global__ void __launch_bounds__(NWAVES * 64, 2) mega(MArgs a) {
    extern __shared__ __attribute__((aligned(16))) unsigned char lds_raw[];
    Frame F; F.lds = (LAS unsigned char*)lds_raw;
    F.tid = threadIdx.x; F.lane = F.tid & 63; F.wave = __builtin_amdgcn_readfirstlane(F.tid >> 6);
    F.G = gridDim.x; { const int bx = blockIdx.x; F.vcu = (F.G % 8 == 0) ? (bx % 8) * (F.G / 8) + bx / 8 : bx; }
    F.P.ws = (GAS unsigned char*)a.ws; F.P.x_in = nullptr; F.P.out = nullptr; F.P.l = 0;
    volatile LAS unsigned* MISC = (volatile LAS unsigned*)(F.lds + L_MISC);
    if (F.tid < 64) MISC[F.tid] = 0u;
    __syncthreads();
    XcdBarrier bar = xcd_barrier_post((unsigned*)(a.ws + OFF_CTL) + CW_BAR + a.li * XCD_BAR_WORDS, MISC + 8);
    for (int ph = a.ph_lo; ph < a.ph_hi; ++ph) {
        { int t_ = threadIdx.x; asm volatile("" : "+v"(t_)); F.tid = t_; F.lane = t_ & 63; F.wave = __builtin_amdgcn_readfirstlane(t_ >> 6); }
        LAS unsigned char* wstg = F.lds + F.wave * 8192;
        typedef const __attribute__((address_space(4))) MArgs* cargs_t; cargs_t ap = (cargs_t)__builtin_amdgcn_kernarg_segment_ptr(); asm volatile("" : "+s"(ap));
        F.P.ws = (GAS unsigned char*)ap->ws; F.P.x_in = (const gfl*)ap->in[0]; F.P.out = (gfl*)ap->out;
        if (ph == 0) { if (CT(0)) { MArgs la; for (int i_ = 0; i_ < 25; ++i_) la.in[i_] = ap->in[i_]; prologue_phase(F, la); } }
        else if (ph == N_PHASES - 1) { if (CT(11)) {
            const int gw = F.vcu * 8 + F.wave, NW_ = F.G * 8, lane = F.lane; const GP& P = F.P;
            for (int row = gw; row < T; row += NW_) { const float rs = rsqrtf(rsum16(P.f(OFF_SSX), row) * (1.0f / 1024.0f) + EPS);
#pragma unroll
                for (int j = 0; j < 4; ++j) { const f32x4 v = *(const GAS f32x4*)(P.f(OFF_XF) + (size_t)row * DM + j * 256 + lane * 4), g = *(const GAS f32x4*)((const gfl*)ap->in[24] + j * 256 + lane * 4);
                    *(GAS f32x4*)(P.out + (size_t)row * DM + j * 256 + lane * 4) = v * rs * g; } } }
        } else {
            const int l = (ph - 1) / 10, j = (ph - 1) % 10; F.P.l = l; const GP P = F.P;
            if (CT(1) && (j == 0 || j == 3 || j == 5)) {
                DenseSched S{P, j == 0 ? 1 : (j == 3 ? 4 : 6), F.G, (int)blockIdx.x}; Epi<false, 0x6Fu> E{P, F.lds};
                g8::gemm_phase<false>(F.lds, DM, S, E, F.tid);
            } else if (CT(3) && j == 2) {
                DenseSched S{P, 3, F.G, (int)blockIdx.x}; Epi<true, 0x10u> E{P, F.lds};
                g8::Unit u0;
                if (S.next(0, u0) && F.tid < 256) {
                    const int q = u0.q0 + F.tid; const f32x4 va = *(const GAS f32x4*)(P.f(OFF_SSA) + (size_t)q * 4), v0 = *(const GAS f32x4*)(P.f(OFF_SSB) + (size_t)q * 8), v1 = *(const GAS f32x4*)(P.f(OFF_SSB) + (size_t)q * 8 + 4);
                    const float ra = rsqrtf(((va[0] + va[1]) + (va[2] + va[3])) * (1.0f / 512.0f) + EPS), rb = rsqrtf((((v0[0] + v0[1]) + (v0[2] + v0[3])) + ((v1[0] + v1[1]) + (v1[2] + v1[3]))) * (1.0f / 512.0f) + EPS);
                    LAS float* rst = (LAS float*)(F.lds + L_ROWST); rst[2 * F.tid] = ra / rb; rst[2 * F.tid + 1] = rb;
                }
                __syncthreads();
                g8::gemm_phase<false>(F.lds, DM, S, E, F.tid);
            } else if (CT(2) && j == 1) {
                const int bh = F.vcu >> 3, sub = F.vcu & 7;
                if (F.G == 256) {
                    for (int k = 0; k < 2; ++k) attn_wave_unit(P, bh >> 3, bh & 7, sub * 16 + F.wave * 2 + k, wstg, F.lane);
                    const int gu = F.vcu * 8 + F.wave;
                    gmlp_wave_unit(P, (const gfl*)ap->in[4], (const gfl*)ap->in[6], gu >> 4, (gu >> 2) & 3, gu & 3, wstg, F.lane);
                } else {
                    for (int uu = F.vcu * 8 + F.wave; uu < 4096; uu += F.G * 8) attn_wave_unit(P, uu >> 10, (uu >> 7) & 7, uu & 127, wstg, F.lane);
                    for (int gu = F.vcu * 8 + F.wave; gu < 2048; gu += F.G * 8) gmlp_wave_unit(P, (const gfl*)ap->in[4], (const gfl*)ap->in[6], gu >> 4, (gu >> 2) & 3, gu & 3, wstg, F.lane);
                }
            } else if (CT(5) && j == 4) {
                for (int uu = F.vcu * 8 + F.wave; uu < 2048; uu += F.G * 8) xattn_wave_unit(P, (uu >> 5) * 8 + (uu & 7), (uu >> 3) & 3, wstg, F.lane);
            } else if (CT(7) && j == 6) {
                if (F.wave < 2) for (int uu = F.vcu * 2 + F.wave; uu < 512; uu += F.G * 2) router_wave_unit(P, (const gfl*)ap->in[18], (const gfl*)ap->in[20], uu, wstg, F.lane);
            } else if (CT(8) && j >= 7) {
                LAS int* seg = (LAS int*)(F.lds + L_SEG);
                const int sg_lo = (j == 9) ? 32 : 0, sg_hi = (j == 8) ? 32 : 64;
                const gint* cnt = P.i(OFF_CTL) + CW_CNT + l * 64;
                if (F.tid < 64) seg[F.tid] = cnt[F.tid];
                __syncthreads();
                if (F.tid == 0) { int rb = 0, tb = 0;
                    for (int s = 0; s < 64; ++s) { seg[64 + s] = rb; rb += (seg[s] + 255) & ~255; }
                    for (int s = sg_lo; s < sg_hi; ++s) { seg[128 + s] = tb; tb += (seg[s] + 255) >> 8; }
                    seg[128 + sg_hi] = tb; }
                __syncthreads();
                MoeSched S{P, j == 7 ? 8 : (j == 8 ? 9 : 10), F.G, (int)blockIdx.x, sg_lo, sg_hi, seg};
                LAS int* tl = (LAS int*)(F.lds + L_TOKL);
                for (int i = 0; i < 4; ++i) { int sg, qt, pt; if (!S.decode(i, sg, qt, pt)) break;
                    if (F.tid < 256) { const int n = seg[sg], r = qt * 256 + F.tid; tl[i * 256 + F.tid] = P.i(OFF_PERM)[(size_t)sg * T + (r < n ? r : n - 1)]; } }
                __syncthreads();
                if (j == 7) { Epi<false, 0x80u> E{P, F.lds}; g8::gemm_phase<true>(F.lds, DM, S, E, F.tid); }
                else { Epi<false, 0x300u> E{P, F.lds}; g8::gemm_phase<false>(F.lds, DE, S, E, F.tid); }
            }
        }
        if (ph + 1 < a.ph_hi) xcd_barrier(bar);
    }
}

#ifndef FAST_MASK
#define FAST_MASK 0xFFF
#endif
extern "C" void kernel_launch(void* const* d_in, const int* in_sizes, int n_in, void* d_out, int out_size, void* d_ws, size_t ws_size, hipStream_t stream) {
    if (n_in != 25 || ws_size < WS_NEED || out_size != T * DM) { fprintf(stderr, "kernel_launch: unexpected shapes (n_in %d, ws %zu need %zu, out %d)\n", n_in, ws_size, (size_t)WS_NEED, out_size); return; }
    static int grid = 0;
    if (grid == 0) {
        int dev = 0, cus = 0;
        if (hipGetDevice(&dev) != hipSuccess || hipDeviceGetAttribute(&cus, hipDeviceAttributeMultiprocessorCount, dev) != hipSuccess) cus = 0;
        if (hipFuncSetAttribute((const void*)mega, hipFuncAttributeMaxDynamicSharedMemorySize, LDS_BYTES) != hipSuccess) cus = 0;
        (void)hipGetLastError();
        grid = (cus == 256) ? 256 : -1;
        if (grid < 0) fprintf(stderr, "kernel_launch: the persistent kernel needs a 256-CU device (got %d); using the per-stage kernels\n", cus);
    }
    const unsigned fast = (grid > 0) ? (unsigned)FAST_MASK : 0u;
    const float* x = (const float*)d_in[0]; const float* mem = (const float*)d_in[1]; const float* norm_mix = (const float*)d_in[2]; const float* w_in = (const float*)d_in[3];
    const float* v_norm = (const float*)d_in[4]; const float* w_sp = (const float*)d_in[5]; const float* b_sp = (const float*)d_in[6]; const float* on_a = (const float*)d_in[7];
    const float* on_b = (const float*)d_in[8]; const float* w_out = (const float*)d_in[9]; const float* norm_cross = (const float*)d_in[10]; const float* norm_mem = (const float*)d_in[11];
    const float* w_xq = (const float*)d_in[12]; const float* w_xk = (const float*)d_in[13]; const float* w_xv = (const float*)d_in[14]; const float* w_xo = (const float*)d_in[15];
    const float* norm_moe = (const float*)d_in[16]; const float* w_group = (const float*)d_in[17]; const float* b_group = (const float*)d_in[18]; const float* w_router = (const float*)d_in[19];
    const float* b_router = (const float*)d_in[20]; const float* w1 = (const float*)d_in[21]; const float* w3 = (const float*)d_in[22]; const float* w2 = (const float*)d_in[23]; const float* norm_final = (const float*)d_in[24];
    unsigned char* ws = (unsigned char*)d_ws;
    (void)hipMemsetAsync(ws + OFF_CTL, 0, 1 * MiB, stream);
    auto B = [&](size_t off) { return (bf16_t*)(ws + off); };
    Ptrs P; P.ws = ws; P.x_in = x; P.out = (float*)d_out; P.l = 0;
    MArgs a{}; for (int i = 0; i < 25; ++i) a.in[i] = (const float*)d_in[i]; a.out = (float*)d_out; a.ws = ws;
    int pend_lo = -1, n_mega = 0;
    auto flush = [&](int hi) { if (pend_lo < 0) return; a.ph_lo = pend_lo; a.ph_hi = hi; a.li = n_mega++; hipLaunchKernelGGL(mega, dim3(grid), dim3(NWAVES * 64), LDS_BYTES, stream, a); pend_lo = -1; };
    for (int ph = 0; ph < N_PHASES; ++ph) {
        const int type = (ph == 0) ? 0 : (ph == N_PHASES - 1) ? 11 : 1 + (ph - 1) % 10, l = (ph == 0 || ph == N_PHASES - 1) ? 0 : (ph - 1) / 10;
        if ((fast >> type) & 1u) { if (pend_lo < 0) pend_lo = ph; continue; }
        flush(ph);
        P.l = l;
        switch (type) {
        case 0: {
            const int HUGE_G = 1 << 30; const long s_in = (long)DM * INW, d_inw = (long)INW * DM, s_sq = (long)DM * DM;
            k_transpose<<<dim3(16 * 8, 1, NL), 256, 0, stream>>>(w_in + 0, B(OFF_WIN), norm_mix, nullptr, DM, 1.f, DM, 512, INW, 0, s_in, 0, d_inw, DM, HUGE_G, 0, 0);
            k_transpose<<<dim3(16 * 8, 1, NL), 256, 0, stream>>>(w_in + 512, B(OFF_WIN), norm_mix, nullptr, DM, 1.f, DM, 512, INW, 0, s_in, 0, d_inw, DM, HUGE_G, 0, 1536);
            k_transpose<<<dim3(16 * 8, 1, NL), 256, 0, stream>>>(w_in + 1024, B(OFF_WIN), norm_mix, nullptr, DM, QSCALE, DM, 512, INW, 0, s_in, 0, d_inw, DM, HUGE_G, 0, 512);
            k_transpose<<<dim3(16 * 8, 1, NL), 256, 0, stream>>>(w_in + 1536, B(OFF_WIN), norm_mix, nullptr, DM, 1.f, DM, 512, INW, 0, s_in, 0, d_inw, DM, HUGE_G, 0, 1024);
            k_transpose<<<dim3(16 * 8, 1, NL), 256, 0, stream>>>(w_in + 2048, B(OFF_WIN), norm_mix, nullptr, DM, 1.f, DM, 512, INW, 0, s_in, 0, d_inw, DM, HUGE_G, 0, 2048);
            k_transpose<<<dim3(16 * 16, 1, NL), 256, 0, stream>>>(w_out, B(OFF_WOUT), on_a, on_b, 512, 1.f, DM, DM, DM, 0, s_sq, 0, s_sq, 512, HUGE_G, 0, 0);
            k_transpose<<<dim3(16 * 16, 1, NL), 256, 0, stream>>>(w_xq, B(OFF_WXQ), norm_cross, nullptr, DM, XSCALE, DM, DM, DM, 0, s_sq, 0, s_sq, DM, HUGE_G, 0, 0);
            k_transpose<<<dim3(16 * 16, 1, NL), 256, 0, stream>>>(w_xk, B(OFF_WXK), norm_mem, nullptr, DM, 1.f, DM, DM, DM, 0, s_sq, 0, s_sq, DM, HUGE_G, 0, 0);
            k_transpose<<<dim3(16 * 16, 1, NL), 256, 0, stream>>>(w_xv, B(OFF_WXV), norm_mem, nullptr, DM, 1.f, DM, DM, DM, 0, s_sq, 0, s_sq, DM, HUGE_G, 0, 0);
            k_transpose<<<dim3(16 * 16, 1, NL), 256, 0, stream>>>(w_xo, B(OFF_WXO), nullptr, nullptr, DM, 1.f, DM, DM, DM, 0, s_sq, 0, s_sq, DM, HUGE_G, 0, 0);
            k_transpose<<<dim3(16 * 8, NE, NL), 256, 0, stream>>>(w1, B(OFF_W13), norm_moe, nullptr, DM, 1.f, DM, DE, DE, (long)DM * DE, (long)NE * DM * DE, (long)1024 * DM, (long)NE * 1024 * DM, DM, 128, 256, 0);
            k_transpose<<<dim3(16 * 8, NE, NL), 256, 0, stream>>>(w3, B(OFF_W13), norm_moe, nullptr, DM, 1.f, DM, DE, DE, (long)DM * DE, (long)NE * DM * DE, (long)1024 * DM, (long)NE * 1024 * DM, DM, 128, 256, 128);
            k_transpose<<<dim3(8 * 16, NE, NL), 256, 0, stream>>>(w2, B(OFF_W2), nullptr, nullptr, DE, 1.f, DE, DM, DM, (long)DE * DM, (long)NE * DE * DM, (long)DM * DE, (long)NE * DM * DE, DM, HUGE_G, 0, 0);
            k_prep_router<<<NL * 64 * DM / 256, 256, 0, stream>>>(w_router, w_group, norm_moe, B(OFF_WR));
            k_prep_spatial<<<NL * AG * CHUNK * CHUNK / 256, 256, 0, stream>>>(w_sp, B(OFF_WS));
            k_prep_rows<<<T / 4, 256, 0, stream>>>(x, B(OFF_XB), (float*)(ws + OFF_SSX), nullptr, T);
            k_prep_rows<<<MT / 4, 256, 0, stream>>>(mem, B(OFF_MB), nullptr, (float*)(ws + OFF_SSM), MT);
        } break;
        case 1:
            if (l == 0) { k_sgemm<ProbMemK><<<dim3(4 * 16, NL), 256, 0, stream>>>(ProbMemK{P}); k_sgemm<ProbMemVT><<<dim3(4 * 16, NL), 256, 0, stream>>>(ProbMemVT{P}); }
            k_sgemm<ProbIn><<<6 * 256, 256, 0, stream>>>(ProbIn{P}); k_sgemm<ProbInT><<<64 * 16, 256, 0, stream>>>(ProbInT{P}); break;
        case 2: k_attn_naive<<<T * SBH / 256, 256, 0, stream>>>(P); k_gmlp_naive<<<(T / CHUNK) * AG, 256, 0, stream>>>(P, v_norm, b_sp); break;
        case 3: k_sgemm<ProbOut><<<4 * 256, 256, 0, stream>>>(ProbOut{P}); break;
        case 4: k_sgemm<ProbXq><<<4 * 256, 256, 0, stream>>>(ProbXq{P}); break;
        case 5: k_xattn_naive<<<(T / 16) * XH, 256, 0, stream>>>(P); break;
        case 6: k_sgemm<ProbXo><<<4 * 256, 256, 0, stream>>>(ProbXo{P}); break;
        case 7: k_router_naive<<<T / 4, 256, 0, stream>>>(P, b_group, b_router); break;
        case 8: k_sgemm<ProbMoe1><<<4 * (2 * T / 64 + 64), 256, 0, stream>>>(ProbMoe1{P}); break;
        case 9: k_sgemm<ProbMoe2<0>><<<4 * (T / 64 + 32), 256, 0, stream>>>(ProbMoe2<0>{P}); break;
        case 10: k_sgemm<ProbMoe2<1>><<<4 * (T / 64 + 32), 256, 0, stream>>>(ProbMoe2<1>{P}); break;
        default: k_final<<<T / 4, 256, 0, stream>>>(P, norm_final); break;
        }
    }
    flush(N_PHASES);
}
```

```cpp
#include <hip/hip_runtime.h>
#include <stdint.h>
#include <stdio.h>

typedef unsigned short bf16_t;
typedef short bf16x8 __attribute__((ext_vector_type(8)));
typedef float f32x4 __attribute__((ext_vector_type(4)));
typedef float f32x16 __attribute__((ext_vector_type(16)));
typedef unsigned u32x2 __attribute__((ext_vector_type(2)));
typedef unsigned u32x4 __attribute__((ext_vector_type(4)));

constexpr int NB = 4, SEQ = 4096, T = NB * SEQ, DM = 1024, NL = 4;
constexpr int AW = 512, AG = 4, ACH = 128, CHUNK = 128;
constexpr int SBW = 512, SBH = 8, SBD = 64;
constexpr int INW = 2560;
constexpr int MEML = 256, MT = NB * MEML, XH = 4, XD = 256;
constexpr int NG = 4, EPG = 8, NE = 32, DE = 512;
constexpr float EPS = 1e-6f;
constexpr float LOG2E = 1.4426950408889634f;
constexpr float QSCALE = 0.125f * LOG2E;
constexpr float XSCALE = 0.0625f * LOG2E;
constexpr float RSTOP = 104.0f * LOG2E;

constexpr size_t MiB = 1u << 20;
constexpr size_t OFF_CTL = 0;
constexpr size_t OFF_WIN = 1 * MiB;
constexpr size_t SZ_WIN = (size_t)INW * DM * 2;
constexpr size_t OFF_WOUT = OFF_WIN + NL * SZ_WIN;
constexpr size_t SZ_SQ = (size_t)DM * DM * 2;
constexpr size_t OFF_WXQ = OFF_WOUT + NL * SZ_SQ;
constexpr size_t OFF_WXK = OFF_WXQ + NL * SZ_SQ;
constexpr size_t OFF_WXV = OFF_WXK + NL * SZ_SQ;
constexpr size_t OFF_WXO = OFF_WXV + NL * SZ_SQ;
constexpr size_t OFF_WR = OFF_WXO + NL * SZ_SQ;
constexpr size_t SZ_WR = (size_t)64 * DM * 2;
constexpr size_t OFF_WS = OFF_WR + NL * SZ_WR;
constexpr size_t SZ_WS = (size_t)AG * CHUNK * CHUNK * 2;
constexpr size_t OFF_W13 = OFF_WS + NL * SZ_WS;
constexpr size_t SZ_W13 = (size_t)1024 * DM * 2;
constexpr size_t OFF_W2 = OFF_W13 + (size_t)NL * NE * SZ_W13;
constexpr size_t SZ_W2 = (size_t)DM * DE * 2;
constexpr size_t OFF_XF = OFF_W2 + (size_t)NL * NE * SZ_W2;
constexpr size_t OFF_YM = OFF_XF;
constexpr size_t OFF_XB = OFF_XF + (size_t)T * DM * 4;
constexpr size_t OFF_SSX = OFF_XB + (size_t)T * DM * 2;
constexpr size_t OFF_U = OFF_SSX + (size_t)T * 16 * 4;
constexpr size_t SZ_H = (size_t)T * 512 * 2;
constexpr size_t OFF_Q = OFF_U + SZ_H;
constexpr size_t OFF_K = OFF_Q + SZ_H;
constexpr size_t OFF_VGT = OFF_K + SZ_H;
constexpr size_t OFF_VBT = OFF_VGT + SZ_H;
constexpr size_t OFF_Y = OFF_VBT + SZ_H;
constexpr size_t OFF_SSA = OFF_Y + (size_t)T * DM * 2;
constexpr size_t OFF_SSB = OFF_SSA + (size_t)T * 4 * 4;
constexpr size_t OFF_QX = OFF_SSB + (size_t)T * 8 * 4;
constexpr size_t OFF_OX = OFF_QX + (size_t)T * DM * 2;
constexpr size_t OFF_MB = OFF_OX + (size_t)T * DM * 2;
constexpr size_t OFF_SSM = OFF_MB + (size_t)MT * DM * 2;
constexpr size_t OFF_KX = OFF_SSM + (size_t)MT * 4;
constexpr size_t OFF_VXT = OFF_KX + (size_t)NL * MT * DM * 2;
constexpr size_t OFF_GATE = OFF_VXT + (size_t)NL * MT * DM * 2;
constexpr size_t OFF_PERM = OFF_GATE + (size_t)T * 2 * 4;
constexpr int ACT_ROWS = 2 * T + 64 * 256;
constexpr size_t OFF_ACT = OFF_PERM + (size_t)64 * T * 4;
constexpr size_t WS_NEED = OFF_ACT + (size_t)ACT_ROWS * DE * 2;
constexpr int CW_CNT = 1024;

__device__ __forceinline__ float bf2f(bf16_t h) { return __uint_as_float((unsigned)h << 16); }
__device__ __forceinline__ bf16_t f2bf(float f) { unsigned u = __float_as_uint(f); u += 0x7fffu + ((u >> 16) & 1u); return (bf16_t)(u >> 16); }
__device__ __forceinline__ unsigned pk2(float lo, float hi) { return (unsigned)f2bf(lo) | ((unsigned)f2bf(hi) << 16); }
__device__ __forceinline__ float gelu_tanh(float x) { const float t = 0.7978845608028654f * (x + 0.044715f * x * x * x); return x / (1.0f + __expf(-2.0f * t)); }
__device__ __forceinline__ float silu(float x) { return x / (1.0f + __expf(-x)); }
__device__ __forceinline__ float softplus2(float u) { return fmaxf(u, 0.f) + __log2f(1.0f + exp2f(-fabsf(u))); }
__device__ __forceinline__ float wave_sum(float v) {
#pragma unroll
    for (int o = 1; o < 64; o <<= 1) v += __shfl_xor(v, o);
    return v;
}
__device__ __forceinline__ float wave_max(float v) {
#pragma unroll
    for (int o = 1; o < 64; o <<= 1) v = fmaxf(v, __shfl_xor(v, o));
    return v;
}
__device__ __forceinline__ float rs4(const float* ss, int row) { const f32x4* p = (const f32x4*)(ss + (size_t)row * 16); const f32x4 a = p[0], b = p[1], c = p[2], d = p[3];
    return rsqrtf(((((a[0] + a[1]) + (a[2] + a[3])) + ((b[0] + b[1]) + (b[2] + b[3]))) + (((c[0] + c[1]) + (c[2] + c[3])) + ((d[0] + d[1]) + (d[2] + d[3])))) * (1.0f / 1024.0f) + EPS); }

__global__ __launch_bounds__(256) void k_transpose(const float* __restrict__ src, bf16_t* __restrict__ dst, const float* __restrict__ gain, const float* __restrict__ gain2, int ksplit,
                                                   float scale, int K, int N, int src_ld, long ssi, long sso, long dsi, long dso, int gso, int G, int GS, int GO) {
    __shared__ float tile[64][65];
    const int ntn = N / 64, kt = blockIdx.x / ntn, nt = blockIdx.x % ntn;
    const float* s = src + (size_t)blockIdx.y * ssi + (size_t)blockIdx.z * sso;
    bf16_t* d = dst + (size_t)blockIdx.y * dsi + (size_t)blockIdx.z * dso;
    const int tx = threadIdx.x & 63, ty = threadIdx.x >> 6;
#pragma unroll 4
    for (int i = 0; i < 16; ++i) { const int k = ty + 4 * i; tile[k][tx] = s[(size_t)(kt * 64 + k) * src_ld + nt * 64 + tx]; }
    __syncthreads();
    const int kx = threadIdx.x & 31, ny = threadIdx.x >> 5, k0 = kt * 64 + 2 * kx;
    float ga = scale, gb = scale;
    if (gain) { const float* g1 = gain + (size_t)blockIdx.z * gso; const float* g2 = gain2 ? gain2 + (size_t)blockIdx.z * gso : g1;
        ga *= (k0 < ksplit) ? g1[k0] : g2[k0 - ksplit]; gb *= (k0 + 1 < ksplit) ? g1[k0 + 1] : g2[k0 + 1 - ksplit]; }
#pragma unroll
    for (int i = 0; i < 8; ++i) { const int n = ny + 8 * i, ng = nt * 64 + n, drow = (ng / G) * GS + GO + (ng % G);
        *(unsigned*)(d + (size_t)drow * K + k0) = pk2(tile[2 * kx][n] * ga, tile[2 * kx + 1][n] * gb); }
}
__global__ void k_prep_router(const float* __restrict__ w_router, const float* __restrict__ w_group, const float* __restrict__ norm_moe, bf16_t* __restrict__ WR) {
    const int idx = blockIdx.x * 256 + threadIdx.x; if (idx >= NL * 64 * DM) return;
    const int k = idx % DM, n = (idx / DM) % 64, l = idx / (64 * DM);
    float v = 0.f;
    if (n < 32) v = w_router[((size_t)l * DM + k) * NE + n]; else if (n < 36) v = w_group[((size_t)l * DM + k) * NG + (n - 32)];
    WR[idx] = f2bf(v * norm_moe[l * DM + k]);
}
__global__ void k_prep_spatial(const float* __restrict__ w_sp, bf16_t* __restrict__ WS) {
    const int idx = blockIdx.x * 256 + threadIdx.x; if (idx >= NL * AG * CHUNK * CHUNK) return;
    const int s = idx % CHUNK, t = (idx / CHUNK) % CHUNK;
    WS[idx] = (s <= t) ? f2bf(w_sp[idx]) : (bf16_t)0;
}
__global__ __launch_bounds__(256) void k_prep_rows(const float* __restrict__ x, bf16_t* __restrict__ xb, float* __restrict__ ss4, float* __restrict__ ss1, int R) {
    const int row = blockIdx.x * 4 + (threadIdx.x >> 6), lane = threadIdx.x & 63; if (row >= R) return;
    float tot = 0.f;
#pragma unroll
    for (int j = 0; j < 4; ++j) {
        const f32x4 v = *(const f32x4*)(x + (size_t)row * DM + j * 256 + lane * 4);
        u32x2 w; w.x = pk2(v[0], v[1]); w.y = pk2(v[2], v[3]);
        *(u32x2*)(xb + (size_t)row * DM + j * 256 + lane * 4) = w;
        float s = (v[0] * v[0] + v[1] * v[1]) + (v[2] * v[2] + v[3] * v[3]);
        s += __shfl_xor(s, 1); s += __shfl_xor(s, 2); s += __shfl_xor(s, 4); s += __shfl_xor(s, 8);
        if (ss4 && (lane & 15) == 0) ss4[(size_t)row * 16 + j * 4 + (lane >> 4)] = s;
        s += __shfl_xor(s, 16); s += __shfl_xor(s, 32);
        tot += s;
    }
    if (ss1 && lane == 0) ss1[row] = tot;
}

#define MFMA32(a, b, c) __builtin_amdgcn_mfma_f32_32x32x16_bf16((a), (b), (c), 0, 0, 0)
struct SUnit { int p0, q0, aux0, aux1, aux2; };
template <class Prob> __global__ __launch_bounds__(256) void k_sgemm(Prob pr) {
    const int tid = threadIdx.x, wave = tid >> 6, lane = tid & 63, c = lane & 31, h = lane >> 5;
    SUnit u;
    if (!pr.unit((int)blockIdx.x, (int)blockIdx.y, u)) return;
    int pb[2], qb[2];
#pragma unroll
    for (int i = 0; i < 2; ++i) { pb[i] = u.p0 + (Prob::PAIRED ? 32 * wave + 128 * i : 64 * wave + 32 * i); qb[i] = u.q0 + 32 * i; }
    const bf16_t* pa[2]; const bf16_t* qa[2];
#pragma unroll
    for (int i = 0; i < 2; ++i) { pa[i] = pr.prow(u, pb[i] + c) + 8 * h; qa[i] = pr.qrow(u, qb[i] + c) + 8 * h; }
    f32x16 acc[2][2];
#pragma unroll
    for (int i = 0; i < 2; ++i)
#pragma unroll
        for (int j = 0; j < 2; ++j)
#pragma unroll
            for (int r = 0; r < 16; ++r) acc[i][j][r] = 0.f;
    constexpr int K = Prob::K;
#pragma unroll 1
    for (int kh = 0; kh < 2; ++kh) {
        if (Prob::MIDK && kh == 1) {
            const float r0 = pr.midscale(u, qb[0] + c), r1 = pr.midscale(u, qb[1] + c);
#pragma unroll
            for (int i = 0; i < 2; ++i)
#pragma unroll
                for (int r = 0; r < 16; ++r) { acc[i][0][r] *= r0; acc[i][1][r] *= r1; }
        }
#pragma unroll 4
        for (int k = kh * (K / 2); k < (kh + 1) * (K / 2); k += 16) {
            const bf16x8 a0 = *(const bf16x8*)(pa[0] + k), a1 = *(const bf16x8*)(pa[1] + k), b0 = *(const bf16x8*)(qa[0] + k), b1 = *(const bf16x8*)(qa[1] + k);
            acc[0][0] = MFMA32(a0, b0, acc[0][0]); acc[0][1] = MFMA32(a0, b1, acc[0][1]); acc[1][0] = MFMA32(a1, b0, acc[1][0]); acc[1][1] = MFMA32(a1, b1, acc[1][1]);
        }
    }
    float ss[2] = {0.f, 0.f};
#pragma unroll
    for (int j = 0; j < 2; ++j)
#pragma unroll
        for (int g = 0; g < 4; ++g) {
            if (Prob::PAIRED) {
                const f32x4 va = {acc[0][j][4 * g], acc[0][j][4 * g + 1], acc[0][j][4 * g + 2], acc[0][j][4 * g + 3]};
                const f32x4 vb = {acc[1][j][4 * g], acc[1][j][4 * g + 1], acc[1][j][4 * g + 2], acc[1][j][4 * g + 3]};
                pr.epi2(u, pb[0] + 8 * g + 4 * h, qb[j] + c, va, vb);
            } else {
#pragma unroll
                for (int i = 0; i < 2; ++i) {
                    const f32x4 v = {acc[i][j][4 * g], acc[i][j][4 * g + 1], acc[i][j][4 * g + 2], acc[i][j][4 * g + 3]};
                    ss[j] += pr.epi(u, pb[i] + 8 * g + 4 * h, qb[j] + c, v);
                }
            }
        }
    if (Prob::ROWSS) {
#pragma unroll
        for (int j = 0; j < 2; ++j) { ss[j] += __shfl_xor(ss[j], 32); if (h == 0) pr.rowss(u, qb[j] + c, wave, ss[j]); }
    }
}

struct Ptrs {
    unsigned char* ws; const float* x_in; float* out; int l;
    __device__ __forceinline__ bf16_t* b(size_t off) const { return (bf16_t*)(ws + off); }
    __device__ __forceinline__ float* f(size_t off) const { return (float*)(ws + off); }
    __device__ __forceinline__ int* i(size_t off) const { return (int*)(ws + off); }
};
__device__ __forceinline__ void st4bf(bf16_t* p, f32x4 v) { u32x2 w; w.x = pk2(v[0], v[1]); w.y = pk2(v[2], v[3]); *(u32x2*)p = w; }

struct ProbIn { static constexpr int K = DM; static constexpr bool PAIRED = false, MIDK = false, ROWSS = false; Ptrs P;
    __device__ bool unit(int bx, int, SUnit& u) const { u.p0 = (bx % 6) * 256; u.q0 = (bx / 6) * 64; return true; }
    __device__ const bf16_t* prow(const SUnit&, int p) const { return P.b(OFF_WIN + P.l * SZ_WIN) + (size_t)p * DM; }
    __device__ const bf16_t* qrow(const SUnit&, int q) const { return P.b(OFF_XB) + (size_t)q * DM; }
    __device__ float midscale(const SUnit&, int) const { return 1.f; }
    __device__ float epi(const SUnit&, int p, int q, f32x4 v) const {
        const float rs = rs4(P.f(OFF_SSX), q); v = v * rs;
        if (p < 512) { for (int i = 0; i < 4; ++i) v[i] = gelu_tanh(v[i]); st4bf(P.b(OFF_U) + (size_t)q * 512 + p, v); }
        else if (p < 1024) st4bf(P.b(OFF_Q) + (size_t)q * 512 + (p - 512), v);
        else st4bf(P.b(OFF_K) + (size_t)q * 512 + (p - 1024), v);
        return 0.f; }
    __device__ void epi2(const SUnit&, int, int, f32x4, f32x4) const {}
    __device__ void rowss(const SUnit&, int, int, float) const {}
};
struct ProbInT { static constexpr int K = DM; static constexpr bool PAIRED = false, MIDK = false, ROWSS = false; Ptrs P;
    __device__ bool unit(int bx, int, SUnit& u) const { u.p0 = (bx % 64) * 256; u.q0 = (bx / 64) * 64; return true; }
    __device__ const bf16_t* prow(const SUnit&, int p) const { return P.b(OFF_XB) + (size_t)p * DM; }
    __device__ const bf16_t* qrow(const SUnit&, int q) const { return P.b(OFF_WIN + P.l * SZ_WIN) + (size_t)(1536 + q) * DM; }
    __device__ float midscale(const SUnit&, int) const { return 1.f; }
    __device__ float epi(const SUnit&, int p, int q, f32x4 v) const {
        for (int i = 0; i < 4; ++i) v[i] *= rs4(P.f(OFF_SSX), p + i);
        if (q < 512) { for (int i = 0; i < 4; ++i) v[i] = gelu_tanh(v[i]); st4bf(P.b(OFF_VGT) + (size_t)q * T + p, v); }
        else st4bf(P.b(OFF_VBT) + (size_t)(q - 512) * T + p, v);
        return 0.f; }
    __device__ void epi2(const SUnit&, int, int, f32x4, f32x4) const {}
    __device__ void rowss(const SUnit&, int, int, float) const {}
};
struct ProbMemK { static constexpr int K = DM; static constexpr bool PAIRED = false, MIDK = false, ROWSS = false; Ptrs P;
    __device__ bool unit(int bx, int by, SUnit& u) const { u.p0 = (bx % 4) * 256; u.q0 = (bx / 4) * 64; u.aux0 = by; return true; }
    __device__ const bf16_t* prow(const SUnit& u, int p) const { return P.b(OFF_WXK + u.aux0 * SZ_SQ) + (size_t)p * DM; }
    __device__ const bf16_t* qrow(const SUnit&, int q) const { return P.b(OFF_MB) + (size_t)q * DM; }
    __device__ float midscale(const SUnit&, int) const { return 1.f; }
    __device__ float epi(const SUnit& u, int p, int q, f32x4 v) const {
        const float rs = rsqrtf(P.f(OFF_SSM)[q] * (1.0f / 1024.0f) + EPS); v = v * rs;
        st4bf(P.b(OFF_KX) + ((size_t)u.aux0 * MT + q) * DM + p, v); return 0.f; }
    __device__ void epi2(const SUnit&, int, int, f32x4, f32x4) const {}
    __device__ void rowss(const SUnit&, int, int, float) const {}
};
struct ProbMemVT { static constexpr int K = DM; static constexpr bool PAIRED = false, MIDK = false, ROWSS = false; Ptrs P;
    __device__ bool unit(int bx, int by, SUnit& u) const { u.p0 = (bx % 4) * 256; u.q0 = (bx / 4) * 64; u.aux0 = by; return true; }
    __device__ const bf16_t* prow(const SUnit&, int p) const { return P.b(OFF_MB) + (size_t)p * DM; }
    __device__ const bf16_t* qrow(const SUnit& u, int q) const { return P.b(OFF_WXV + u.aux0 * SZ_SQ) + (size_t)q * DM; }
    __device__ float midscale(const SUnit&, int) const { return 1.f; }
    __device__ float epi(const SUnit& u, int p, int q, f32x4 v) const {
        for (int i = 0; i < 4; ++i) v[i] *= rsqrtf(P.f(OFF_SSM)[p + i] * (1.0f / 1024.0f) + EPS);
        st4bf(P.b(OFF_VXT) + ((size_t)u.aux0 * DM + q) * MT + p, v); return 0.f; }
    __device__ void epi2(const SUnit&, int, int, f32x4, f32x4) const {}
    __device__ void rowss(const SUnit&, int, int, float) const {}
};
__device__ __forceinline__ float resid_store(const Ptrs& P, const float* res, int tok, int col, f32x4 add) {
    const f32x4 r = *(const f32x4*)(res + (size_t)tok * DM + col);
    const f32x4 xn = r + add;
    *(f32x4*)(P.f(OFF_XF) + (size_t)tok * DM + col) = xn;
    st4bf(P.b(OFF_XB) + (size_t)tok * DM + col, xn);
    return (xn[0] * xn[0] + xn[1] * xn[1]) + (xn[2] * xn[2] + xn[3] * xn[3]);
}
struct ProbOut { static constexpr int K = DM; static constexpr bool PAIRED = false, MIDK = true, ROWSS = true; Ptrs P;
    __device__ float rsa(int q) const { const f32x4 v = *(const f32x4*)(P.f(OFF_SSA) + (size_t)q * 4); return rsqrtf(((v[0] + v[1]) + (v[2] + v[3])) * (1.0f / 512.0f) + EPS); }
    __device__ float rsb(int q) const { const f32x4 v = *(const f32x4*)(P.f(OFF_SSB) + (size_t)q * 8), w = *(const f32x4*)(P.f(OFF_SSB) + (size_t)q * 8 + 4);
        return rsqrtf((((v[0] + v[1]) + (v[2] + v[3])) + ((w[0] + w[1]) + (w[2] + w[3]))) * (1.0f / 512.0f) + EPS); }
    __device__ bool unit(int bx, int, SUnit& u) const { u.p0 = (bx % 4) * 256; u.q0 = (bx / 4) * 64; return true; }
    __device__ const bf16_t* prow(const SUnit&, int p) const { return P.b(OFF_WOUT + P.l * SZ_SQ) + (size_t)p * DM; }
    __device__ const bf16_t* qrow(const SUnit&, int q) const { return P.b(OFF_Y) + (size_t)q * DM; }
    __device__ float midscale(const SUnit&, int q) const { return rsa(q) / rsb(q); }
    __device__ float epi(const SUnit&, int p, int q, f32x4 v) const { const float* res = (P.l == 0) ? P.x_in : P.f(OFF_XF); return resid_store(P, res, q, p, v * rsb(q)); }
    __device__ void epi2(const SUnit&, int, int, f32x4, f32x4) const {}
    __device__ void rowss(const SUnit& u, int q, int w, float s) const { P.f(OFF_SSX)[(size_t)q * 16 + (u.p0 / 256) * 4 + w] = s; }
};
struct ProbXq { static constexpr int K = DM; static constexpr bool PAIRED = false, MIDK = false, ROWSS = false; Ptrs P;
    __device__ bool unit(int bx, int, SUnit& u) const { u.p0 = (bx % 4) * 256; u.q0 = (bx / 4) * 64; return true; }
    __device__ const bf16_t* prow(const SUnit&, int p) const { return P.b(OFF_WXQ + P.l * SZ_SQ) + (size_t)p * DM; }
    __device__ const bf16_t* qrow(const SUnit&, int q) const { return P.b(OFF_XB) + (size_t)q * DM; }
    __device__ float midscale(const SUnit&, int) const { return 1.f; }
    __device__ float epi(const SUnit&, int p, int q, f32x4 v) const { st4bf(P.b(OFF_QX) + (size_t)q * DM + p, v * rs4(P.f(OFF_SSX), q)); return 0.f; }
    __device__ void epi2(const SUnit&, int, int, f32x4, f32x4) const {}
    __device__ void rowss(const SUnit&, int, int, float) const {}
};
struct ProbXo { static constexpr int K = DM; static constexpr bool PAIRED = false, MIDK = false, ROWSS = true; Ptrs P;
    __device__ bool unit(int bx, int, SUnit& u) const { u.p0 = (bx % 4) * 256; u.q0 = (bx / 4) * 64; return true; }
    __device__ const bf16_t* prow(const SUnit&, int p) const { return P.b(OFF_WXO + P.l * SZ_SQ) + (size_t)p * DM; }
    __device__ const bf16_t* qrow(const SUnit&, int q) const { return P.b(OFF_OX) + (size_t)q * DM; }
    __device__ float midscale(const SUnit&, int) const { return 1.f; }
    __device__ float epi(const SUnit&, int p, int q, f32x4 v) const { return resid_store(P, P.f(OFF_XF), q, p, v); }
    __device__ void epi2(const SUnit&, int, int, f32x4, f32x4) const {}
    __device__ void rowss(const SUnit& u, int q, int w, float s) const { P.f(OFF_SSX)[(size_t)q * 16 + (u.p0 / 256) * 4 + w] = s; }
};
template <int TQ> __device__ __forceinline__ bool moe_decode(const int* cnt, int sg_lo, int sg_hi, int qt_flat, int& sg, int& qt, int& n, int& rowbase) {
    int rb = 0, base = 0; bool found = false;
    for (int s = 0; s < 64; ++s) {
        const int c = cnt[s];
        if (s >= sg_lo && s < sg_hi && !found) { const int nt = (c + TQ - 1) / TQ; if (qt_flat < base + nt) { sg = s; qt = qt_flat - base; n = c; rowbase = rb; found = true; } base += nt; }
        rb += (c + 255) & ~255;
    }
    return found;
}
struct ProbMoe1 { static constexpr int K = DM; static constexpr bool PAIRED = true, MIDK = false, ROWSS = false; Ptrs P;
    __device__ bool unit(int bx, int, SUnit& u) const { int sg, qt, n, rb; if (!moe_decode<64>(P.i(OFF_CTL) + CW_CNT + P.l * 64, 0, 64, bx / 4, sg, qt, n, rb)) return false;
        u.p0 = (bx % 4) * 256; u.q0 = qt * 64; u.aux0 = sg; u.aux1 = n; u.aux2 = rb; return true; }
    __device__ const bf16_t* prow(const SUnit& u, int p) const { return P.b(OFF_W13 + ((size_t)P.l * NE + (u.aux0 & 31)) * SZ_W13) + (size_t)p * DM; }
    __device__ int tok(const SUnit& u, int q) const { return P.i(OFF_PERM)[(size_t)u.aux0 * T + (q < u.aux1 ? q : u.aux1 - 1)]; }
    __device__ const bf16_t* qrow(const SUnit& u, int q) const { return P.b(OFF_XB) + (size_t)tok(u, q) * DM; }
    __device__ float midscale(const SUnit&, int) const { return 1.f; }
    __device__ float epi(const SUnit&, int, int, f32x4) const { return 0.f; }
    __device__ void epi2(const SUnit& u, int p, int q, f32x4 a, f32x4 b) const {
        const float rs = rs4(P.f(OFF_SSX), tok(u, q)); f32x4 r;
        for (int i = 0; i < 4; ++i) r[i] = silu(a[i] * rs) * (b[i] * rs);
        st4bf(P.b(OFF_ACT) + (size_t)(u.aux2 + q) * DE + (p >> 8) * 128 + (p & 127), r); }
    __device__ void rowss(const SUnit&, int, int, float) const {}
};
template <int SLOT> struct ProbMoe2 { static constexpr int K = DE; static constexpr bool PAIRED = false, MIDK = false, ROWSS = (SLOT == 1); Ptrs P;
    __device__ bool unit(int bx, int, SUnit& u) const { int sg, qt, n, rb; if (!moe_decode<64>(P.i(OFF_CTL) + CW_CNT + P.l * 64, SLOT * 32, SLOT * 32 + 32, bx / 4, sg, qt, n, rb)) return false;
        u.p0 = (bx % 4) * 256; u.q0 = qt * 64; u.aux0 = sg; u.aux1 = n; u.aux2 = rb; return true; }
    __device__ const bf16_t* prow(const SUnit& u, int p) const { return P.b(OFF_W2 + ((size_t)P.l * NE + (u.aux0 & 31)) * SZ_W2) + (size_t)p * DE; }
    __device__ const bf16_t* qrow(const SUnit& u, int q) const { return P.b(OFF_ACT) + (size_t)(u.aux2 + q) * DE; }
    __device__ float midscale(const SUnit&, int) const { return 1.f; }
    __device__ float epi(const SUnit& u, int p, int q, f32x4 v) const {
        if (q >= u.aux1) return 0.f;
        const int tok = P.i(OFF_PERM)[(size_t)u.aux0 * T + q]; const float g = P.f(OFF_GATE)[(size_t)tok * 2 + SLOT]; v = v * g;
        if (SLOT == 0) { float* xp = P.f(OFF_XF) + (size_t)tok * DM + p; *(f32x4*)xp = *(const f32x4*)xp + v; return 0.f; }
        return resid_store(P, P.f(OFF_XF), tok, p, v); }
    __device__ void epi2(const SUnit&, int, int, f32x4, f32x4) const {}
    __device__ void rowss(const SUnit& u, int q, int w, float s) const { if (q < u.aux1) { const int tok = P.i(OFF_PERM)[(size_t)u.aux0 * T + q]; P.f(OFF_SSX)[(size_t)tok * 16 + (u.p0 / 256) * 4 + w] = s; } }
};

__global__ __launch_bounds__(256) void k_attn_naive(Ptrs P) {
    const int idx = blockIdx.x * 256 + threadIdx.x, h = idx & 7, tok = idx >> 3, b = tok / SEQ, t = tok % SEQ;
    const bf16_t* Qp = P.b(OFF_Q) + (size_t)tok * 512 + h * 64;
    float q[64], o[64];
#pragma unroll
    for (int d = 0; d < 64; ++d) { q[d] = bf2f(Qp[d]); o[d] = 0.f; }
    float R = 0.f;
    for (int s = t - 1; s >= 0; --s) {
        const bf16_t* kr = P.b(OFF_K) + (size_t)(b * SEQ + s) * 512 + h * 64;
        float u = 0.f;
#pragma unroll
        for (int d = 0; d < 64; ++d) u += q[d] * bf2f(kr[d]);
        const float sp = softplus2(u), a = exp2f(u - sp - R);
        const bf16_t* vc = P.b(OFF_VBT) + (size_t)(h * 64) * T + b * SEQ + s;
#pragma unroll
        for (int d = 0; d < 64; ++d) o[d] += a * bf2f(vc[(size_t)d * T]);
        R += sp; if (R > RSTOP) break;
    }
    float ss = 0.f;
#pragma unroll
    for (int d = 0; d < 64; ++d) { const bf16_t ob = f2bf(o[d]); P.b(OFF_Y)[(size_t)tok * DM + 512 + h * 64 + d] = ob; const float of = bf2f(ob); ss += of * of; }
    P.f(OFF_SSB)[(size_t)tok * 8 + h] = ss;
}
__global__ __launch_bounds__(256) void k_gmlp_naive(Ptrs P, const float* __restrict__ v_norm, const float* __restrict__ b_sp) {
    __shared__ bf16_t vgs[128][130];
    __shared__ float rs[128];
    __shared__ float part[128][2];
    const int g = blockIdx.x & 3, bc = blockIdx.x >> 2, tok0 = bc * 128, tid = threadIdx.x, l = P.l;
    for (int idx = tid; idx < 128 * 128; idx += 256) { const int c = idx >> 7, s = idx & 127; vgs[s][c] = P.b(OFF_VGT)[(size_t)(g * 128 + c) * T + tok0 + s]; }
    __syncthreads();
    if (tid < 128) { float s2 = 0.f; for (int c = 0; c < 128; ++c) { const float v = bf2f(vgs[tid][c]); s2 += v * v; } rs[tid] = rsqrtf(s2 * (1.0f / 128.0f) + EPS); }
    __syncthreads();
    const int c = tid & 127, th = tid >> 7;
    const float gain = v_norm[(size_t)l * AW + g * 128 + c];
    const bf16_t* W = P.b(OFF_WS + l * SZ_WS) + (size_t)g * CHUNK * CHUNK;
    for (int t = th * 64; t < th * 64 + 64; ++t) {
        float acc = 0.f;
        for (int s = 0; s <= t; ++s) acc += bf2f(W[t * 128 + s]) * rs[s] * bf2f(vgs[s][c]);
        const float mixed = gain * acc + b_sp[(size_t)l * AG * CHUNK + g * CHUNK + t];
        const float y = bf2f(P.b(OFF_U)[(size_t)(tok0 + t) * 512 + g * 128 + c]) * mixed;
        const bf16_t yb = f2bf(y); P.b(OFF_Y)[(size_t)(tok0 + t) * DM + g * 128 + c] = yb;
        const float yf = bf2f(yb); const float sq = wave_sum(yf * yf);
        if ((tid & 63) == 0) part[t][(tid >> 6) & 1] = sq;
    }
    __syncthreads();
    if (tid < 128) P.f(OFF_SSA)[(size_t)(tok0 + tid) * 4 + g] = part[tid][0] + part[tid][1];
}
__global__ __launch_bounds__(256) void k_xattn_naive(Ptrs P) {
    __shared__ float qs[16][256];
    __shared__ float pp[16][256];
    const int h = blockIdx.x & 3, tok0 = (blockIdx.x >> 2) * 16, b = tok0 / SEQ, tid = threadIdx.x, l = P.l;
    for (int i = 0; i < 16; ++i) qs[i][tid] = bf2f(P.b(OFF_QX)[(size_t)(tok0 + i) * DM + h * 256 + tid]);
    __syncthreads();
    {
        const bf16_t* kr = P.b(OFF_KX) + ((size_t)l * MT + b * MEML + tid) * DM + h * 256;
        float s[16];
#pragma unroll
        for (int i = 0; i < 16; ++i) s[i] = 0.f;
        for (int d = 0; d < 256; d += 8) {
            const bf16x8 kv = *(const bf16x8*)(kr + d);
#pragma unroll
            for (int j = 0; j < 8; ++j) { const float kf = bf2f((bf16_t)kv[j]);
#pragma unroll
                for (int i = 0; i < 16; ++i) s[i] += qs[i][d + j] * kf; }
        }
#pragma unroll
        for (int i = 0; i < 16; ++i) pp[i][tid] = s[i];
    }
    __syncthreads();
    {
        const int wave = tid >> 6, lane = tid & 63;
        for (int i = wave * 4; i < wave * 4 + 4; ++i) {
            float v[4]; float m = -INFINITY;
#pragma unroll
            for (int j = 0; j < 4; ++j) { v[j] = pp[i][lane + 64 * j]; m = fmaxf(m, v[j]); }
            m = wave_max(m); float sum = 0.f;
#pragma unroll
            for (int j = 0; j < 4; ++j) { v[j] = exp2f(v[j] - m); sum += v[j]; }
            sum = wave_sum(sum); const float inv = 1.0f / sum;
#pragma unroll
            for (int j = 0; j < 4; ++j) pp[i][lane + 64 * j] = v[j] * inv;
        }
    }
    __syncthreads();
    {
        const bf16_t* vr = P.b(OFF_VXT) + ((size_t)l * DM + h * 256 + tid) * MT + b * MEML;
        float o[16];
#pragma unroll
        for (int i = 0; i < 16; ++i) o[i] = 0.f;
        for (int m = 0; m < 256; m += 8) {
            const bf16x8 vv = *(const bf16x8*)(vr + m);
#pragma unroll
            for (int j = 0; j < 8; ++j) { const float vf = bf2f((bf16_t)vv[j]);
#pragma unroll
                for (int i = 0; i < 16; ++i) o[i] += pp[i][m + j] * vf; }
        }
#pragma unroll
        for (int i = 0; i < 16; ++i) P.b(OFF_OX)[(size_t)(tok0 + i) * DM + h * 256 + tid] = f2bf(o[i]);
    }
}
__global__ __launch_bounds__(256) void k_router_naive(Ptrs P, const float* __restrict__ b_group, const float* __restrict__ b_router) {
    __shared__ float lg[4][64];
    const int tid = threadIdx.x, w = tid >> 6, n = tid & 63, tok = blockIdx.x * 4 + w, l = P.l;
    if (n < 36) {
        const bf16_t* xr = P.b(OFF_XB) + (size_t)tok * DM; const bf16_t* wr = P.b(OFF_WR + l * SZ_WR) + (size_t)n * DM;
        float dot = 0.f;
        for (int k = 0; k < DM; k += 8) { const bf16x8 a = *(const bf16x8*)(xr + k), bb = *(const bf16x8*)(wr + k);
#pragma unroll
            for (int j = 0; j < 8; ++j) dot += bf2f((bf16_t)a[j]) * bf2f((bf16_t)bb[j]); }
        lg[w][n] = dot * rs4(P.f(OFF_SSX), tok) + (n < 32 ? b_router[l * NE + n] : b_group[l * NG + (n - 32)]);
    }
    __syncthreads();
    if (n == 0) {
        int gs = 0; float gm = lg[w][32];
        for (int i = 1; i < 4; ++i) if (lg[w][32 + i] > gm) { gm = lg[w][32 + i]; gs = i; }
        float den = 0.f; for (int i = 0; i < 4; ++i) den += __expf(lg[w][32 + i] - gm);
        const float pg = 1.0f / den;
        int i1 = 0; float v1 = lg[w][gs * 8];
        for (int i = 1; i < 8; ++i) if (lg[w][gs * 8 + i] > v1) { v1 = lg[w][gs * 8 + i]; i1 = i; }
        int i2 = -1; float v2 = -INFINITY;
        for (int i = 0; i < 8; ++i) if (i != i1 && lg[w][gs * 8 + i] > v2) { v2 = lg[w][gs * 8 + i]; i2 = i; }
        const float w1 = 1.0f / (1.0f + __expf(v2 - v1)), w2 = 1.0f - w1;
        const int e1 = gs * 8 + i1, e2 = gs * 8 + i2;
        int* cnt = P.i(OFF_CTL) + CW_CNT + l * 64;
        const int p1 = atomicAdd(cnt + e1, 1), p2 = atomicAdd(cnt + 32 + e2, 1);
        P.i(OFF_PERM)[(size_t)e1 * T + p1] = tok; P.i(OFF_PERM)[(size_t)(32 + e2) * T + p2] = tok;
        P.f(OFF_GATE)[(size_t)tok * 2] = pg * w1; P.f(OFF_GATE)[(size_t)tok * 2 + 1] = pg * w2;
    }
}
__global__ __launch_bounds__(256) void k_final(Ptrs P, const float* __restrict__ norm_final) {
    const int row = blockIdx.x * 4 + (threadIdx.x >> 6), lane = threadIdx.x & 63;
    const float rs = rs4(P.f(OFF_SSX), row);
#pragma unroll
    for (int j = 0; j < 4; ++j) {
        const f32x4 v = *(const f32x4*)(P.f(OFF_XF) + (size_t)row * DM + j * 256 + lane * 4), g = *(const f32x4*)(norm_final + j * 256 + lane * 4);
        *(f32x4*)(P.out + (size_t)row * DM + j * 256 + lane * 4) = v * rs * g;
    }
}


#define LAS __attribute__((address_space(3)))
#define GAS __attribute__((address_space(1)))
template <int M> __device__ __forceinline__ float sx(float v) {
    const int i = __float_as_int(v); int r;
    if constexpr (M == 1) r = __builtin_amdgcn_mov_dpp(i, 0xB1, 0xF, 0xF, true);
    else if constexpr (M == 2) r = __builtin_amdgcn_mov_dpp(i, 0x4E, 0xF, 0xF, true);
    else if constexpr (M == 32) { auto p = __builtin_amdgcn_permlane32_swap((unsigned)i, (unsigned)i, false, false); const unsigned lo = p[0], hi = p[1]; r = (int)((__builtin_amdgcn_mbcnt_hi(~0u, __builtin_amdgcn_mbcnt_lo(~0u, 0u)) < 32u) ? hi : lo); }
    else r = __builtin_amdgcn_ds_swizzle(i, (M << 10) | 0x1F);
    return __int_as_float(r);
}
typedef float f32x2h __attribute__((ext_vector_type(2))); typedef __bf16 bf16x2h __attribute__((ext_vector_type(2)));
__device__ __forceinline__ unsigned pk2h(float lo, float hi) { f32x2h v = {lo, hi}; bf16x2h b = __builtin_convertvector(v, bf16x2h); return __builtin_bit_cast(unsigned, b); }
__device__ __forceinline__ bf16_t f2bfh(float f) { return (bf16_t)(pk2h(f, 0.f) & 0xffffu); }

constexpr int NWAVES = 8;
constexpr int RING_BYTES = 131072;
constexpr int L_MISC = RING_BYTES;
constexpr int L_SC = RING_BYTES + 12288;
constexpr int L_SC2 = RING_BYTES + 14336;
constexpr int L_ROWST = RING_BYTES + 2048;
constexpr int L_TOKL = RING_BYTES + 4096;
constexpr int L_SEG = RING_BYTES + 8192;
constexpr int LDS_BYTES = RING_BYTES + 20480;
constexpr int CW_CNTP = 150016;
constexpr int CW_BAR = 4096;

#define XB_TMO      128
#define XB_XCNT(j)  (256  + 64 * (j))
#define XB_XSUB(j)  (1280 + 64 * (j))
#define XB_XGEN(j)  (2304 + 64 * (j))
#define XB_TOP      3328
#define XB_TOPGEN   3392
#define XCD_BAR_WORDS 3456
#define XB_SPIN_CAP (1u << 18)
__device__ __forceinline__ unsigned xb_ld(unsigned* p)              { return __hip_atomic_load(p, __ATOMIC_RELAXED, __HIP_MEMORY_SCOPE_AGENT); }
__device__ __forceinline__ unsigned xb_add(unsigned* p, unsigned v) { return __hip_atomic_fetch_add(p, v, __ATOMIC_RELAXED, __HIP_MEMORY_SCOPE_AGENT); }
__device__ __forceinline__ unsigned xb_xcc_id() { return (unsigned)__builtin_amdgcn_s_getreg((3 << 11) | 20) & 0xFu; }
#define XB_SPIN(cond, bar) do { unsigned _sp = 0; while (cond) { __builtin_amdgcn_s_sleep(1); \
    if ((++_sp & 255u) == 0u) { if (xb_ld(&(bar)[XB_TMO])) break; if (_sp > XB_SPIN_CAP) { atomicAdd(&(bar)[XB_TMO], 1u); break; } } } } while (0)
struct XcdBarrier { unsigned* bar; unsigned x; volatile LAS unsigned* st; };
__device__ __forceinline__ XcdBarrier xcd_barrier_post(unsigned* bar, volatile LAS unsigned* st) {
    XcdBarrier b; b.bar = bar; b.x = xb_xcc_id(); b.st = st;
    if (threadIdx.x == 0) (void)xb_add(&bar[XB_XCNT(b.x)], 1u);
    return b;
}
__device__ __forceinline__ void xcd_barrier_complete(unsigned* bar, unsigned x, unsigned& nloc, unsigned& nx) {
    const unsigned G = gridDim.x * gridDim.y * gridDim.z;
    unsigned sum, cnt, mine, sp = 0u;
    for (;;) {
        sum = 0u; cnt = 0u; mine = 0u;
#pragma unroll
        for (unsigned j = 0; j < 16; ++j) { const unsigned c = xb_ld(&bar[XB_XCNT(j)]); sum += c; cnt += (c > 0u) ? 1u : 0u; mine = (j == x) ? c : mine; }
        if (sum == G) break;
        __builtin_amdgcn_s_sleep(1);
        if ((++sp & 255u) == 0u) { if (xb_ld(&bar[XB_TMO])) break; if (sp > XB_SPIN_CAP) { atomicAdd(&bar[XB_TMO], 1u); break; } }
    }
    nloc = mine > 0u ? mine : 1u; nx = cnt > 0u ? cnt : 1u;
}
__device__ __forceinline__ void xcd_barrier(const XcdBarrier& b, const bool leader  ) {
    asm volatile("s_waitcnt vmcnt(0)" ::: "memory");
    __syncthreads();
    if (leader) {
        unsigned* bar = b.bar; unsigned bx_ = b.x;
        asm volatile("" : "+s"(bar), "+s"(bx_));
        __builtin_amdgcn_s_waitcnt(0);
        unsigned nloc = b.st[0], nx = b.st[1];
        if (nloc == 0u) { xcd_barrier_complete(bar, bx_, nloc, nx); b.st[0] = nloc; b.st[1] = nx; }
        const unsigned old = xb_add(&bar[XB_XSUB(bx_)], 1u);
        const unsigned gen = old / nloc;
        if (old + 1u == (gen + 1u) * nloc) {
            __builtin_amdgcn_fence(__ATOMIC_RELEASE, "agent");
            asm volatile("s_waitcnt vmcnt(0)" ::: "memory");
            const unsigned og = xb_add(&bar[XB_TOP], 1u);
            const unsigned tg = og / nx;
            if (og + 1u == (tg + 1u) * nx) xb_add(&bar[XB_TOPGEN], 1u);
            else XB_SPIN(xb_ld(&bar[XB_TOPGEN]) == tg, bar);
            __builtin_amdgcn_fence(__ATOMIC_ACQUIRE, "agent");
            xb_add(&bar[XB_XGEN(bx_)], 1u);
            asm volatile("s_waitcnt vmcnt(0)" ::: "memory");
        } else {
            XB_SPIN(xb_ld(&bar[XB_XGEN(bx_)]) == gen, bar);
            __builtin_amdgcn_fence(__ATOMIC_ACQUIRE, "agent");
            asm volatile("s_waitcnt vmcnt(0)" ::: "memory");
        }
    }
    __syncthreads();
}

constexpr int CW_TEAM = 16384;
__device__ __forceinline__ void team_barrier(unsigned* cnt, const bool leader) {
    asm volatile("s_waitcnt vmcnt(0)" ::: "memory");
    __syncthreads();
    if (leader) {
        asm volatile("" : "+s"(cnt));
        (void)xb_add(cnt, 1u);
        unsigned sp = 0u;
        while (xb_ld(cnt) < 4u) { __builtin_amdgcn_s_sleep(1); if (++sp > (1u << 22)) break; }
        __builtin_amdgcn_fence(__ATOMIC_ACQUIRE, "agent");
        asm volatile("s_waitcnt vmcnt(0)" ::: "memory");
    }
    __syncthreads();
}

namespace g8 {
constexpr int BM = 256, BK = 64, HALF = 128, HTB = HALF * BK * 2, STAGE_BYTES = 8 * HTB;
__host__ __device__ __forceinline__ int lds_byte(int r, int c) { const int st = (r >> 4) * 2 + (c >> 5), rr = r & 15, cc = c & 31, ob = rr * 64 + cc * 2; return st * 1024 + (ob ^ (((ob >> 9) & 1) << 5)); }
__host__ __device__ __forceinline__ int perm32(int rho) { const int n = rho >> 4, i = rho & 15; return 8 * (i >> 2) + 4 * n + (i & 3); }
__host__ __device__ __forceinline__ void stage_rc(int b, int& R, int& C) { const int st = b / 1024, sb = b % 1024, swz = sb ^ (((sb >> 9) & 1) << 5); R = (st >> 1) * 16 + swz / 64; C = (st & 1) * 32 + (swz % 64) / 2; }
enum Kind { K_IN = 0, K_INT, K_MEMK, K_MEMVT, K_OUT, K_XQ, K_XO, K_MOE1, K_MOE2A, K_MOE2B };
struct Unit { int q0, p0, kind, a0, a1, a2, slot; };

template <bool GATHER, class Sched, class Epi>
__device__ __forceinline__ void gemm_phase(LAS unsigned char* lds, const int K, const Sched& S, const Epi& E, const int tid) {
    const int wid = __builtin_amdgcn_readfirstlane(tid >> 6), lane = tid & 63, wr = wid >> 2, wc = wid & 3, fr = lane & 15, fq = lane >> 4;
    const int nt = K / BK;
    int sR[2], sC[2]; unsigned voff[2], voffB[2];
#pragma unroll
    for (int i = 0; i < 2; ++i) { int R, C; stage_rc(tid * 16 + i * 8192, R, C); sR[i] = R; sC[i] = C; voff[i] = (unsigned)(R * K + C) * 2u;
        const int Rb = (R & ~31) + perm32(R & 31); voffB[i] = (unsigned)(Rb * K + C) * 2u; }
    const size_t kstep = (size_t)(BK * 2);
    const size_t hstep = (size_t)HALF * K * 2;
    const unsigned ldsw = (unsigned)wid * 1024u;
    const int aoff = lds_byte(wr * 64 + fr, fq * 8), boff = lds_byte(wc * 32 + fr, fq * 8);
#define G8_SA(b, h) (((b) * 2 + (h)) * HTB)
#define G8_SB(b, h) ((4 + (b) * 2 + (h)) * HTB)
#define G8_STAGE(bufoff, gbase, vo0, vo1) do { \
        __builtin_amdgcn_global_load_lds((const GAS unsigned*)((const GAS char*)(gbase) + (vo0)), (LAS unsigned*)(lds + (bufoff) + ldsw), 16, 0, 0); \
        __builtin_amdgcn_global_load_lds((const GAS unsigned*)((const GAS char*)(gbase) + (vo1)), (LAS unsigned*)(lds + (bufoff) + ldsw + 8192), 16, 0, 0); } while (0)
#define G8_STA(bufoff, base, h, g0, g1) do { if (GATHER) { G8_STAGE(bufoff, base, g0, g1); } else { G8_STAGE(bufoff, (base) + (h) * hstep, voff[0], voff[1]); } } while (0)
#define G8_STB(bufoff, base) G8_STAGE(bufoff, base, voffB[0], voffB[1])
#define G8_LDA(dst, b, h) do { _Pragma("unroll") for (int m = 0; m < 4; ++m) _Pragma("unroll") for (int k = 0; k < 2; ++k) dst[m][k] = *(const LAS bf16x8*)(lds + G8_SA(b, h) + aoff + m * 2048 + k * 1024); } while (0)
#define G8_LDB(dst, b, h) do { _Pragma("unroll") for (int n = 0; n < 2; ++n) _Pragma("unroll") for (int k = 0; k < 2; ++k) dst[n][k] = *(const LAS bf16x8*)(lds + G8_SB(b, h) + boff + n * 2048 + k * 1024); } while (0)
#define G8_MMA(ai, bj, At, Bt) do { __builtin_amdgcn_s_setprio(1); _Pragma("unroll") for (int m = 0; m < 4; ++m) _Pragma("unroll") for (int n = 0; n < 2; ++n) _Pragma("unroll") for (int k = 0; k < 2; ++k) \
        acc[ai][bj][m][n] = __builtin_amdgcn_mfma_f32_16x16x32_bf16(Bt[n][k], At[m][k], acc[ai][bj][m][n], 0, 0, 0); __builtin_amdgcn_s_setprio(0); } while (0)
#define G8_WAIT_V(n) asm volatile("s_waitcnt vmcnt(" #n ")" ::: "memory")
#define G8_WAIT_L(n) asm volatile("s_waitcnt lgkmcnt(" #n ")" ::: "memory")
#define G8_BAR __builtin_amdgcn_s_barrier()
#define G8_SCHED __builtin_amdgcn_sched_barrier(0)
    Unit cur, nxt; int ui = 0;
    if (!S.next(0, cur)) return;
    f32x4 acc[2][2][4][2];
#pragma unroll
    for (int a = 0; a < 2; ++a)
#pragma unroll
        for (int b = 0; b < 2; ++b)
#pragma unroll
            for (int m = 0; m < 4; ++m)
#pragma unroll
                for (int n = 0; n < 2; ++n) acc[a][b][m][n] = (f32x4){0.f, 0.f, 0.f, 0.f};
    bf16x8 At[4][2], B0[2][2], B1[2][2];
    E.prep(cur, 0, tid); asm volatile("s_waitcnt vmcnt(0) lgkmcnt(0)" ::: "memory"); G8_BAR;
    const GAS char* cA = S.ptrA(cur); const GAS char* cB = S.ptrB(cur);
    unsigned g00 = 0, g01 = 0, g10 = 0, g11 = 0;
    if (GATHER) { const LAS int* tl = E.tokl(cur.slot); g00 = (unsigned)tl[sR[0]] * (unsigned)(K * 2) + sC[0] * 2; g01 = (unsigned)tl[sR[1]] * (unsigned)(K * 2) + sC[1] * 2;
                  g10 = (unsigned)tl[sR[0] + 128] * (unsigned)(K * 2) + sC[0] * 2; g11 = (unsigned)tl[sR[1] + 128] * (unsigned)(K * 2) + sC[1] * 2; G8_WAIT_L(0); }
    G8_STB(G8_SB(0, 0), cB); G8_STB(G8_SB(0, 1), cB + hstep); G8_STA(G8_SA(0, 0), cA, 0, g00, g01); G8_STA(G8_SA(0, 1), cA, 1, g10, g11);
    if (wr == 1) G8_BAR;
    G8_WAIT_V(2); G8_BAR;
    G8_STB(G8_SB(1, 0), cB + kstep); G8_STA(G8_SA(1, 0), cA + kstep, 0, g00, g01); G8_STB(G8_SB(1, 1), cB + hstep + kstep);
    G8_WAIT_V(6); G8_BAR;
    for (;;) {
        const bool has_next = S.next(ui + 1, nxt);
        const GAS char* nA = has_next ? S.ptrA(nxt) : cA; const GAS char* nB = has_next ? S.ptrB(nxt) : cB;
        for (int t = 0; t < nt; t += 2) {
            const bool last = (t == nt - 2);
            if (Epi::MIDK) { if (t == nt / 2) E.midk(acc, cur, wr, fr); }
            const GAS char* a1 = cA + (size_t)(t + 1) * kstep;
            const GAS char* a2 = last ? nA : cA + (size_t)(t + 2) * kstep; const GAS char* b2 = last ? nB : cB + (size_t)(t + 2) * kstep;
            const GAS char* a3 = a2 + kstep; const GAS char* b3 = b2 + kstep;
            G8_LDB(B0, 0, 0); G8_LDB(B1, 0, 1); G8_SCHED; G8_LDA(At, 0, 0); G8_STA(G8_SA(1, 1), a1, 1, g10, g11);
            if (GATHER) { if (last && has_next) { const LAS int* tl = E.tokl(nxt.slot); int t2 = tid; asm volatile("" : "+v"(t2)); int R0, C0, R1, C1; stage_rc(t2 * 16, R0, C0); stage_rc(t2 * 16 + 8192, R1, C1);
                  g00 = (unsigned)tl[R0] * (unsigned)(K * 2) + C0 * 2; g01 = (unsigned)tl[R1] * (unsigned)(K * 2) + C1 * 2;
                  g10 = (unsigned)tl[R0 + 128] * (unsigned)(K * 2) + C0 * 2; g11 = (unsigned)tl[R1 + 128] * (unsigned)(K * 2) + C1 * 2; } }
            G8_WAIT_V(8); G8_WAIT_L(0); G8_BAR; G8_MMA(0, 0, At, B0); G8_MMA(0, 1, At, B1); G8_BAR; G8_SCHED;
            G8_LDA(At, 0, 1); G8_STB(G8_SB(0, 0), b2); G8_STB(G8_SB(0, 1), b2 + hstep); G8_STA(G8_SA(0, 0), a2, 0, g00, g01);
            G8_WAIT_V(8); G8_WAIT_L(0); G8_BAR; G8_MMA(1, 0, At, B0); G8_MMA(1, 1, At, B1); G8_BAR; G8_SCHED;
            G8_LDB(B0, 1, 0); G8_LDB(B1, 1, 1); G8_SCHED; G8_LDA(At, 1, 0); G8_STA(G8_SA(0, 1), a2, 1, g10, g11);
            G8_WAIT_V(8); G8_WAIT_L(0); G8_BAR; G8_MMA(0, 0, At, B0); G8_MMA(0, 1, At, B1); G8_BAR; G8_SCHED;
            G8_LDA(At, 1, 1); G8_STB(G8_SB(1, 0), b3); G8_STB(G8_SB(1, 1), b3 + hstep); G8_STA(G8_SA(1, 0), a3, 0, g00, g01);
            G8_WAIT_V(8); G8_WAIT_L(0); G8_BAR; G8_MMA(1, 0, At, B0); G8_MMA(1, 1, At, B1); G8_BAR; G8_SCHED;
        }
        if (wr == 0) G8_BAR;
        if (has_next) E.prep(nxt, (ui + 1) & 1, tid);
        E(acc, cur, wid, wr, wc, fr, fq, tid, ui & 1);
        if (!has_next) break;
#pragma unroll
        for (int a = 0; a < 2; ++a)
#pragma unroll
            for (int b = 0; b < 2; ++b)
#pragma unroll
                for (int m = 0; m < 4; ++m)
#pragma unroll
                    for (int n = 0; n < 2; ++n) acc[a][b][m][n] = (f32x4){0.f, 0.f, 0.f, 0.f};
        cur = nxt; cA = nA; cB = nB; ++ui;
        if (wr == 1) G8_BAR;
    }
    G8_WAIT_V(0);
    G8_BAR;
#undef G8_SA
#undef G8_SB
#undef G8_STAGE
#undef G8_STA
#undef G8_STB
#undef G8_LDA
#undef G8_LDB
#undef G8_MMA
#undef G8_WAIT_V
#undef G8_WAIT_L
#undef G8_BAR
#undef G8_SCHED
}
}

struct MArgs { const float* in[25]; float* out; unsigned char* ws; int ph_lo, ph_hi, li, pad; };
typedef GAS bf16_t gbf; typedef GAS float gfl; typedef GAS int gint;
struct GP {
    GAS unsigned char* ws; int l;
    __device__ __forceinline__ gbf* b(size_t off) const { return (gbf*)(ws + off); }
    __device__ __forceinline__ gfl* f(size_t off) const { return (gfl*)(ws + off); }
    __device__ __forceinline__ gint* i(size_t off) const { return (gint*)(ws + off); }
};
struct Frame {
    LAS unsigned char* lds; GP P; int tid, lane, wave, vcu, G;
};
__device__ __forceinline__ void gst4bf(gbf* p, f32x4 v) { u32x2 w; w.x = pk2h(v[0], v[1]); w.y = pk2h(v[2], v[3]); *(GAS u32x2*)p = w; }
__device__ __forceinline__ void gst8bf(gbf* p, f32x4 a, f32x4 b) { u32x4 w; w.x = pk2h(a[0], a[1]); w.y = pk2h(a[2], a[3]); w.z = pk2h(b[0], b[1]); w.w = pk2h(b[2], b[3]); *(GAS u32x4*)p = w; }
__device__ __forceinline__ void st16_wt(GAS void* p, u32x4 v) { asm volatile("global_store_dwordx4 %0, %1, off sc1\n\ts_nop 1" :: "v"(p), "v"(v) : "memory"); }
__device__ __forceinline__ void st4_wt(GAS float* p, float v) { asm volatile("global_store_dword %0, %1, off sc1\n\ts_nop 1" :: "v"(p), "v"(v) : "memory"); }
__device__ __forceinline__ float gresid8(gbf* xp, f32x4 a, f32x4 b) {
    const u32x4 o = *(const GAS u32x4*)xp; u32x4 w; float ss = 0.f;
#pragma unroll
    for (int j = 0; j < 4; ++j) {
        const float lo = __uint_as_float(o[j] << 16) + (j < 2 ? a[2 * j] : b[2 * j - 4]), hi = __uint_as_float(o[j] & 0xffff0000u) + (j < 2 ? a[2 * j + 1] : b[2 * j - 3]);
        const unsigned pw = pk2h(lo, hi); w[j] = pw;
        const float rl = __uint_as_float(pw << 16), rh = __uint_as_float(pw & 0xffff0000u); ss += rl * rl + rh * rh;
    }
    *(GAS u32x4*)xp = w; return ss;
}
__device__ __forceinline__ int xcd_remap(int L, int nwg) { const int q = nwg / 8, r = nwg % 8, x = L % 8, off = L / 8; return (x < r ? x * (q + 1) : r * (q + 1) + (x - r) * q) + off; }
__device__ __forceinline__ float rsum16(const gfl* ss, int row) { const GAS f32x4* p = (const GAS f32x4*)(ss + (unsigned)row * 16); const f32x4 a = p[0], b = p[1], c = p[2], d = p[3];
    return ((((a[0] + a[1]) + (a[2] + a[3])) + ((b[0] + b[1]) + (b[2] + b[3]))) + (((c[0] + c[1]) + (c[2] + c[3])) + ((d[0] + d[1]) + (d[2] + d[3])))); }

struct DenseSched {
    GP P; int type, G, c;
    __device__ __forceinline__ bool next(int i, g8::Unit& u) const {
        const int L = i * G + c;
        u.a0 = 0; u.a1 = 0; u.a2 = 0; u.slot = 0;
        if (type == 1) {
            const int nwg = 672; if (L >= nwg) return false;
            const int w = xcd_remap(L, nwg);
            if (w < 384) { const int gid = w / 48, r = w % 48, pm = gid * 8 + (r % 8), pn = r / 8; u.kind = g8::K_IN; u.q0 = pm * 256; u.p0 = pn * 256; }
            else if (w < 640) { const int v = w - 384, ch = v % 4, tk = v / 4; u.kind = g8::K_INT; u.q0 = ch * 256; u.p0 = tk * 256; }
            else { const int r = w - 640; u.a0 = P.l;
                if (r < 16) { u.kind = g8::K_MEMK; u.q0 = (r % 4) * 256; u.p0 = (r / 4) * 256; }
                else { const int r2 = r - 16; u.kind = g8::K_MEMVT; u.q0 = (r2 % 4) * 256; u.p0 = (r2 / 4) * 256; } }
            return true;
        }
        if (L >= 256) return false;
        const int w = xcd_remap(L, 256), gid = w / 32, r = w % 32, pm = gid * 8 + (r % 8), pn = r / 8;
        u.q0 = pm * 256; u.p0 = pn * 256; u.kind = (type == 3) ? g8::K_OUT : (type == 4) ? g8::K_XQ : g8::K_XO;
        return true;
    }
    __device__ __forceinline__ const GAS char* ptrA(const g8::Unit& u) const { const int l = P.l;
        const size_t off = (u.kind == g8::K_IN || u.kind == g8::K_XQ) ? OFF_XB : (u.kind == g8::K_INT) ? OFF_WIN + l * SZ_WIN + (size_t)1536 * DM * 2 : (u.kind == g8::K_MEMK) ? OFF_MB : (u.kind == g8::K_MEMVT) ? OFF_WXV + l * SZ_SQ : (u.kind == g8::K_OUT) ? OFF_Y : OFF_OX;
        return (const GAS char*)(P.ws + off) + (size_t)u.q0 * (DM * 2); }
    __device__ __forceinline__ const GAS char* ptrB(const g8::Unit& u) const { const int l = P.l;
        const size_t off = (u.kind == g8::K_IN) ? OFF_WIN + l * SZ_WIN : (u.kind == g8::K_INT) ? OFF_XB : (u.kind == g8::K_MEMK) ? OFF_WXK + l * SZ_SQ : (u.kind == g8::K_MEMVT) ? OFF_MB : (u.kind == g8::K_OUT) ? OFF_WOUT + l * SZ_SQ : (u.kind == g8::K_XQ) ? OFF_WXQ + l * SZ_SQ : OFF_WXO + l * SZ_SQ;
        return (const GAS char*)(P.ws + off) + (size_t)u.p0 * (DM * 2); }
};
struct MoeSched {
    GP P; int type, G, c, sg_lo, sg_hi; const LAS int* seg; int ibase;
    __device__ __forceinline__ bool next(int i, g8::Unit& u) const {
        if (i >= 4) return false;
        const int sg = seg[256 + 4 * i]; if (sg < 0) return false;
        const int qt = seg[256 + 4 * i + 1], pt = seg[256 + 4 * i + 2];
        u.a0 = sg; u.a1 = seg[sg] - qt * 256; u.a2 = seg[64 + sg] + qt * 256; u.slot = i; u.q0 = qt * 256; u.p0 = pt * 256;
        u.kind = (type == 8) ? g8::K_MOE1 : g8::K_MOE2A;
        return true;
    }
    __device__ __forceinline__ const GAS char* ptrA(const g8::Unit& u) const { return (type == 8) ? (const GAS char*)(P.ws + OFF_XB) : (const GAS char*)(P.ws + OFF_ACT) + (size_t)u.a2 * (DE * 2); }
    __device__ __forceinline__ const GAS char* ptrB(const g8::Unit& u) const { const size_t e = (size_t)P.l * NE + (u.a0 & 31);
        return (type == 8) ? (const GAS char*)(P.ws + OFF_W13) + e * SZ_W13 + (size_t)u.p0 * (DM * 2) : (const GAS char*)(P.ws + OFF_W2) + e * SZ_W2 + (size_t)u.p0 * (DE * 2); }
};

template <bool MIDK_, unsigned KSET> struct Epi {
    static constexpr bool MIDK = MIDK_;
    GP P; LAS unsigned char* lds;
    __device__ __forceinline__ const LAS int* tokl(int slot) const { return (const LAS int*)(lds + L_TOKL) + (slot & 3) * 256; }
    __device__ __forceinline__ void midk(f32x4 (&acc)[2][2][4][2], const g8::Unit&, int wr, int fr) const {
        const LAS float* rst = (const LAS float*)(lds + L_ROWST);
#pragma unroll
        for (int ai = 0; ai < 2; ++ai)
#pragma unroll
            for (int m = 0; m < 4; ++m) { const float ratio = rst[2 * (ai * 128 + wr * 64 + m * 16 + fr)];
#pragma unroll
                for (int bj = 0; bj < 2; ++bj)
#pragma unroll
                    for (int n = 0; n < 2; ++n) acc[ai][bj][m][n] = acc[ai][bj][m][n] * ratio; }
    }
    __device__ __forceinline__ void prep(const g8::Unit& u, int b, int tid) const {
        const int kind = u.kind;
        if (kind == g8::K_OUT || kind == g8::K_XO || kind == g8::K_MOE2A) return;
        if (tid < 256) {
            float s = 1.f;
            if (kind == g8::K_IN || kind == g8::K_XQ) s = rsqrtf(rsum16(P.f(OFF_SSX), u.q0 + tid) * (1.0f / 1024.0f) + EPS);
            else if (kind == g8::K_INT) s = rsqrtf(rsum16(P.f(OFF_SSX), u.p0 + tid) * (1.0f / 1024.0f) + EPS);
            else if (kind == g8::K_MEMK) s = rsqrtf(P.f(OFF_SSM)[u.q0 + tid] * (1.0f / 1024.0f) + EPS);
            else if (kind == g8::K_MEMVT) s = rsqrtf(P.f(OFF_SSM)[u.p0 + tid] * (1.0f / 1024.0f) + EPS);
            else if (kind == g8::K_MOE1) { const int tk = tokl(u.slot)[tid]; s = rsqrtf(rsum16(P.f(OFF_SSX), tk) * (1.0f / 1024.0f) + EPS);
                ((LAS float*)(lds + L_SC2))[b * 256 + tid] = P.f(OFF_GATE)[(unsigned)tk * 2 + (u.a0 >> 5)]; }
            ((LAS float*)(lds + L_SC))[b * 256 + tid] = s;
        }
    }
    __device__ __forceinline__ void operator()(f32x4 (&acc)[2][2][4][2], const g8::Unit& u, int wid, int wr, int wc, int fr, int fq, int tid, int b) const {
        asm volatile("" : "+v"(fr), "+v"(fq), "+v"(tid));
        const int kind = u.kind;
#define EPI_CASE(K) if ((KSET >> (K)) & 1u) { if (kind == (K)) { apply<(K)>(acc, u, wr, wc, fr, fq, b); return; } }
        EPI_CASE(g8::K_IN) EPI_CASE(g8::K_INT) EPI_CASE(g8::K_MEMK) EPI_CASE(g8::K_MEMVT) EPI_CASE(g8::K_OUT) EPI_CASE(g8::K_XQ) EPI_CASE(g8::K_XO) EPI_CASE(g8::K_MOE1) EPI_CASE(g8::K_MOE2A) EPI_CASE(g8::K_MOE2B)
#undef EPI_CASE
    }
    template <int KIND> __device__ __forceinline__ void apply(f32x4 (&acc)[2][2][4][2], const g8::Unit& u, int wr, int wc, int fr, int fq, int b) const {
        const LAS float* sc = (const LAS float*)(lds + L_SC) + b * 256;
        const int cb = wc * 32 + 8 * fq;
        gbf* dst = nullptr; unsigned pitch = 0; bool act = false;
        if constexpr (KIND == g8::K_IN) { const int pt = u.p0 >> 9; dst = (pt == 0 ? P.b(OFF_U) : pt == 1 ? P.b(OFF_Q) : P.b(OFF_K)) + (size_t)u.q0 * 512 + (u.p0 & 511); pitch = 512; act = (pt == 0); }
        else if constexpr (KIND == g8::K_INT) { act = u.q0 < 512; dst = (act ? P.b(OFF_VGT) : P.b(OFF_VBT)) + (size_t)(u.q0 & 511) * T + u.p0; pitch = T; }
        else if constexpr (KIND == g8::K_MEMK) { dst = P.b(OFF_KX) + ((size_t)u.a0 * MT + u.q0) * DM + u.p0; pitch = DM; }
        else if constexpr (KIND == g8::K_MEMVT) { dst = P.b(OFF_VXT) + ((size_t)u.a0 * DM + u.q0) * MT + u.p0; pitch = MT; }
        else if constexpr (KIND == g8::K_XQ) { dst = P.b(OFF_QX) + (size_t)u.q0 * DM + u.p0; pitch = DM; }
        else if constexpr (KIND == g8::K_MOE1) { dst = P.b(OFF_ACT) + (size_t)u.a2 * DE + (u.p0 >> 8) * 128; pitch = DE; }
        else if constexpr (KIND == g8::K_MOE2A) { dst = P.b(OFF_YM) + (size_t)(u.a0 >> 5) * DM + u.p0; pitch = 2 * DM; }
        else { dst = P.b(OFF_XB) + u.p0; pitch = DM; }
        if constexpr (KIND == g8::K_OUT || KIND == g8::K_XO) {
#pragma unroll
            for (int am = 0; am < 4; ++am) { const int ai = am >> 1;
                u32x4 pre[2][2];
#pragma unroll
                for (int mm = 0; mm < 2; ++mm)
#pragma unroll
                    for (int bj = 0; bj < 2; ++bj) pre[mm][bj] = *(const GAS u32x4*)(dst + ((unsigned)(u.q0 + ai * 128 + wr * 64 + ((am & 1) * 2 + mm) * 16 + fr) * pitch + cb + bj * 128));
#pragma unroll
                for (int mm = 0; mm < 2; ++mm) { const int m = (am & 1) * 2 + mm;
                    const int r = ai * 128 + wr * 64 + m * 16 + fr, tok = u.q0 + r; float ss = 0.f;
                    float rowsc = 1.f; if constexpr (KIND == g8::K_OUT) rowsc = ((const LAS float*)(lds + L_ROWST))[2 * r + 1];
#pragma unroll
                    for (int bj = 0; bj < 2; ++bj) {
                        const f32x4 a = acc[ai][bj][m][0] * rowsc, b = acc[ai][bj][m][1] * rowsc; const u32x4 o = pre[mm][bj]; u32x4 w;
#pragma unroll
                        for (int j = 0; j < 4; ++j) {
                            const float lo = __uint_as_float(o[j] << 16) + (j < 2 ? a[2 * j] : b[2 * j - 4]), hi = __uint_as_float(o[j] & 0xffff0000u) + (j < 2 ? a[2 * j + 1] : b[2 * j - 3]);
                            const unsigned pw = pk2h(lo, hi); w[j] = pw;
                            const float rl = __uint_as_float(pw << 16), rh = __uint_as_float(pw & 0xffff0000u); ss += rl * rl + rh * rh;
                        }
                        st16_wt(dst + ((unsigned)tok * pitch + cb + bj * 128), w);
                    }
                    ss += sx<16>(ss); ss += sx<32>(ss);
                    if (fq == 0) st4_wt(P.f(OFF_SSX) + ((unsigned)tok * 16 + (u.p0 >> 8) * 4 + wc), ss);
                }
                asm volatile("" ::: "memory");
            }
            return;
        }
#pragma unroll
        for (int ai = 0; ai < 2; ++ai)
#pragma unroll
            for (int m = 0; m < 4; ++m) {
                const int r = ai * 128 + wr * 64 + m * 16 + fr;
                float ss = 0.f;
                float rowsc = 1.f; if constexpr (KIND == g8::K_IN || KIND == g8::K_MEMK || KIND == g8::K_XQ || KIND == g8::K_MOE1) rowsc = sc[r];
                float gate = 1.f; if constexpr (KIND == g8::K_MOE1) gate = ((const LAS float*)(lds + L_SC2))[b * 256 + r];
                if constexpr (KIND == g8::K_OUT) rowsc = ((const LAS float*)(lds + L_ROWST))[2 * r + 1];
                int tok = u.q0 + r; bool rowok = true;
                if constexpr (KIND == g8::K_MOE2A || KIND == g8::K_MOE2B) { rowok = r < u.a1; tok = tokl(u.slot)[r]; }
#pragma unroll
                for (int bj = 0; bj < 2; ++bj) {
                    const int c = cb + bj * 128;
                    f32x4 v0 = acc[ai][bj][m][0], v1 = acc[ai][bj][m][1];
                    if constexpr (KIND == g8::K_IN || KIND == g8::K_MEMK || KIND == g8::K_XQ) { v0 = v0 * rowsc; v1 = v1 * rowsc;
                        if (KIND == g8::K_IN && act) {
#pragma unroll
                            for (int e = 0; e < 4; ++e) { v0[e] = gelu_tanh(v0[e]); v1[e] = gelu_tanh(v1[e]); } }
                        gst8bf(dst + ((unsigned)r * pitch + c), v0, v1);
                    } else if constexpr (KIND == g8::K_INT || KIND == g8::K_MEMVT) { v0 = v0 * *(const LAS f32x4*)(sc + c); v1 = v1 * *(const LAS f32x4*)(sc + c + 4);
                        if (KIND == g8::K_INT && act) {
#pragma unroll
                            for (int e = 0; e < 4; ++e) { v0[e] = gelu_tanh(v0[e]); v1[e] = gelu_tanh(v1[e]); } }
                        gst8bf(dst + ((unsigned)r * pitch + c), v0, v1);
                    } else if constexpr (KIND == g8::K_OUT || KIND == g8::K_XO) { ss += gresid8(dst + ((unsigned)tok * pitch + c), v0 * rowsc, v1 * rowsc);
                    } else if constexpr (KIND == g8::K_MOE1) {
                        if (bj == 0) { const f32x4 b0 = acc[ai][1][m][0], b1 = acc[ai][1][m][1]; f32x4 o0, o1;
#pragma unroll
                            for (int e = 0; e < 4; ++e) { o0[e] = silu(v0[e] * rowsc) * (b0[e] * rowsc) * gate; o1[e] = silu(v1[e] * rowsc) * (b1[e] * rowsc) * gate; }
                            gst8bf(dst + ((unsigned)r * pitch + c), o0, o1); }
                    } else {
                        if (rowok) gst8bf(dst + ((unsigned)tok * pitch + c), v0 * rowsc, v1 * rowsc);
                    }
                }
                if constexpr (KIND == g8::K_OUT || KIND == g8::K_XO) {
                    ss += sx<16>(ss); ss += sx<32>(ss);
                    if (fq == 0 && rowok) P.f(OFF_SSX)[(unsigned)tok * 16 + (u.p0 >> 8) * 4 + wc] = ss;
                }
                asm volatile("" ::: "memory");
            }
    }
};

__device__ __forceinline__ bf16x8 pack8(float a0, float a1, float a2, float a3, float a4, float a5, float a6, float a7) {
    u32x4 w; w.x = pk2h(a0, a1); w.y = pk2h(a2, a3); w.z = pk2h(a4, a5); w.w = pk2h(a6, a7); return __builtin_bit_cast(bf16x8, w);
}
__device__ __forceinline__ void attn_wave_unit(const GP& P, int b, int hh, int qblk, LAS unsigned char* stg, int lane) {
    const int c = lane & 31, hi = lane >> 5, t0 = qblk * 32;
    const int pic = (c & ~12) | ((c & 4) << 1) | ((c & 8) >> 1);
    const gbf* Qp = P.b(OFF_Q) + ((size_t)b * SEQ + t0 + c) * 512 + hh * 64 + 8 * hi;
    bf16x8 qf[4];
#pragma unroll
    for (int s = 0; s < 4; ++s) qf[s] = *(const GAS bf16x8*)(Qp + 16 * s);
    const gbf* Kb = P.b(OFF_K) + ((size_t)b * SEQ + pic) * 512 + hh * 64 + 8 * hi;
    const gbf* Vb = P.b(OFF_VBT) + ((size_t)hh * 64 + c) * T + (size_t)b * SEQ + 8 * hi;
    f32x16 o0, o1;
#pragma unroll
    for (int r = 0; r < 16; ++r) { o0[r] = 0.f; o1[r] = 0.f; }
    float R = 1.f;
    bf16x8 kf[4], vf[2][2], kn[4], vn[2][2];
#pragma unroll
    for (int s = 0; s < 4; ++s) kf[s] = *(const GAS bf16x8*)(Kb + (size_t)t0 * 512 + 16 * s);
#pragma unroll
    for (int s = 0; s < 2; ++s)
#pragma unroll
        for (int d = 0; d < 2; ++d) vf[s][d] = *(const GAS bf16x8*)(Vb + (size_t)d * 32 * T + t0 + 16 * s);
#define ATT_TILE(DIAG, key0) do { \
        const int kp = (key0) >= 32 ? (key0) - 32 : 0;                    \
        _Pragma("unroll") for (int s = 0; s < 4; ++s) kn[s] = *(const GAS bf16x8*)(Kb + (size_t)kp * 512 + 16 * s); \
        _Pragma("unroll") for (int s = 0; s < 2; ++s) _Pragma("unroll") for (int d = 0; d < 2; ++d) vn[s][d] = *(const GAS bf16x8*)(Vb + (size_t)d * 32 * T + kp + 16 * s); \
        f32x16 x; _Pragma("unroll") for (int r = 0; r < 16; ++r) x[r] = 0.f; \
        _Pragma("unroll") for (int s = 0; s < 4; ++s) x = MFMA32(kf[s], qf[s], x); \
        float rr[16], be[16];                                             \
        _Pragma("unroll") for (int r = 0; r < 16; ++r) { \
            float e = __builtin_amdgcn_exp2f(fminf(x[r], 100.0f));        \
            if (DIAG) { const int krel = 16 * (r >> 3) + 8 * hi + (r & 7); e = (krel < c) ? e : 0.f; }                    \
            const float rc = __builtin_amdgcn_rcpf(1.0f + e); rr[r] = rc; be[r] = e * rc; } \
        float pA = 1.f, pB = 1.f; \
        _Pragma("unroll") for (int r = 7; r >= 0; --r) { const float t = rr[r]; rr[r] = pA; pA *= t; } \
        _Pragma("unroll") for (int r = 15; r >= 8; --r) { const float t = rr[r]; rr[r] = pB; pB *= t; } \
        const float pAp = sx<32>(pA), pBp = sx<32>(pB); \
        const float baseA = R * ((hi ? 1.f : pAp) * (pB * pBp)), baseB = R * (hi ? 1.f : pBp); \
        float a[16]; \
        _Pragma("unroll") for (int r = 0; r < 8; ++r) a[r] = be[r] * (rr[r] * baseA); \
        _Pragma("unroll") for (int r = 8; r < 16; ++r) a[r] = be[r] * (rr[r] * baseB); \
        R *= (pA * pAp) * (pB * pBp); \
        const bf16x8 pa0 = pack8(a[0], a[1], a[2], a[3], a[4], a[5], a[6], a[7]), pa1 = pack8(a[8], a[9], a[10], a[11], a[12], a[13], a[14], a[15]); \
        o0 = MFMA32(pa0, vf[0][0], o0); o1 = MFMA32(pa0, vf[0][1], o1); \
        o0 = MFMA32(pa1, vf[1][0], o0); o1 = MFMA32(pa1, vf[1][1], o1); \
        _Pragma("unroll") for (int s = 0; s < 4; ++s) kf[s] = kn[s]; \
        _Pragma("unroll") for (int s = 0; s < 2; ++s) _Pragma("unroll") for (int d = 0; d < 2; ++d) vf[s][d] = vn[s][d]; } while (0)
    ATT_TILE(true, t0);
    for (int key0 = t0 - 32; key0 >= 0; key0 -= 32) {
        if (__all(R == 0.f)) break;
        ATT_TILE(false, key0);
    }
#undef ATT_TILE
    LAS bf16_t* st = (LAS bf16_t*)stg;
#pragma unroll
    for (int r = 0; r < 16; ++r) { const int row = (r & 3) + 8 * (r >> 2) + 4 * hi; st[row * 64 + c] = f2bfh(o0[r]); st[row * 64 + 32 + c] = f2bfh(o1[r]); }
    asm volatile("s_waitcnt lgkmcnt(0)" ::: "memory");
#pragma unroll
    for (int i = 0; i < 4; ++i) {
        const int row = i * 8 + (lane >> 3), ch = lane & 7; const u32x4 v = *(const LAS u32x4*)(st + row * 64 + ch * 8);
        const size_t tok = (size_t)b * SEQ + t0 + row;
        *(GAS u32x4*)(P.b(OFF_Y) + tok * DM + 512 + hh * 64 + ch * 8) = v;
        float ss = 0.f;
#pragma unroll
        for (int j = 0; j < 4; ++j) { const float lo = __uint_as_float(v[j] << 16), hi2 = __uint_as_float(v[j] & 0xffff0000u); ss += lo * lo + hi2 * hi2; }
        ss += sx<1>(ss); ss += sx<2>(ss); ss += sx<4>(ss);
        if (ch == 0) P.f(OFF_SSB)[tok * 8 + hh] = ss;
    }
    asm volatile("s_waitcnt lgkmcnt(0)" ::: "memory");
}
constexpr int AT_RING = 0, AT_STG = L_TOKL, AT_FLAGS = L_MISC + 256;
__device__ __forceinline__ void attn_block(const GP& P, int b, int hh, int sub, LAS unsigned char* lds, int tid, int wave, int lane) {
    const int c = lane & 31, hi = lane >> 5;
    const int pic = (c & ~12) | ((c & 4) << 1) | ((c & 8) >> 1);
    const GAS char* src0; int tstride;
    if (wave < 4) { const int row = tid >> 3, ch = (tid & 7) ^ ((row >> 1) & 7); src0 = (const GAS char*)(P.b(OFF_K) + ((size_t)b * SEQ + row) * 512 + hh * 64 + ch * 8); tstride = 32 * 512 * 2; }
    else { const int t2 = tid - 256, row = t2 >> 2, ch = (t2 & 3) ^ ((row >> 2) & 3); src0 = (const GAS char*)(P.b(OFF_VBT) + ((size_t)hh * 64 + row) * T + (size_t)b * SEQ + ch * 8); tstride = 32 * 2; }
    tstride = __builtin_amdgcn_readfirstlane(tstride);
    int koff[4], voff[2][2];
#pragma unroll
    for (int s = 0; s < 4; ++s) koff[s] = pic * 128 + (((hi + 2 * s) ^ ((pic >> 1) & 7)) * 16);
#pragma unroll
    for (int s = 0; s < 2; ++s)
#pragma unroll
        for (int d = 0; d < 2; ++d) { const int vr = c + 32 * d; voff[s][d] = 4096 + vr * 64 + (((hi + 2 * s) ^ ((vr >> 2) & 3)) * 16); }
    LAS unsigned char* ring = lds + AT_RING;
    volatile LAS int* flags = (volatile LAS int*)(lds + AT_FLAGS);
    bool resident = false;
#pragma unroll 1
    for (int sweep = 0; sweep < 2; ++sweep) {
        const int base = sub * 16 + (sweep == 0 ? 8 : 0), qi = base + wave, top = base + 7, t0 = qi * 32;
        const gbf* Qp = P.b(OFF_Q) + ((size_t)b * SEQ + t0 + c) * 512 + hh * 64 + 8 * hi;
        bf16x8 qf[4];
#pragma unroll
        for (int s = 0; s < 4; ++s) qf[s] = *(const GAS bf16x8*)(Qp + 16 * s);
        f32x16 o0, o1;
#pragma unroll
        for (int r = 0; r < 16; ++r) { o0[r] = 0.f; o1[r] = 0.f; }
        float R = 1.f;
        int done = 0;
        __syncthreads();
        int jhi = top;
#pragma unroll 1
        for (int round = 0;; ++round) {
            if (round > 0) {
                if (lane == 0) flags[wave] = done;
                asm volatile("s_waitcnt lgkmcnt(0)" ::: "memory"); __builtin_amdgcn_s_barrier(); asm volatile("" ::: "memory");
                const LAS unsigned* fl = (const LAS unsigned*)(lds + AT_FLAGS); const u32x4 f0 = *(const LAS u32x4*)fl, f1 = *(const LAS u32x4*)(fl + 4);
                if (((f0[0] & f0[1]) & (f0[2] & f0[3])) & ((f1[0] & f1[1]) & (f1[2] & f1[3]))) break;
                resident = false;
            }
#pragma unroll
            for (int p = 0; p < 16; ++p) { const int tile = jhi - p;
                if (tile >= 0 && !(round == 0 && resident && p < 8))
                    __builtin_amdgcn_global_load_lds((const GAS unsigned*)(src0 + (size_t)tile * (size_t)tstride), (LAS unsigned*)(ring + (tile & 15) * 8192 + wave * 1024), 16, 0, 0); }
            asm volatile("s_waitcnt vmcnt(0)" ::: "memory"); __builtin_amdgcn_s_barrier(); asm volatile("" ::: "memory");
            const int jend = (jhi - 15) > 0 ? (jhi - 15) : 0;
#pragma unroll 1
            for (int j = (qi < jhi ? qi : jhi); j >= jend && !done; --j) {
                const LAS unsigned char* sl = ring + (j & 15) * 8192;
                bf16x8 kf[4], vf[2][2];
#pragma unroll
                for (int s = 0; s < 4; ++s) kf[s] = *(const LAS bf16x8*)(sl + koff[s]);
#pragma unroll
                for (int s = 0; s < 2; ++s)
#pragma unroll
                    for (int d = 0; d < 2; ++d) vf[s][d] = *(const LAS bf16x8*)(sl + voff[s][d]);
                f32x16 x;
#pragma unroll
                for (int r = 0; r < 16; ++r) x[r] = 0.f;
#pragma unroll
                for (int s = 0; s < 4; ++s) x = MFMA32(kf[s], qf[s], x);
                const bool diag = (j == qi);
                float rr[16], be[16];
#pragma unroll
                for (int r = 0; r < 16; ++r) {
                    float e = __builtin_amdgcn_exp2f(__builtin_amdgcn_fmed3f(x[r], -1000.0f, 100.0f));
                    const int krel = 16 * (r >> 3) + 8 * hi + (r & 7); e = (!diag || krel < c) ? e : 0.f;
                    const float rc = __builtin_amdgcn_rcpf(1.0f + e); rr[r] = rc; be[r] = e * rc; }
                float PA[9], PB[9]; PA[8] = 1.f; PB[8] = 1.f;
#pragma unroll
                for (int r = 7; r >= 0; --r) { PA[r] = PA[r + 1] * rr[r]; PB[r] = PB[r + 1] * rr[8 + r]; }
                const float pA = PA[0], pB = PB[0], pAp = sx<32>(pA), pBp = sx<32>(pB);
                const float baseA = R * ((hi ? 1.f : pAp) * (pB * pBp)), baseB = R * (hi ? 1.f : pBp);
                float a[16];
#pragma unroll
                for (int r = 0; r < 8; ++r) { a[r] = be[r] * (PA[r + 1] * baseA); a[8 + r] = be[8 + r] * (PB[r + 1] * baseB); }
                R *= (pA * pAp) * (pB * pBp);
                const bf16x8 pa0 = pack8(a[0], a[1], a[2], a[3], a[4], a[5], a[6], a[7]), pa1 = pack8(a[8], a[9], a[10], a[11], a[12], a[13], a[14], a[15]);
                o0 = MFMA32(pa0, vf[0][0], o0); o1 = MFMA32(pa0, vf[0][1], o1);
                o0 = MFMA32(pa1, vf[1][0], o0); o1 = MFMA32(pa1, vf[1][1], o1);
                done = __all(R == 0.f) ? 1 : 0;
            }
            jhi -= 16;
            if (jhi < 0) break;
        }
        resident = (sweep == 0) && (jhi == top - 16);
        LAS bf16_t* st = (LAS bf16_t*)(lds + AT_STG + wave * 2048);
        float ss2[2] = {0.f, 0.f};
#pragma unroll
        for (int half = 0; half < 2; ++half) {
#pragma unroll
            for (int r = 0; r < 16; ++r) { const int row = (r & 3) + 8 * (r >> 2) + 4 * hi; st[row * 32 + c] = f2bfh(half ? o1[r] : o0[r]); }
            asm volatile("s_waitcnt lgkmcnt(0)" ::: "memory");
#pragma unroll
            for (int i = 0; i < 2; ++i) {
                const int row = i * 16 + (lane >> 2), ch = lane & 3; const u32x4 v = *(const LAS u32x4*)(st + row * 32 + ch * 8);
                const size_t tok = (size_t)b * SEQ + t0 + row;
                *(GAS u32x4*)(P.b(OFF_Y) + tok * DM + 512 + hh * 64 + half * 32 + ch * 8) = v;
#pragma unroll
                for (int j2 = 0; j2 < 4; ++j2) { const float lo = __uint_as_float(v[j2] << 16), hi2 = __uint_as_float(v[j2] & 0xffff0000u); ss2[i] += lo * lo + hi2 * hi2; }
            }
            asm volatile("s_waitcnt lgkmcnt(0)" ::: "memory");
        }
#pragma unroll
        for (int i = 0; i < 2; ++i) { float ss = ss2[i]; ss += sx<1>(ss); ss += sx<2>(ss);
            if ((lane & 3) == 0) P.f(OFF_SSB)[((size_t)b * SEQ + t0 + i * 16 + (lane >> 2)) * 8 + hh] = ss; }
    }
}
constexpr int GM_RS = L_TOKL;
__device__ __forceinline__ void gmlp_block(const GP& P, const gfl* v_norm, const gfl* b_sp, int vcu, LAS unsigned char* lds, int tid, int wave, int lane) {
    const int c = lane & 31, hi = lane >> 5, bc = vcu >> 1, g2 = wave >> 2, g = (vcu & 1) * 2 + g2, tblk = wave & 3, tok0 = bc * 128, l = P.l;
    { const GAS char* vsrc = (const GAS char*)(P.b(OFF_VGT) + (size_t)((vcu & 1) * 256) * T + tok0);
      const GAS char* wsrc = (const GAS char*)(P.b(OFF_WS + l * SZ_WS) + (size_t)((vcu & 1) * 256) * CHUNK);
#pragma unroll
      for (int i = 0; i < 8; ++i) { const int row = i * 32 + (tid >> 4), ch = (tid & 15) ^ (row & 15);
          __builtin_amdgcn_global_load_lds((const GAS unsigned*)(vsrc + ((size_t)row * T + ch * 8) * 2), (LAS unsigned*)(lds + i * 8192 + wave * 1024), 16, 0, 0); }
#pragma unroll
      for (int i = 0; i < 8; ++i) { const int row = i * 32 + (tid >> 4), ch = (tid & 15) ^ (row & 15);
          __builtin_amdgcn_global_load_lds((const GAS unsigned*)(wsrc + ((size_t)row * CHUNK + ch * 8) * 2), (LAS unsigned*)(lds + 65536 + i * 8192 + wave * 1024), 16, 0, 0); } }
    const int row = lane >> 1, half = lane & 1, t = tblk * 32 + row;
    const size_t tok = (size_t)tok0 + t;
    u32x4 uq[4][2]; float gains[4];
#pragma unroll
    for (int cb = 0; cb < 4; ++cb) { const int col = g * 128 + cb * 32 + half * 16;
        uq[cb][0] = *(const GAS u32x4*)(P.b(OFF_U) + tok * 512 + col); uq[cb][1] = *(const GAS u32x4*)(P.b(OFF_U) + tok * 512 + col + 8);
        gains[cb] = v_norm[(size_t)l * AW + g * 128 + cb * 32 + c]; }
    const float bt = b_sp[(size_t)l * AG * CHUNK + g * CHUNK + t];
    f32x16 acc[4];
#pragma unroll
    for (int cb = 0; cb < 4; ++cb)
#pragma unroll
        for (int r = 0; r < 16; ++r) acc[cb][r] = 0.f;
    asm volatile("s_waitcnt vmcnt(0)" ::: "memory"); __builtin_amdgcn_s_barrier(); asm volatile("" ::: "memory");
    {
      const int gs = tid >> 8, pos = (tid >> 1) & 127, hf = tid & 1; float s = 0.f;
#pragma unroll 16
      for (int k = 0; k < 64; ++k) { const int row = gs * 128 + hf * 64 + k;
          const float f = bf2f(*(const LAS bf16_t*)(lds + row * 256 + ((((pos >> 3) ^ (row & 15))) << 4) + (pos & 7) * 2)); s += f * f; }
      s += sx<1>(s);
      if (hf == 0) ((LAS float*)(lds + GM_RS))[gs * 128 + pos] = rsqrtf(s * (1.0f / 128.0f) + EPS); }
    asm volatile("s_waitcnt lgkmcnt(0)" ::: "memory"); __builtin_amdgcn_s_barrier(); asm volatile("" ::: "memory");
    const int nks = 2 * (tblk + 1);
    const LAS unsigned char* vb = lds + (g2 * 128 + c) * 256; const LAS unsigned char* wb = lds + 65536 + (g2 * 128 + tblk * 32 + c) * 256; const LAS float* rsl = (const LAS float*)(lds + GM_RS) + g2 * 128 + 8 * hi;
#pragma unroll 2
    for (int ks = 0; ks < nks; ++ks) {
        const int so = ((2 * ks + hi) ^ (c & 15)) << 4;
        bf16x8 vf[4];
#pragma unroll
        for (int cb = 0; cb < 4; ++cb) vf[cb] = *(const LAS bf16x8*)(vb + cb * 32 * 256 + so);
        const bf16x8 wf = *(const LAS bf16x8*)(wb + so);
        const f32x4 r0 = *(const LAS f32x4*)(rsl + 16 * ks), r1 = *(const LAS f32x4*)(rsl + 16 * ks + 4);
        float w[8];
#pragma unroll
        for (int j = 0; j < 8; ++j) w[j] = bf2f((bf16_t)wf[j]) * (j < 4 ? r0[j] : r1[j - 4]);
        const bf16x8 ws = pack8(w[0], w[1], w[2], w[3], w[4], w[5], w[6], w[7]);
#pragma unroll
        for (int cb = 0; cb < 4; ++cb) acc[cb] = MFMA32(ws, vf[cb], acc[cb]);
    }
    asm volatile("s_waitcnt lgkmcnt(0)" ::: "memory"); __syncthreads();
    LAS unsigned char* stg = lds + wave * 8192;
    LAS float* st = (LAS float*)stg;
    float ss = 0.f;
#pragma unroll
    for (int cb = 0; cb < 4; ++cb) {
        const float gain = gains[cb];
#pragma unroll
        for (int r = 0; r < 16; ++r) st[((r & 3) + 8 * (r >> 2) + 4 * hi) * 36 + c] = gain * acc[cb][r];
        asm volatile("s_waitcnt lgkmcnt(0)" ::: "memory");
        const int col = g * 128 + cb * 32 + half * 16;
        const u32x4 u0 = uq[cb][0], u1 = uq[cb][1];
        float mx[16];
#pragma unroll
        for (int j = 0; j < 4; ++j) { const f32x4 mv = *(const LAS f32x4*)(st + row * 36 + half * 16 + 4 * j); mx[4 * j] = mv[0] + bt; mx[4 * j + 1] = mv[1] + bt; mx[4 * j + 2] = mv[2] + bt; mx[4 * j + 3] = mv[3] + bt; }
        asm volatile("s_waitcnt lgkmcnt(0)" ::: "memory");
        u32x4 y0, y1;
#pragma unroll
        for (int j = 0; j < 4; ++j) {
            const float ua = __uint_as_float(u0[j] << 16), ub = __uint_as_float(u0[j] & 0xffff0000u), uc = __uint_as_float(u1[j] << 16), ud = __uint_as_float(u1[j] & 0xffff0000u);
            const unsigned w0 = pk2h(ua * mx[2 * j], ub * mx[2 * j + 1]), w1 = pk2h(uc * mx[8 + 2 * j], ud * mx[8 + 2 * j + 1]);
            y0[j] = w0; y1[j] = w1;
            const float f0 = __uint_as_float(w0 << 16), f1 = __uint_as_float(w0 & 0xffff0000u), f2 = __uint_as_float(w1 << 16), f3 = __uint_as_float(w1 & 0xffff0000u);
            ss += (f0 * f0 + f1 * f1) + (f2 * f2 + f3 * f3);
        }
        *(GAS u32x4*)(P.b(OFF_Y) + tok * DM + col) = y0; *(GAS u32x4*)(P.b(OFF_Y) + tok * DM + col + 8) = y1;
    }
    ss += sx<1>(ss);
    if (half == 0) P.f(OFF_SSA)[((size_t)tok0 + t) * 4 + g] = ss;
}
__device__ __forceinline__ void gmlp_wave_unit(const GP& P, const gfl* v_norm, const gfl* b_sp, int bc, int g, int tblk, LAS unsigned char* stg, int lane) {
    const int c = lane & 31, hi = lane >> 5, tok0 = bc * 128, l = P.l;
    const gbf* Wp = P.b(OFF_WS + l * SZ_WS) + ((size_t)g * CHUNK + tblk * 32 + c) * CHUNK + 8 * hi;
    const gbf* Vp = P.b(OFF_VGT) + ((size_t)g * 128 + c) * T + tok0 + 8 * hi;
    f32x16 acc[4];
#pragma unroll
    for (int cb = 0; cb < 4; ++cb)
#pragma unroll
        for (int r = 0; r < 16; ++r) acc[cb][r] = 0.f;
    const int nks = 2 * (tblk + 1);
    bf16x8 vf[4], vnx[4], wf, wnx;
#pragma unroll
    for (int cb = 0; cb < 4; ++cb) vf[cb] = *(const GAS bf16x8*)(Vp + (size_t)cb * 32 * T);
    wf = *(const GAS bf16x8*)(Wp);
    for (int ks = 0; ks < nks; ++ks) {
        const int kn_ = (ks + 1 < nks) ? ks + 1 : ks;
#pragma unroll
        for (int cb = 0; cb < 4; ++cb) vnx[cb] = *(const GAS bf16x8*)(Vp + (size_t)cb * 32 * T + 16 * kn_);
        wnx = *(const GAS bf16x8*)(Wp + 16 * kn_);
        float ssq[8];
#pragma unroll
        for (int j = 0; j < 8; ++j) { ssq[j] = 0.f;
#pragma unroll
            for (int cb = 0; cb < 4; ++cb) { const float f = bf2f((bf16_t)vf[cb][j]); ssq[j] += f * f; } }
#pragma unroll
        for (int j = 0; j < 8; ++j) { ssq[j] += sx<1>(ssq[j]); ssq[j] += sx<2>(ssq[j]); ssq[j] += sx<4>(ssq[j]); ssq[j] += sx<8>(ssq[j]); ssq[j] += sx<16>(ssq[j]); }
        float w[8];
#pragma unroll
        for (int j = 0; j < 8; ++j) w[j] = bf2f((bf16_t)wf[j]) * rsqrtf(ssq[j] * (1.0f / 128.0f) + EPS);
        const bf16x8 ws = pack8(w[0], w[1], w[2], w[3], w[4], w[5], w[6], w[7]);
#pragma unroll
        for (int cb = 0; cb < 4; ++cb) acc[cb] = MFMA32(ws, vf[cb], acc[cb]);
#pragma unroll
        for (int cb = 0; cb < 4; ++cb) vf[cb] = vnx[cb];
        wf = wnx;
    }
    LAS float* st = (LAS float*)stg;
    const int row = lane >> 1, half = lane & 1, t = tblk * 32 + row;
    const float bt = b_sp[(size_t)l * AG * CHUNK + g * CHUNK + t];
    float ss = 0.f;
#pragma unroll
    for (int cb = 0; cb < 4; ++cb) {
        const float gain = v_norm[(size_t)l * AW + g * 128 + cb * 32 + c];
#pragma unroll
        for (int r = 0; r < 16; ++r) st[((r & 3) + 8 * (r >> 2) + 4 * hi) * 36 + c] = gain * acc[cb][r];
        asm volatile("s_waitcnt lgkmcnt(0)" ::: "memory");
        const size_t tok = (size_t)tok0 + t; const int col = g * 128 + cb * 32 + half * 16;
        const u32x4 u0 = *(const GAS u32x4*)(P.b(OFF_U) + tok * 512 + col), u1 = *(const GAS u32x4*)(P.b(OFF_U) + tok * 512 + col + 8);
        float mx[16];
#pragma unroll
        for (int j = 0; j < 4; ++j) { const f32x4 mv = *(const LAS f32x4*)(st + row * 36 + half * 16 + 4 * j); mx[4 * j] = mv[0] + bt; mx[4 * j + 1] = mv[1] + bt; mx[4 * j + 2] = mv[2] + bt; mx[4 * j + 3] = mv[3] + bt; }
        asm volatile("s_waitcnt lgkmcnt(0)" ::: "memory");
        u32x4 y0, y1;
#pragma unroll
        for (int j = 0; j < 4; ++j) {
            const float ua = __uint_as_float(u0[j] << 16), ub = __uint_as_float(u0[j] & 0xffff0000u), uc = __uint_as_float(u1[j] << 16), ud = __uint_as_float(u1[j] & 0xffff0000u);
            const unsigned w0 = pk2h(ua * mx[2 * j], ub * mx[2 * j + 1]), w1 = pk2h(uc * mx[8 + 2 * j], ud * mx[8 + 2 * j + 1]);
            y0[j] = w0; y1[j] = w1;
            const float f0 = __uint_as_float(w0 << 16), f1 = __uint_as_float(w0 & 0xffff0000u), f2 = __uint_as_float(w1 << 16), f3 = __uint_as_float(w1 & 0xffff0000u);
            ss += (f0 * f0 + f1 * f1) + (f2 * f2 + f3 * f3);
        }
        *(GAS u32x4*)(P.b(OFF_Y) + tok * DM + col) = y0; *(GAS u32x4*)(P.b(OFF_Y) + tok * DM + col + 8) = y1;
    }
    ss += sx<1>(ss);
    if (half == 0) P.f(OFF_SSA)[((size_t)tok0 + t) * 4 + g] = ss;
}
__device__ __forceinline__ void xattn_block(const GP& P, int tokgrp, int hh, LAS unsigned char* lds, int tid, int wave, int lane) {
    const int c = lane & 31, hi = lane >> 5, tok0 = tokgrp * 256 + wave * 32, b = (tokgrp * 256) / SEQ, l = P.l;
    const int pic = (c & ~12) | ((c & 4) << 1) | ((c & 8) >> 1);
    const GAS char* Qb = (const GAS char*)(P.b(OFF_QX) + (size_t)(tokgrp * 256) * DM + hh * 256);
    const unsigned qoff = (unsigned)((wave * 32 + c) * DM + 8 * hi) * 2u;
    const GAS char* Kg = (const GAS char*)(P.b(OFF_KX) + ((size_t)l * MT + b * MEML) * DM + hh * 256);
    const GAS char* Vg = (const GAS char*)(P.b(OFF_VXT) + ((size_t)l * DM + hh * 256) * MT + b * MEML);
    const unsigned koff = (unsigned)((tid >> 3) * DM + (((tid & 7) ^ ((tid >> 4) & 7)) * 8)) * 2u, voff = (unsigned)((tid >> 5) * MT + (((tid & 31) ^ ((tid >> 5) & 15)) * 8)) * 2u;
#define XA_DMA(st) do { LAS unsigned char* sl_ = lds + ((st) % 3) * 32768 + wave * 1024; \
        if ((st) < 4) { const GAS char* bs = Kg + (size_t)(st) * 128 + koff; _Pragma("unroll") for (int i = 0; i < 4; ++i) __builtin_amdgcn_global_load_lds((const GAS unsigned*)(bs + (size_t)i * (64 * DM * 2)), (LAS unsigned*)(sl_ + i * 8192), 16, 0, 0); } \
        else { const GAS char* bs = Vg + (size_t)((st) - 4) * (64 * MT * 2) + voff; _Pragma("unroll") for (int i = 0; i < 4; ++i) __builtin_amdgcn_global_load_lds((const GAS unsigned*)(bs + (size_t)i * (16 * MT * 2)), (LAS unsigned*)(sl_ + i * 8192), 16, 0, 0); } } while (0)
#define XA_LOADQ(st, q) do { const GAS char* bs = Qb + (size_t)(st) * 128; _Pragma("unroll") for (int s = 0; s < 4; ++s) q[s] = *(const GAS bf16x8*)(bs + s * 32 + qoff); } while (0)
#define XA_SYNC do { asm volatile("s_waitcnt vmcnt(8)" ::: "memory"); __builtin_amdgcn_s_barrier(); asm volatile("" ::: "memory"); } while (0)
    int kaddr[4];
#pragma unroll
    for (int s = 0; s < 4; ++s) kaddr[s] = pic * 128 + (((2 * s + hi) ^ ((pic >> 1) & 7)) << 4);
    f32x16 x[8];
#pragma unroll
    for (int mb = 0; mb < 8; ++mb)
#pragma unroll
        for (int r = 0; r < 16; ++r) x[mb][r] = 0.f;
    bf16x8 qa[4], qb[4];
    XA_DMA(0); XA_DMA(1); XA_LOADQ(0, qa);
#pragma unroll 1
    for (int st2 = 0; st2 < 4; st2 += 2) {
        { XA_SYNC; XA_DMA(st2 + 2); XA_LOADQ(st2 + 1, qb);
          const LAS unsigned char* buf = lds + (st2 % 3) * 32768;
#pragma unroll
          for (int s = 0; s < 4; ++s)
#pragma unroll
              for (int mb = 0; mb < 8; ++mb) { const bf16x8 kf = *(const LAS bf16x8*)(buf + kaddr[s] + mb * 4096); x[mb] = MFMA32(kf, qa[s], x[mb]); } }
        { XA_SYNC; XA_DMA(st2 + 3); if (st2 == 0) XA_LOADQ(2, qa);
          const LAS unsigned char* buf = lds + ((st2 + 1) % 3) * 32768;
#pragma unroll
          for (int s = 0; s < 4; ++s)
#pragma unroll
              for (int mb = 0; mb < 8; ++mb) { const bf16x8 kf = *(const LAS bf16x8*)(buf + kaddr[s] + mb * 4096); x[mb] = MFMA32(kf, qb[s], x[mb]); } }
    }
    float m = -INFINITY;
#pragma unroll
    for (int mb = 0; mb < 8; ++mb)
#pragma unroll
        for (int r = 0; r < 16; ++r) m = fmaxf(m, x[mb][r]);
    m = fmaxf(m, sx<32>(m));
    float sum = 0.f;
#pragma unroll
    for (int mb = 0; mb < 8; ++mb)
#pragma unroll
        for (int r = 0; r < 16; ++r) { x[mb][r] = __builtin_amdgcn_exp2f(x[mb][r] - m); sum += x[mb][r]; }
    sum += sx<32>(sum);
    const float inv = 1.0f / sum;
    bf16x8 pa[8][2];
#pragma unroll
    for (int mb = 0; mb < 8; ++mb)
#pragma unroll
        for (int s = 0; s < 2; ++s)
            pa[mb][s] = pack8(x[mb][8 * s] * inv, x[mb][8 * s + 1] * inv, x[mb][8 * s + 2] * inv, x[mb][8 * s + 3] * inv, x[mb][8 * s + 4] * inv, x[mb][8 * s + 5] * inv, x[mb][8 * s + 6] * inv, x[mb][8 * s + 7] * inv);
    LAS bf16_t* stg = (LAS bf16_t*)(lds + 98304 + wave * 4096);
    int vaddr[8]; { int c2 = c, h2 = hi; asm volatile("" : "+v"(c2), "+v"(h2));
#pragma unroll
        for (int q = 0; q < 8; ++q) vaddr[q] = c2 * 512 + ((((q >> 1) * 4 + (q & 1) * 2 + h2) ^ (c2 & 15)) << 4); }
#pragma unroll 1
    for (int st = 4; st < 8; ++st) {
        XA_SYNC; if (st < 6) XA_DMA(st + 2);
        const LAS unsigned char* buf = lds + (st % 3) * 32768;
        f32x16 o0, o1;
#pragma unroll
        for (int r = 0; r < 16; ++r) { o0[r] = 0.f; o1[r] = 0.f; }
#pragma unroll
        for (int mb = 0; mb < 8; ++mb)
#pragma unroll
            for (int s = 0; s < 2; ++s) { const int va = vaddr[(mb & 3) * 2 + s] + (mb >> 2) * 256;
                const bf16x8 v0 = *(const LAS bf16x8*)(buf + va), v1 = *(const LAS bf16x8*)(buf + va + 32 * 512);
                o0 = MFMA32(pa[mb][s], v0, o0); o1 = MFMA32(pa[mb][s], v1, o1); }
#pragma unroll
        for (int r = 0; r < 16; ++r) { const int row = (r & 3) + 8 * (r >> 2) + 4 * hi; stg[row * 64 + c] = f2bfh(o0[r]); stg[row * 64 + 32 + c] = f2bfh(o1[r]); }
        asm volatile("s_waitcnt lgkmcnt(0)" ::: "memory");
        { GAS char* ob = (GAS char*)(P.b(OFF_OX) + (size_t)tok0 * DM + hh * 256 + (st - 4) * 64);
#pragma unroll
        for (int i = 0; i < 4; ++i) { const int row = i * 8 + (lane >> 3), ch = lane & 7; const u32x4 v = *(const LAS u32x4*)(stg + row * 64 + ch * 8);
            st16_wt(ob + (unsigned)(row * DM + ch * 8) * 2u, v); } }
        asm volatile("s_waitcnt lgkmcnt(0)" ::: "memory");
    }
#undef XA_DMA
#undef XA_LOADQ
#undef XA_SYNC
}
__device__ __forceinline__ void router_block(const GP& P, const gfl* b_group, const gfl* b_router, int tokblk0, LAS unsigned char* ldsbase, int wave, int lane) {
    const int c = lane & 31, hi = lane >> 5, tok0 = (tokblk0 + (wave >> 2)) * 32, kq = wave & 3, l = P.l;
    const gbf* Xp = P.b(OFF_XB) + ((size_t)tok0 + c) * DM + kq * 256 + 8 * hi;
    const gbf* Wp = P.b(OFF_WR + l * SZ_WR) + (size_t)c * DM + kq * 256 + 8 * hi;
    f32x16 d0, d1;
#pragma unroll
    for (int r = 0; r < 16; ++r) { d0[r] = 0.f; d1[r] = 0.f; }
#pragma unroll 8
    for (int s = 0; s < 16; ++s) {
        const bf16x8 a = *(const GAS bf16x8*)(Xp + 16 * s), w0 = *(const GAS bf16x8*)(Wp + 16 * s), w1 = *(const GAS bf16x8*)(Wp + (size_t)32 * DM + 16 * s);
        d0 = MFMA32(a, w0, d0); d1 = MFMA32(a, w1, d1);
    }
    LAS float* st = (LAS float*)(ldsbase + wave * 8192);
#pragma unroll
    for (int r = 0; r < 16; ++r) { const int row = (r & 3) + 8 * (r >> 2) + 4 * hi; st[row * 40 + c] = d0[r]; if (c < 4) st[row * 40 + 32 + c] = d1[r]; }
    __syncthreads();
    if (kq == 0 && lane < 32) {
        const LAS float* s0 = st + lane * 40; const LAS float* s1 = s0 + 2048; const LAS float* s2 = s0 + 4096; const LAS float* s3 = s0 + 6144;
        const int tok = tok0 + lane; const float rs = rsqrtf(rsum16(P.f(OFF_SSX), tok) * (1.0f / 1024.0f) + EPS);
        float gl[4];
#pragma unroll
        for (int i = 0; i < 4; ++i) gl[i] = ((s0[32 + i] + s1[32 + i]) + (s2[32 + i] + s3[32 + i])) * rs + b_group[l * NG + i];
        int gs = 0; float gm = gl[0];
#pragma unroll
        for (int i = 1; i < 4; ++i) if (gl[i] > gm) { gm = gl[i]; gs = i; }
        float den = 0.f;
#pragma unroll
        for (int i = 0; i < 4; ++i) den += __expf(gl[i] - gm);
        const float pg = 1.0f / den;
        float v1 = -INFINITY, v2 = -INFINITY; int i1 = 0, i2 = 0;
#pragma unroll
        for (int i = 0; i < 8; ++i) { const int n = gs * 8 + i; const float e = ((s0[n] + s1[n]) + (s2[n] + s3[n])) * rs + b_router[l * NE + n];
            if (e > v1) { v2 = v1; i2 = i1; v1 = e; i1 = i; } else if (e > v2) { v2 = e; i2 = i; } }
        const float w1 = 1.0f / (1.0f + __expf(v2 - v1)), w2 = 1.0f - w1;
        const int e1 = gs * 8 + i1, e2 = gs * 8 + i2;
        const int rep = (tok0 >> 5) & 7; int* cnt = (int*)(P.i(OFF_CTL) + CW_CNTP + l * 64 * 8 * 32);
        const int p1 = atomicAdd(cnt + (e1 * 8 + rep) * 32, 1), p2 = atomicAdd(cnt + ((32 + e2) * 8 + rep) * 32, 1);
        P.i(OFF_PERM)[(size_t)(e1 * 8 + rep) * (T / 8) + p1] = tok; P.i(OFF_PERM)[(size_t)((32 + e2) * 8 + rep) * (T / 8) + p2] = tok;
        P.f(OFF_GATE)[(size_t)tok * 2] = pg * w1; P.f(OFF_GATE)[(size_t)tok * 2 + 1] = pg * w2;
    }
}

__device__ __forceinline__ void router_block_w(const GP& P, const gfl* b_group, const gfl* b_router, int tokblk0, LAS unsigned char* lds, int tid, int wave, int lane) {
    const int c = lane & 31, hi = lane >> 5, tok0 = (tokblk0 + (wave >> 2)) * 32, kq = wave & 3, l = P.l;
    { const GAS char* wsrc = (const GAS char*)P.b(OFF_WR + l * SZ_WR);
#pragma unroll
      for (int i = 0; i < 16; ++i) { const int row = i * 4 + (tid >> 7), cs = tid & 127;
          __builtin_amdgcn_global_load_lds((const GAS unsigned*)(wsrc + row * 2048 + ((cs ^ (row & 15)) << 4)), (LAS unsigned*)(lds + i * 8192 + wave * 1024), 16, 0, 0); } }
    const gbf* Xp = P.b(OFF_XB) + ((size_t)tok0 + c) * DM + kq * 256 + 8 * hi;
    bf16x8 xa[16];
#pragma unroll
    for (int s = 0; s < 16; ++s) xa[s] = *(const GAS bf16x8*)(Xp + 16 * s);
    f32x16 d0, d1;
#pragma unroll
    for (int r = 0; r < 16; ++r) { d0[r] = 0.f; d1[r] = 0.f; }
    asm volatile("s_waitcnt vmcnt(0)" ::: "memory"); __builtin_amdgcn_s_barrier(); asm volatile("" ::: "memory");
#pragma unroll
    for (int s = 0; s < 16; ++s) { const int ch = kq * 32 + 2 * s + hi;
        const bf16x8 w0 = *(const LAS bf16x8*)(lds + c * 2048 + ((ch ^ (c & 15)) << 4)), w1 = *(const LAS bf16x8*)(lds + (c + 32) * 2048 + ((ch ^ (c & 15)) << 4));
        d0 = MFMA32(xa[s], w0, d0); d1 = MFMA32(xa[s], w1, d1); }
    asm volatile("s_waitcnt lgkmcnt(0)" ::: "memory"); __syncthreads();
    LAS float* st = (LAS float*)(lds + wave * 8192);
#pragma unroll
    for (int r = 0; r < 16; ++r) { const int row = (r & 3) + 8 * (r >> 2) + 4 * hi; st[row * 40 + c] = d0[r]; if (c < 4) st[row * 40 + 32 + c] = d1[r]; }
    __syncthreads();
    if (kq == 0 && lane < 32) {
        const LAS float* s0 = st + lane * 40; const LAS float* s1 = s0 + 2048; const LAS float* s2 = s0 + 4096; const LAS float* s3 = s0 + 6144;
        const int tok = tok0 + lane; const float rs = rsqrtf(rsum16(P.f(OFF_SSX), tok) * (1.0f / 1024.0f) + EPS);
        float gl[4];
#pragma unroll
        for (int i = 0; i < 4; ++i) gl[i] = ((s0[32 + i] + s1[32 + i]) + (s2[32 + i] + s3[32 + i])) * rs + b_group[l * NG + i];
        int gs = 0; float gm = gl[0];
#pragma unroll
        for (int i = 1; i < 4; ++i) if (gl[i] > gm) { gm = gl[i]; gs = i; }
        float den = 0.f;
#pragma unroll
        for (int i = 0; i < 4; ++i) den += __expf(gl[i] - gm);
        const float pg = 1.0f / den;
        float v1 = -INFINITY, v2 = -INFINITY; int i1 = 0, i2 = 0;
#pragma unroll
        for (int i = 0; i < 8; ++i) { const int n = gs * 8 + i; const float e = ((s0[n] + s1[n]) + (s2[n] + s3[n])) * rs + b_router[l * NE + n];
            if (e > v1) { v2 = v1; i2 = i1; v1 = e; i1 = i; } else if (e > v2) { v2 = e; i2 = i; } }
        const float w1 = 1.0f / (1.0f + __expf(v2 - v1)), w2 = 1.0f - w1;
        const int e1 = gs * 8 + i1, e2 = gs * 8 + i2;
        const int rep = (tok0 >> 5) & 7; int* cnt = (int*)(P.i(OFF_CTL) + CW_CNTP + l * 64 * 8 * 32);
        const int p1 = atomicAdd(cnt + (e1 * 8 + rep) * 32, 1), p2 = atomicAdd(cnt + ((32 + e2) * 8 + rep) * 32, 1);
        P.i(OFF_PERM)[(size_t)(e1 * 8 + rep) * (T / 8) + p1] = tok; P.i(OFF_PERM)[(size_t)((32 + e2) * 8 + rep) * (T / 8) + p2] = tok;
        P.f(OFF_GATE)[(size_t)tok * 2] = pg * w1; P.f(OFF_GATE)[(size_t)tok * 2 + 1] = pg * w2;
    }
}

typedef const __attribute__((address_space(4))) MArgs* cargs_t;
constexpr int TI_PER_LAYER = 640 + 256 + 1024 + 3 * 4096;
__device__ __forceinline__ void cvt_tile_wave(const GP& P, cargs_t a, int l, int r, LAS unsigned char* stg, int lane) {
    const int HG = 1 << 30;
    const gfl* s; gbf* d; const gfl* g1 = nullptr; const gfl* g2 = nullptr; int ksplit = DM, K = DM, src_ld, kt, nt, G = HG, GS = 0, GO = 0; float scale = 1.f;
    if (r < 640) { const int grp = r / 128, q = r % 128; kt = q / 8; nt = q % 8; src_ld = INW; g1 = (const gfl*)a->in[2] + l * DM; g2 = g1;
        s = (const gfl*)a->in[3] + (size_t)l * DM * INW + grp * 512; d = P.b(OFF_WIN + l * SZ_WIN);
        GO = (grp == 0) ? 0 : (grp == 1) ? 1536 : (grp == 2) ? 512 : (grp == 3) ? 1024 : 2048; if (grp == 2) scale = QSCALE; }
    else if (r < 896) { const int q = r - 640; kt = q / 16; nt = q % 16; src_ld = DM; s = (const gfl*)a->in[9] + (size_t)l * DM * DM; d = P.b(OFF_WOUT + l * SZ_SQ); g1 = (const gfl*)a->in[7] + l * 512; g2 = (const gfl*)a->in[8] + l * 512; ksplit = 512; }
    else if (r < 1920) { const int m = (r - 896) / 256, q = (r - 896) % 256; kt = q / 16; nt = q % 16; src_ld = DM;
        if (m == 0) { s = (const gfl*)a->in[12] + (size_t)l * DM * DM; d = P.b(OFF_WXQ + l * SZ_SQ); g1 = (const gfl*)a->in[10] + l * DM; scale = XSCALE; }
        else if (m == 1) { s = (const gfl*)a->in[13] + (size_t)l * DM * DM; d = P.b(OFF_WXK + l * SZ_SQ); g1 = (const gfl*)a->in[11] + l * DM; }
        else if (m == 2) { s = (const gfl*)a->in[14] + (size_t)l * DM * DM; d = P.b(OFF_WXV + l * SZ_SQ); g1 = (const gfl*)a->in[11] + l * DM; }
        else { s = (const gfl*)a->in[15] + (size_t)l * DM * DM; d = P.b(OFF_WXO + l * SZ_SQ); }
        g2 = g1; }
    else { const int q0 = r - 1920, m = q0 / 4096, e = (q0 % 4096) / 128, q = q0 % 128;
        if (m < 2) { kt = q / 8; nt = q % 8; src_ld = DE; s = (const gfl*)(m == 0 ? a->in[21] : a->in[22]) + ((size_t)l * NE + e) * DM * DE; d = P.b(OFF_W13 + ((size_t)l * NE + e) * SZ_W13); g1 = (const gfl*)a->in[16] + l * DM; g2 = g1; G = 128; GS = 256; GO = m * 128; }
        else { K = DE; kt = q / 16; nt = q % 16; src_ld = DM; s = (const gfl*)a->in[23] + ((size_t)l * NE + e) * DE * DM; d = P.b(OFF_W2 + ((size_t)l * NE + e) * SZ_W2); } }
    const int kr = lane >> 4, n4 = (lane & 15) * 4;
    const gfl* sp = s + (size_t)(kt * 64 + kr) * src_ld + nt * 64 + n4;
    f32x4 v[16];
#pragma unroll
    for (int i = 0; i < 16; ++i) v[i] = *(const GAS f32x4*)(sp + (size_t)(4 * i) * src_ld);
    float ga[16];
#pragma unroll
    for (int i = 0; i < 16; ++i) { const int k = kt * 64 + 4 * i + kr; ga[i] = scale; if (g1) ga[i] *= (k < ksplit) ? g1[k] : g2[k - ksplit]; }
#pragma unroll
    for (int i = 0; i < 16; ++i) { const int k = 4 * i + kr; u32x2 w; w.x = pk2h(v[i][0] * ga[i], v[i][1] * ga[i]); w.y = pk2h(v[i][2] * ga[i], v[i][3] * ga[i]);
        *(LAS u32x2*)(stg + k * 128 + ((n4 * 2) ^ ((k >> 3) << 3))) = w; }
    asm volatile("s_waitcnt lgkmcnt(0)" ::: "memory");
#pragma unroll
    for (int j = 0; j < 8; ++j) {
        const int chunk = j * 64 + lane, n = chunk >> 3, kc = chunk & 7;
        unsigned short e[8];
#pragma unroll
        for (int q = 0; q < 8; ++q) e[q] = *(const LAS unsigned short*)(stg + (8 * kc + q) * 128 + ((n * 2) ^ (kc << 3)));
        u32x4 w; w.x = e[0] | ((unsigned)e[1] << 16); w.y = e[2] | ((unsigned)e[3] << 16); w.z = e[4] | ((unsigned)e[5] << 16); w.w = e[6] | ((unsigned)e[7] << 16);
        const int ng = nt * 64 + n, drow = (ng / G) * GS + GO + (ng % G);
        *(GAS u32x4*)(d + (size_t)drow * K + kt * 64 + 8 * kc) = w;
    }
    asm volatile("s_waitcnt lgkmcnt(0)" ::: "memory");
}
__device__ __forceinline__ void prologue_phase(const Frame& F, cargs_t a) {
    const gfl* x = (const gfl*)a->in[0]; const gfl* mem = (const gfl*)a->in[1]; const gfl* w_sp = (const gfl*)a->in[5]; const gfl* norm_moe = (const gfl*)a->in[16];
    const gfl* w_group = (const gfl*)a->in[17]; const gfl* w_router = (const gfl*)a->in[19];
    const GP& P = F.P;
    const int gw = F.vcu * 8 + F.wave, NW_ = F.G * 8, lane = F.lane;
    LAS unsigned char* cstg = F.lds + 65536 + F.wave * 8192;
    for (int it = gw; it < NL * TI_PER_LAYER; it += NW_) cvt_tile_wave(P, a, it / TI_PER_LAYER, it % TI_PER_LAYER, cstg, lane);
    const int gt = F.vcu * 512 + F.tid, NT_ = F.G * 512;
    for (int idx = gt; idx < NL * 64 * DM; idx += NT_) { const int k = idx % DM, n = (idx / DM) % 64, l = idx / (64 * DM); float v = 0.f;
        if (n < 32) v = w_router[((size_t)l * DM + k) * NE + n]; else if (n < 36) v = w_group[((size_t)l * DM + k) * NG + (n - 32)];
        P.b(OFF_WR)[idx] = f2bfh(v * norm_moe[l * DM + k]); }
    for (int idx = gt; idx < NL * AG * CHUNK * CHUNK; idx += NT_) { const int s_ = idx % CHUNK, t_ = (idx / CHUNK) % CHUNK; P.b(OFF_WS)[idx] = (s_ <= t_) ? f2bfh(w_sp[idx]) : (bf16_t)0; }
    for (int row = gw; row < T + MT; row += NW_) {
        const bool ism = row >= T; const int rr = ism ? row - T : row; const gfl* src = ism ? mem : x; gbf* dst = ism ? P.b(OFF_MB) : P.b(OFF_XB); float tot = 0.f;
#pragma unroll
        for (int j = 0; j < 4; ++j) {
            const f32x4 v = *(const GAS f32x4*)(src + (size_t)rr * DM + j * 256 + lane * 4);
            u32x2 w; w.x = pk2h(v[0], v[1]); w.y = pk2h(v[2], v[3]); *(GAS u32x2*)(dst + (size_t)rr * DM + j * 256 + lane * 4) = w;
            float s = (v[0] * v[0] + v[1] * v[1]) + (v[2] * v[2] + v[3] * v[3]);
            s += sx<1>(s); s += sx<2>(s); s += sx<4>(s); s += sx<8>(s);
            if (!ism && (lane & 15) == 0) P.f(OFF_SSX)[(size_t)rr * 16 + j * 4 + (lane >> 4)] = s;
            s += sx<16>(s); s += sx<32>(s); tot += s;
        }
        if (ism && lane == 0) P.f(OFF_SSM)[rr] = tot;
    }
}


template <bool GATHER> __device__ __forceinline__ void moe_phase(const Frame& F, const GP& P, int type, const bool reuse) {
    LAS int* seg = (LAS int*)(F.lds + L_SEG);
    const int sg_lo = 0, sg_hi = 64, l = P.l;
    const gint* cnt = P.i(OFF_CTL) + CW_CNTP + l * 64 * 8 * 32;
    const bool ru = reuse && !GATHER && ((const LAS int*)seg)[128 + 64] * 4 <= 4 * F.G;
    if (!ru && F.tid < 64) {
        int c = 0;
#pragma unroll
        for (int rp = 0; rp < 8; ++rp) { seg[512 + 8 * F.tid + rp] = c; c += cnt[(F.tid * 8 + rp) * 32]; } int rb = (c + 255) & ~255, tb = (c + 255) >> 8; const int rb0 = rb, tb0 = tb;
#pragma unroll
        for (int o = 1; o < 64; o <<= 1) { const int r2 = __shfl_up(rb, o), t2 = __shfl_up(tb, o); if (F.tid >= o) { rb += r2; tb += t2; } }
        seg[F.tid] = c; seg[64 + F.tid] = rb - rb0; seg[128 + F.tid] = tb - tb0; if (F.tid == 63) seg[128 + 64] = tb;
    }
    __syncthreads();
    int bxl = blockIdx.x; asm volatile("" : "+s"(bxl));
    LAS int* tl = (LAS int*)(F.lds + L_TOKL);
    const int nwg = seg[128 + 64] * 4;
    for (int ibase = 0; ibase * F.G + bxl < nwg; ibase += 4) {
        if (!ru && F.tid < 64) {
            const int lo = seg[128 + F.tid] * 4, hi = seg[128 + F.tid + 1] * 4;
#pragma unroll
            for (int i = 0; i < 4; ++i) { const int L = (ibase + i) * F.G + bxl;
                if (L >= nwg) { if (F.tid == 0) seg[256 + 4 * i] = -1; }
                else { const int w = xcd_remap(L, nwg); if (w >= lo && w < hi) { const int nts = (hi - lo) >> 2, r = w - lo; seg[256 + 4 * i] = F.tid; seg[256 + 4 * i + 1] = r % nts; seg[256 + 4 * i + 2] = r / nts; } } }
        }
        __syncthreads();
#pragma unroll
        for (int i = 0; i < 4; ++i) { const int sg = seg[256 + 4 * i]; if (!ru && sg >= 0 && F.tid < 256) { const int n = seg[sg]; int r = seg[256 + 4 * i + 1] * 256 + F.tid; r = r < n ? r : n - 1;
                int rp = 0;
#pragma unroll
                for (int q = 1; q < 8; ++q) rp += (seg[512 + 8 * sg + q] <= r) ? 1 : 0;
                tl[i * 256 + F.tid] = P.i(OFF_PERM)[(size_t)(sg * 8 + rp) * (T / 8) + (r - seg[512 + 8 * sg + rp])]; } }
        __syncthreads();
        MoeSched S{P, type, F.G, bxl, sg_lo, sg_hi, seg, ibase};
        if (GATHER) { Epi<false, 0x80u> E{P, F.lds}; g8::gemm_phase<true>(F.lds, DM, S, E, F.tid); }
        else { Epi<false, 0x100u> E{P, F.lds}; g8::gemm_phase<false>(F.lds, DE, S, E, F.tid); }
        __syncthreads();
    }
}

constexpr int N_PHASES = 42;
#ifndef CT_MASK
#define CT_MASK 0xFFF
#endif
#define CT(t) (((CT_MASK) >> (t)) & 1)
__global__ void __launch_bounds__(NWAVES * 64, 2) mega(MArgs a) {
    extern __shared__ __attribute__((aligned(16))) unsigned char lds_raw[];
    Frame F; F.lds = (LAS unsigned char*)lds_raw;
    F.tid = threadIdx.x; F.lane = F.tid & 63; F.wave = __builtin_amdgcn_readfirstlane(F.tid >> 6); const int wave_s = F.wave;
    F.G = gridDim.x; { const int bx = blockIdx.x; F.vcu = (F.G % 8 == 0) ? (bx % 8) * (F.G / 8) + bx / 8 : bx; }
    F.P.ws = (GAS unsigned char*)a.ws; F.P.l = 0;
    volatile LAS unsigned* MISC = (volatile LAS unsigned*)(F.lds + L_MISC);
    if (F.tid < 64) MISC[F.tid] = 0u;
    __syncthreads();
    XcdBarrier bar = xcd_barrier_post((unsigned*)(a.ws + OFF_CTL) + CW_BAR + a.li * XCD_BAR_WORDS, MISC + 8);
#ifdef PROBE_PAD
    unsigned long long tacc_ = 0ull;
#endif
    for (int ph = a.ph_lo; ph < a.ph_hi; ++ph) {
        if (gridDim.x == 256 && ph >= 1 && ph < N_PHASES - 1 && (ph - 1) % 10 == 4) continue;
#ifdef PROBE_PAD
        const unsigned long long tph0_ = __builtin_amdgcn_s_memrealtime();
#endif
        { int ln_ = (int)__builtin_amdgcn_mbcnt_hi(~0u, __builtin_amdgcn_mbcnt_lo(~0u, 0u)); asm volatile("" : "+v"(ln_)); int wv_ = wave_s; asm volatile("" : "+s"(wv_));
          F.lane = ln_; F.wave = wv_; F.tid = wv_ * 64 + ln_; }
        int bxl = blockIdx.x, gl_ = gridDim.x; asm volatile("" : "+s"(bxl), "+s"(gl_));
        F.G = gl_; F.vcu = (gl_ % 8 == 0) ? (bxl % 8) * (gl_ / 8) + bxl / 8 : bxl;
        LAS unsigned char* wstg = F.lds + F.wave * 8192;
        cargs_t ap = (cargs_t)__builtin_amdgcn_kernarg_segment_ptr(); asm volatile("" : "+s"(ap));
        F.P.ws = (GAS unsigned char*)ap->ws;
        if (ph == 0) { if (CT(0)) prologue_phase(F, ap); }
        else if (ph == N_PHASES - 1) { if (false) {
            const int gw = F.vcu * 8 + F.wave, NW_ = F.G * 8, lane = F.lane; const GP& P = F.P;
            for (int row = gw; row < T; row += NW_) { const float rs = rsqrtf(rsum16(P.f(OFF_SSX), row) * (1.0f / 1024.0f) + EPS);
#pragma unroll
                for (int j = 0; j < 4; ++j) { const u32x2 xv = *(const GAS u32x2*)(P.b(OFF_XB) + (size_t)row * DM + j * 256 + lane * 4); const f32x4 g = *(const GAS f32x4*)((const gfl*)ap->in[24] + j * 256 + lane * 4);
                    f32x4 v; v[0] = __uint_as_float(xv.x << 16); v[1] = __uint_as_float(xv.x & 0xffff0000u); v[2] = __uint_as_float(xv.y << 16); v[3] = __uint_as_float(xv.y & 0xffff0000u);
                    *(GAS f32x4*)((gfl*)ap->out + (size_t)row * DM + j * 256 + lane * 4) = v * rs * g; } } }
        } else {
            const int l = (ph - 1) / 10, j = (ph - 1) % 10; F.P.l = l; const GP P = F.P;
            if (CT(1) && (j == 0 || j == 3 || j == 5)) {
                { int t_ = F.tid; asm volatile("" : "+v"(t_)); F.tid = t_; F.lane = t_ & 63; }
                DenseSched S{P, j == 0 ? 1 : (j == 3 ? 4 : 6), F.G, bxl}; Epi<false, 0x6Fu> E{P, F.lds};
                g8::gemm_phase<false>(F.lds, DM, S, E, F.tid);
                if (j == 3 && F.G == 256) {
                    g8::Unit u4; S.next(0, u4);
                    asm volatile("s_waitcnt vmcnt(0)" ::: "memory"); __syncthreads();
                    if (F.tid == 0) { __builtin_amdgcn_fence(__ATOMIC_ACQUIRE, "agent"); asm volatile("s_waitcnt vmcnt(0)" ::: "memory"); }
                    __syncthreads();
                    xattn_block(P, u4.q0 >> 8, u4.p0 >> 8, F.lds, F.tid, F.wave, F.lane);
                }
            } else if (CT(3) && j == 2) {
                { int t_ = F.tid; asm volatile("" : "+v"(t_)); F.tid = t_; F.lane = t_ & 63; }
                DenseSched S{P, 3, F.G, bxl}; Epi<true, 0x10u> E{P, F.lds};
                g8::Unit u0;
                if (S.next(0, u0) && F.tid < 256) {
                    const int q = u0.q0 + F.tid; const f32x4 va = *(const GAS f32x4*)(P.f(OFF_SSA) + (size_t)q * 4), v0 = *(const GAS f32x4*)(P.f(OFF_SSB) + (size_t)q * 8), v1 = *(const GAS f32x4*)(P.f(OFF_SSB) + (size_t)q * 8 + 4);
                    const float ra = rsqrtf(((va[0] + va[1]) + (va[2] + va[3])) * (1.0f / 512.0f) + EPS), rb = rsqrtf((((v0[0] + v0[1]) + (v0[2] + v0[3])) + ((v1[0] + v1[1]) + (v1[2] + v1[3]))) * (1.0f / 512.0f) + EPS);
                    LAS float* rst = (LAS float*)(F.lds + L_ROWST); rst[2 * F.tid] = ra / rb; rst[2 * F.tid + 1] = rb;
                }
                __syncthreads();
                g8::gemm_phase<false>(F.lds, DM, S, E, F.tid);
            } else if (CT(2) && j == 1) {
                { int t_ = F.tid; asm volatile("" : "+v"(t_)); F.tid = t_; F.lane = t_ & 63; }
                const int bh = F.vcu >> 3, sub = F.vcu & 7;
                if (F.G == 256) {
                    const int gu = F.vcu * 8 + F.wave;
                    gmlp_block(P, (const gfl*)ap->in[4], (const gfl*)ap->in[6], F.vcu, F.lds, F.tid, F.wave, F.lane);
                    attn_block(P, bh >> 3, bh & 7, sub, F.lds, F.tid, F.wave, F.lane);
                } else {
                    for (int uu = F.vcu * 8 + F.wave; uu < 4096; uu += F.G * 8) attn_wave_unit(P, uu >> 10, (uu >> 7) & 7, uu & 127, wstg, F.lane);
                    for (int gu = F.vcu * 8 + F.wave; gu < 2048; gu += F.G * 8) gmlp_wave_unit(P, (const gfl*)ap->in[4], (const gfl*)ap->in[6], gu >> 4, (gu >> 2) & 3, gu & 3, wstg, F.lane);
                }
            } else if (CT(5) && j == 4) {
                if (F.G != 256) for (int uu = F.vcu; uu < 256; uu += F.G) xattn_block(P, uu >> 2, uu & 3, F.lds, F.tid, F.wave, F.lane);
            } else if (CT(7) && j == 6) {
                { int t_ = F.tid; asm volatile("" : "+v"(t_)); F.tid = t_; F.lane = t_ & 63; }
                if (F.G == 256) { g8::Unit ur; DenseSched Sr{P, 6, F.G, bxl}; Sr.next(0, ur);
                    router_block_w(P, (const gfl*)ap->in[18], (const gfl*)ap->in[20], (ur.q0 >> 5) + (ur.p0 >> 8) * 2, F.lds, F.tid, F.wave, F.lane); __syncthreads(); }
                else for (int tb = F.vcu * 2; tb < 512; tb += F.G * 2) { router_block(P, (const gfl*)ap->in[18], (const gfl*)ap->in[20], tb, F.lds, F.wave, F.lane); __syncthreads(); }
            } else if (CT(8) && j == 9) {
                { int t_ = F.tid; asm volatile("" : "+v"(t_)); F.tid = t_; F.lane = t_ & 63; }
                const int gw = F.vcu * 8 + F.wave, NW_ = F.G * 8, lane = F.lane;
                for (int row0 = gw; row0 + NW_ < T; row0 += 2 * NW_) {
                    u32x4 xv[2][2], ya[2][2], yb[2][2];
#pragma unroll
                    for (int k = 0; k < 2; ++k) { const int row = row0 + k * NW_; {
#pragma unroll
                        for (int hf = 0; hf < 2; ++hf) { const unsigned o = (unsigned)row * DM + lane * 16 + hf * 8;
                            xv[k][hf] = *(const GAS u32x4*)(P.b(OFF_XB) + o); ya[k][hf] = *(const GAS u32x4*)(P.b(OFF_YM) + (size_t)row * 2 * DM + lane * 16 + hf * 8); yb[k][hf] = *(const GAS u32x4*)(P.b(OFF_YM) + (size_t)row * 2 * DM + DM + lane * 16 + hf * 8); } } }
#pragma unroll
                    for (int k = 0; k < 2; ++k) { const int row = row0 + k * NW_; {
                        u32x4 w[2]; float s = 0.f;
#pragma unroll
                        for (int hf = 0; hf < 2; ++hf)
#pragma unroll
                            for (int e = 0; e < 4; ++e) {
                                const float lo = __uint_as_float(xv[k][hf][e] << 16) + __uint_as_float(ya[k][hf][e] << 16) + __uint_as_float(yb[k][hf][e] << 16);
                                const float hi2 = __uint_as_float(xv[k][hf][e] & 0xffff0000u) + __uint_as_float(ya[k][hf][e] & 0xffff0000u) + __uint_as_float(yb[k][hf][e] & 0xffff0000u);
                                const unsigned pw = pk2h(lo, hi2); w[hf][e] = pw;
                                const float rl = __uint_as_float(pw << 16), rh = __uint_as_float(pw & 0xffff0000u); s += rl * rl + rh * rh;
                            }
                        s += sx<1>(s); s += sx<2>(s);
                        if (l < NL - 1) {
                            *(GAS u32x4*)(P.b(OFF_XB) + (unsigned)row * DM + lane * 16) = w[0]; *(GAS u32x4*)(P.b(OFF_XB) + (unsigned)row * DM + lane * 16 + 8) = w[1];
                            if ((lane & 3) == 0) P.f(OFF_SSX)[(size_t)row * 16 + (lane >> 2)] = s;
                        } else {
                            s += sx<4>(s); s += sx<8>(s); s += sx<16>(s); s += sx<32>(s);
                            const float rs = rsqrtf(s * (1.0f / 1024.0f) + EPS);
#pragma unroll
                            for (int q4 = 0; q4 < 4; ++q4) { const f32x4 g = *(const GAS f32x4*)((const gfl*)ap->in[24] + lane * 16 + q4 * 4); const unsigned w0 = w[q4 >> 1][(q4 & 1) * 2], w1 = w[q4 >> 1][(q4 & 1) * 2 + 1];
                                f32x4 v; v[0] = __uint_as_float(w0 << 16); v[1] = __uint_as_float(w0 & 0xffff0000u); v[2] = __uint_as_float(w1 << 16); v[3] = __uint_as_float(w1 & 0xffff0000u);
                                *(GAS f32x4*)((gfl*)ap->out + (size_t)row * DM + lane * 16 + q4 * 4) = v * rs * g; }
                        } } }
                }
            } else if (CT(8) && j == 7) { { int t_ = F.tid; asm volatile("" : "+v"(t_)); F.tid = t_; F.lane = t_ & 63; }     moe_phase<true>(F, P, 8, false); }
            else if (CT(8) && j == 8) { { int t_ = F.tid; asm volatile("" : "+v"(t_)); F.tid = t_; F.lane = t_ & 63; }     moe_phase<false>(F, P, 9, ph > ap->ph_lo); }
        }
        if (ph >= 1 && ph <= 30) {
            const int l_ = (ph - 1) / 10, j_ = (ph - 1) % 10, it_ = j_ * (F.G * 8) + F.vcu * 8 + wave_s;
            if (false && j_ < 7 && it_ < TI_PER_LAYER) { int ln2 = (int)__builtin_amdgcn_mbcnt_hi(~0u, __builtin_amdgcn_mbcnt_lo(~0u, 0u)); asm volatile("" : "+v"(ln2)); cvt_tile_wave(F.P, ap, l_ + 1, it_, F.lds + 65536 + wave_s * 8192, ln2); }
        }
        if (ph + 1 < a.ph_hi) { const int ln3 = (int)__builtin_amdgcn_mbcnt_hi(~0u, __builtin_amdgcn_mbcnt_lo(~0u, 0u));
            const int jb = (ph >= 1 && ph < N_PHASES - 1) ? (ph - 1) % 10 : -1;
            int bx2 = blockIdx.x, g2_ = gridDim.x; asm volatile("" : "+s"(bx2), "+s"(g2_));
            if (g2_ == 256 && (jb == 2 || jb == 3 || jb == 5)) {
                const int w2_ = xcd_remap(bx2, 256), pm_ = (w2_ / 32) * 8 + (w2_ % 8), st_ = (jb == 2) ? 0 : (jb == 3) ? 1 : 2;
                team_barrier((unsigned*)(ap->ws + OFF_CTL) + CW_TEAM + ((((ph - 1) / 10) * 3 + st_) * 64 + pm_) * 32, wave_s == 0 && ln3 == 0);
            } else xcd_barrier(bar, wave_s == 0 && ln3 == 0); }
#ifdef PROBE_PAD
        if ((a.pad & 1) && ph + 1 < a.ph_hi) xcd_barrier(bar, wave_s == 0 && (int)__builtin_amdgcn_mbcnt_hi(~0u, __builtin_amdgcn_mbcnt_lo(~0u, 0u)) == 0);
        { const int pty_ = (ph == 0) ? 0 : (ph == N_PHASES - 1) ? 11 : 1 + (ph - 1) % 10; if (pty_ + 1 == (a.pad >> 8)) tacc_ += __builtin_amdgcn_s_memrealtime() - tph0_; }
#endif
    }
#ifdef PROBE_PAD
    if ((a.pad >> 8) && blockIdx.x == 0) { const unsigned long long t0_ = __builtin_amdgcn_s_memrealtime(); while (__builtin_amdgcn_s_memrealtime() - t0_ < tacc_) __builtin_amdgcn_s_sleep(8); }
#endif
}

#ifndef FAST_MASK
#define FAST_MASK 0xFFF
#endif
extern "C" void kernel_launch(void* const* d_in, const int* in_sizes, int n_in, void* d_out, int out_size, void* d_ws, size_t ws_size, hipStream_t stream) {
    if (n_in != 25 || ws_size < WS_NEED || out_size != T * DM) { fprintf(stderr, "kernel_launch: unexpected shapes (n_in %d, ws %zu need %zu, out %d)\n", n_in, ws_size, (size_t)WS_NEED, out_size); return; }
    static int grid = 0;
    if (grid == 0) {
        int dev = 0, cus = 0;
        if (hipGetDevice(&dev) != hipSuccess || hipDeviceGetAttribute(&cus, hipDeviceAttributeMultiprocessorCount, dev) != hipSuccess) cus = 0;
        if (hipFuncSetAttribute((const void*)mega, hipFuncAttributeMaxDynamicSharedMemorySize, LDS_BYTES) != hipSuccess) cus = 0;
        (void)hipGetLastError();
        grid = (cus == 256) ? 256 : -1;
        if (grid < 0) fprintf(stderr, "kernel_launch: the persistent kernel needs a 256-CU device (got %d); using the per-stage kernels\n", cus);
    }
    const unsigned fast = (grid > 0) ? (unsigned)FAST_MASK : 0u;
    const float* x = (const float*)d_in[0]; const float* mem = (const float*)d_in[1]; const float* norm_mix = (const float*)d_in[2]; const float* w_in = (const float*)d_in[3];
    const float* v_norm = (const float*)d_in[4]; const float* w_sp = (const float*)d_in[5]; const float* b_sp = (const float*)d_in[6]; const float* on_a = (const float*)d_in[7];
    const float* on_b = (const float*)d_in[8]; const float* w_out = (const float*)d_in[9]; const float* norm_cross = (const float*)d_in[10]; const float* norm_mem = (const float*)d_in[11];
    const float* w_xq = (const float*)d_in[12]; const float* w_xk = (const float*)d_in[13]; const float* w_xv = (const float*)d_in[14]; const float* w_xo = (const float*)d_in[15];
    const float* norm_moe = (const float*)d_in[16]; const float* w_group = (const float*)d_in[17]; const float* b_group = (const float*)d_in[18]; const float* w_router = (const float*)d_in[19];
    const float* b_router = (const float*)d_in[20]; const float* w1 = (const float*)d_in[21]; const float* w3 = (const float*)d_in[22]; const float* w2 = (const float*)d_in[23]; const float* norm_final = (const float*)d_in[24];
    unsigned char* ws = (unsigned char*)d_ws;
    (void)hipMemsetAsync(ws + OFF_CTL, 0, 1 * MiB, stream);
    auto B = [&](size_t off) { return (bf16_t*)(ws + off); };
    Ptrs P; P.ws = ws; P.x_in = x; P.out = (float*)d_out; P.l = 0;
    MArgs a{}; for (int i = 0; i < 25; ++i) a.in[i] = (const float*)d_in[i]; a.out = (float*)d_out; a.ws = ws;
#ifdef PROBE_PAD
    a.pad = PROBE_PAD;
#endif
    int pend_lo = -1, n_mega = 0;
    auto flush = [&](int hi) { if (pend_lo < 0) return; a.ph_lo = pend_lo; a.ph_hi = hi; a.li = n_mega++; hipLaunchKernelGGL(mega, dim3(grid), dim3(NWAVES * 64), LDS_BYTES, stream, a); pend_lo = -1; };
    for (int ph = 0; ph < N_PHASES; ++ph) {
        const int type = (ph == 0) ? 0 : (ph == N_PHASES - 1) ? 11 : 1 + (ph - 1) % 10, l = (ph == 0 || ph == N_PHASES - 1) ? 0 : (ph - 1) / 10;
        if ((fast >> type) & 1u) { if (pend_lo < 0) pend_lo = ph;
#ifdef REPEAT_TYPE
            if (type == REPEAT_TYPE) { flush(ph + 1); pend_lo = ph; }
#endif
            continue; }
        flush(ph);
        P.l = l;
        switch (type) {
        case 0: {
            const int HUGE_G = 1 << 30; const long s_in = (long)DM * INW, d_inw = (long)INW * DM, s_sq = (long)DM * DM;
            k_transpose<<<dim3(16 * 8, 1, NL), 256, 0, stream>>>(w_in + 0, B(OFF_WIN), norm_mix, nullptr, DM, 1.f, DM, 512, INW, 0, s_in, 0, d_inw, DM, HUGE_G, 0, 0);
            k_transpose<<<dim3(16 * 8, 1, NL), 256, 0, stream>>>(w_in + 512, B(OFF_WIN), norm_mix, nullptr, DM, 1.f, DM, 512, INW, 0, s_in, 0, d_inw, DM, HUGE_G, 0, 1536);
            k_transpose<<<dim3(16 * 8, 1, NL), 256, 0, stream>>>(w_in + 1024, B(OFF_WIN), norm_mix, nullptr, DM, QSCALE, DM, 512, INW, 0, s_in, 0, d_inw, DM, HUGE_G, 0, 512);
            k_transpose<<<dim3(16 * 8, 1, NL), 256, 0, stream>>>(w_in + 1536, B(OFF_WIN), norm_mix, nullptr, DM, 1.f, DM, 512, INW, 0, s_in, 0, d_inw, DM, HUGE_G, 0, 1024);
            k_transpose<<<dim3(16 * 8, 1, NL), 256, 0, stream>>>(w_in + 2048, B(OFF_WIN), norm_mix, nullptr, DM, 1.f, DM, 512, INW, 0, s_in, 0, d_inw, DM, HUGE_G, 0, 2048);
            k_transpose<<<dim3(16 * 16, 1, NL), 256, 0, stream>>>(w_out, B(OFF_WOUT), on_a, on_b, 512, 1.f, DM, DM, DM, 0, s_sq, 0, s_sq, 512, HUGE_G, 0, 0);
            k_transpose<<<dim3(16 * 16, 1, NL), 256, 0, stream>>>(w_xq, B(OFF_WXQ), norm_cross, nullptr, DM, XSCALE, DM, DM, DM, 0, s_sq, 0, s_sq, DM, HUGE_G, 0, 0);
            k_transpose<<<dim3(16 * 16, 1, NL), 256, 0, stream>>>(w_xk, B(OFF_WXK), norm_mem, nullptr, DM, 1.f, DM, DM, DM, 0, s_sq, 0, s_sq, DM, HUGE_G, 0, 0);
            k_transpose<<<dim3(16 * 16, 1, NL), 256, 0, stream>>>(w_xv, B(OFF_WXV), norm_mem, nullptr, DM, 1.f, DM, DM, DM, 0, s_sq, 0, s_sq, DM, HUGE_G, 0, 0);
            k_transpose<<<dim3(16 * 16, 1, NL), 256, 0, stream>>>(w_xo, B(OFF_WXO), nullptr, nullptr, DM, 1.f, DM, DM, DM, 0, s_sq, 0, s_sq, DM, HUGE_G, 0, 0);
            k_transpose<<<dim3(16 * 8, NE, NL), 256, 0, stream>>>(w1, B(OFF_W13), norm_moe, nullptr, DM, 1.f, DM, DE, DE, (long)DM * DE, (long)NE * DM * DE, (long)1024 * DM, (long)NE * 1024 * DM, DM, 128, 256, 0);
            k_transpose<<<dim3(16 * 8, NE, NL), 256, 0, stream>>>(w3, B(OFF_W13), norm_moe, nullptr, DM, 1.f, DM, DE, DE, (long)DM * DE, (long)NE * DM * DE, (long)1024 * DM, (long)NE * 1024 * DM, DM, 128, 256, 128);
            k_transpose<<<dim3(8 * 16, NE, NL), 256, 0, stream>>>(w2, B(OFF_W2), nullptr, nullptr, DE, 1.f, DE, DM, DM, (long)DE * DM, (long)NE * DE * DM, (long)DM * DE, (long)NE * DM * DE, DM, HUGE_G, 0, 0);
            k_prep_router<<<NL * 64 * DM / 256, 256, 0, stream>>>(w_router, w_group, norm_moe, B(OFF_WR));
            k_prep_spatial<<<NL * AG * CHUNK * CHUNK / 256, 256, 0, stream>>>(w_sp, B(OFF_WS));
            k_prep_rows<<<T / 4, 256, 0, stream>>>(x, B(OFF_XB), (float*)(ws + OFF_SSX), nullptr, T);
            k_prep_rows<<<MT / 4, 256, 0, stream>>>(mem, B(OFF_MB), nullptr, (float*)(ws + OFF_SSM), MT);
        } break;
        case 1:
            if (l == 0) { k_sgemm<ProbMemK><<<dim3(4 * 16, NL), 256, 0, stream>>>(ProbMemK{P}); k_sgemm<ProbMemVT><<<dim3(4 * 16, NL), 256, 0, stream>>>(ProbMemVT{P}); }
            k_sgemm<ProbIn><<<6 * 256, 256, 0, stream>>>(ProbIn{P}); k_sgemm<ProbInT><<<64 * 16, 256, 0, stream>>>(ProbInT{P}); break;
        case 2: k_attn_naive<<<T * SBH / 256, 256, 0, stream>>>(P); k_gmlp_naive<<<(T / CHUNK) * AG, 256, 0, stream>>>(P, v_norm, b_sp); break;
        case 3: k_sgemm<ProbOut><<<4 * 256, 256, 0, stream>>>(ProbOut{P}); break;
        case 4: k_sgemm<ProbXq><<<4 * 256, 256, 0, stream>>>(ProbXq{P}); break;
        case 5: k_xattn_naive<<<(T / 16) * XH, 256, 0, stream>>>(P); break;
        case 6: k_sgemm<ProbXo><<<4 * 256, 256, 0, stream>>>(ProbXo{P}); break;
        case 7: k_router_naive<<<T / 4, 256, 0, stream>>>(P, b_group, b_router); break;
        case 8: k_sgemm<ProbMoe1><<<4 * (2 * T / 64 + 64), 256, 0, stream>>>(ProbMoe1{P}); break;
        case 9: k_sgemm<ProbMoe2<0>><<<4 * (T / 64 + 32), 256, 0, stream>>>(ProbMoe2<0>{P}); break;
        case 10: k_sgemm<ProbMoe2<1>><<<4 * (T / 64 + 32), 256, 0, stream>>>(ProbMoe2<1>{P}); break;
        default: k_final<<<T / 4, 256, 0, stream>>>(P, norm_final); break;
        }
    }
    flush((fast >> 11) & 1u ? N_PHASES - 1 : N_PHASES);
}
```

```cpp
#include <hip/hip_runtime.h>
#include <stdint.h>
#include <stdio.h>

typedef unsigned short bf16_t;
typedef short bf16x8 __attribute__((ext_vector_type(8)));
typedef float f32x4 __attribute__((ext_vector_type(4)));
typedef float f32x16 __attribute__((ext_vector_type(16)));
typedef unsigned u32x2 __attribute__((ext_vector_type(2)));
typedef unsigned u32x4 __attribute__((ext_vector_type(4)));

constexpr int NB = 4, SEQ = 4096, T = NB * SEQ, DM = 1024, NL = 4;
constexpr int AW = 512, AG = 4, ACH = 128, CHUNK = 128;
constexpr int SBW = 512, SBH = 8, SBD = 64;
constexpr int INW = 2560;
constexpr int MEML = 256, MT = NB * MEML, XH = 4, XD = 256;
constexpr int NG = 4, EPG = 8, NE = 32, DE = 512;
constexpr float EPS = 1e-6f;
constexpr float LOG2E = 1.4426950408889634f;
constexpr float QSCALE = 0.125f * LOG2E;
constexpr float XSCALE = 0.0625f * LOG2E;
constexpr float RSTOP = 104.0f * LOG2E;

constexpr size_t MiB = 1u << 20;
constexpr size_t OFF_CTL = 0;
constexpr size_t OFF_WIN = 1 * MiB;
constexpr size_t SZ_WIN = (size_t)INW * DM * 2;
constexpr size_t OFF_WOUT = OFF_WIN + NL * SZ_WIN;
constexpr size_t SZ_SQ = (size_t)DM * DM * 2;
constexpr size_t OFF_WXQ = OFF_WOUT + NL * SZ_SQ;
constexpr size_t OFF_WXK = OFF_WXQ + NL * SZ_SQ;
constexpr size_t OFF_WXV = OFF_WXK + NL * SZ_SQ;
constexpr size_t OFF_WXO = OFF_WXV + NL * SZ_SQ;
constexpr size_t OFF_WR = OFF_WXO + NL * SZ_SQ;
constexpr size_t SZ_WR = (size_t)64 * DM * 2;
constexpr size_t OFF_WS = OFF_WR + NL * SZ_WR;
constexpr size_t SZ_WS = (size_t)AG * CHUNK * CHUNK * 2;
constexpr size_t OFF_W13 = OFF_WS + NL * SZ_WS;
constexpr size_t SZ_W13 = (size_t)1024 * DM * 2;
constexpr size_t OFF_W2 = OFF_W13 + (size_t)NL * NE * SZ_W13;
constexpr size_t SZ_W2 = (size_t)DM * DE * 2;
constexpr size_t OFF_XF = OFF_W2 + (size_t)NL * NE * SZ_W2;
constexpr size_t OFF_YM = OFF_XF;
constexpr size_t OFF_XB = OFF_XF + (size_t)T * DM * 4;
constexpr size_t OFF_SSX = OFF_XB + (size_t)T * DM * 2;
constexpr size_t OFF_U = OFF_SSX + (size_t)T * 16 * 4;
constexpr size_t SZ_H = (size_t)T * 512 * 2;
constexpr size_t OFF_Q = OFF_U + SZ_H;
constexpr size_t OFF_K = OFF_Q + SZ_H;
constexpr size_t OFF_VGT = OFF_K + SZ_H;
constexpr size_t OFF_VBT = OFF_VGT + SZ_H;
constexpr size_t OFF_Y = OFF_VBT + SZ_H;
constexpr size_t OFF_SSA = OFF_Y + (size_t)T * DM * 2;
constexpr size_t OFF_SSB = OFF_SSA + (size_t)T * 4 * 4;
constexpr size_t OFF_QX = OFF_SSB + (size_t)T * 8 * 4;
constexpr size_t OFF_OX = OFF_QX + (size_t)T * DM * 2;
constexpr size_t OFF_MB = OFF_OX + (size_t)T * DM * 2;
constexpr size_t OFF_SSM = OFF_MB + (size_t)MT * DM * 2;
constexpr size_t OFF_KX = OFF_SSM + (size_t)MT * 4;
constexpr size_t OFF_VXT = OFF_KX + (size_t)NL * MT * DM * 2;
constexpr size_t OFF_GATE = OFF_VXT + (size_t)NL * MT * DM * 2;
constexpr size_t OFF_PERM = OFF_GATE + (size_t)T * 2 * 4;
constexpr int ACT_ROWS = 2 * T + 64 * 256;
constexpr size_t OFF_ACT = OFF_PERM + (size_t)64 * T * 4;
constexpr size_t WS_NEED = OFF_ACT + (size_t)ACT_ROWS * DE * 2;
constexpr int CW_CNT = 1024;

__device__ __forceinline__ float bf2f(bf16_t h) { return __uint_as_float((unsigned)h << 16); }
__device__ __forceinline__ bf16_t f2bf(float f) { unsigned u = __float_as_uint(f); u += 0x7fffu + ((u >> 16) & 1u); return (bf16_t)(u >> 16); }
__device__ __forceinline__ unsigned pk2(float lo, float hi) { return (unsigned)f2bf(lo) | ((unsigned)f2bf(hi) << 16); }
__device__ __forceinline__ float gelu_tanh(float x) { const float t = x + 0.044715f * x * x * x; return x * __builtin_amdgcn_rcpf(1.0f + __builtin_amdgcn_exp2f(-2.3022082f * t)); }
__device__ __forceinline__ float silu(float x) { return x * __builtin_amdgcn_rcpf(1.0f + __builtin_amdgcn_exp2f(-1.4426950408889634f * x)); }
__device__ __forceinline__ float softplus2(float u) { return fmaxf(u, 0.f) + __log2f(1.0f + exp2f(-fabsf(u))); }
__device__ __forceinline__ float wave_sum(float v) {
#pragma unroll
    for (int o = 1; o < 64; o <<= 1) v += __shfl_xor(v, o);
    return v;
}
__device__ __forceinline__ float wave_max(float v) {
#pragma unroll
    for (int o = 1; o < 64; o <<= 1) v = fmaxf(v, __shfl_xor(v, o));
    return v;
}
__device__ __forceinline__ float rs4(const float* ss, int row) { const f32x4* p = (const f32x4*)(ss + (size_t)row * 16); const f32x4 a = p[0], b = p[1], c = p[2], d = p[3];
    return rsqrtf(((((a[0] + a[1]) + (a[2] + a[3])) + ((b[0] + b[1]) + (b[2] + b[3]))) + (((c[0] + c[1]) + (c[2] + c[3])) + ((d[0] + d[1]) + (d[2] + d[3])))) * (1.0f / 1024.0f) + EPS); }

__global__ __launch_bounds__(256) void k_transpose(const float* __restrict__ src, bf16_t* __restrict__ dst, const float* __restrict__ gain, const float* __restrict__ gain2, int ksplit,
                                                   float scale, int K, int N, int src_ld, long ssi, long sso, long dsi, long dso, int gso, int G, int GS, int GO) {
    __shared__ float tile[64][65];
    const int ntn = N / 64, kt = blockIdx.x / ntn, nt = blockIdx.x % ntn;
    const float* s = src + (size_t)blockIdx.y * ssi + (size_t)blockIdx.z * sso;
    bf16_t* d = dst + (size_t)blockIdx.y * dsi + (size_t)blockIdx.z * dso;
    const int tx = threadIdx.x & 63, ty = threadIdx.x >> 6;
#pragma unroll 4
    for (int i = 0; i < 16; ++i) { const int k = ty + 4 * i; tile[k][tx] = s[(size_t)(kt * 64 + k) * src_ld + nt * 64 + tx]; }
    __syncthreads();
    const int kx = threadIdx.x & 31, ny = threadIdx.x >> 5, k0 = kt * 64 + 2 * kx;
    float ga = scale, gb = scale;
    if (gain) { const float* g1 = gain + (size_t)blockIdx.z * gso; const float* g2 = gain2 ? gain2 + (size_t)blockIdx.z * gso : g1;
        ga *= (k0 < ksplit) ? g1[k0] : g2[k0 - ksplit]; gb *= (k0 + 1 < ksplit) ? g1[k0 + 1] : g2[k0 + 1 - ksplit]; }
#pragma unroll
    for (int i = 0; i < 8; ++i) { const int n = ny + 8 * i, ng = nt * 64 + n, drow = (ng / G) * GS + GO + (ng % G);
        *(unsigned*)(d + (size_t)drow * K + k0) = pk2(tile[2 * kx][n] * ga, tile[2 * kx + 1][n] * gb); }
}
__global__ void k_prep_router(const float* __restrict__ w_router, const float* __restrict__ w_group, const float* __restrict__ norm_moe, bf16_t* __restrict__ WR) {
    const int idx = blockIdx.x * 256 + threadIdx.x; if (idx >= NL * 64 * DM) return;
    const int k = idx % DM, n = (idx / DM) % 64, l = idx / (64 * DM);
    float v = 0.f;
    if (n < 32) v = w_router[((size_t)l * DM + k) * NE + n]; else if (n < 36) v = w_group[((size_t)l * DM + k) * NG + (n - 32)];
    WR[idx] = f2bf(v * norm_moe[l * DM + k]);
}
__global__ void k_prep_spatial(const float* __restrict__ w_sp, bf16_t* __restrict__ WS) {
    const int idx = blockIdx.x * 256 + threadIdx.x; if (idx >= NL * AG * CHUNK * CHUNK) return;
    const int s = idx % CHUNK, t = (idx / CHUNK) % CHUNK;
    WS[idx] = (s <= t) ? f2bf(w_sp[idx]) : (bf16_t)0;
}
__global__ __launch_bounds__(256) void k_prep_rows(const float* __restrict__ x, bf16_t* __restrict__ xb, float* __restrict__ ss4, float* __restrict__ ss1, int R) {
    const int row = blockIdx.x * 4 + (threadIdx.x >> 6), lane = threadIdx.x & 63; if (row >= R) return;
    float tot = 0.f;
#pragma unroll
    for (int j = 0; j < 4; ++j) {
        const f32x4 v = *(const f32x4*)(x + (size_t)row * DM + j * 256 + lane * 4);
        u32x2 w; w.x = pk2(v[0], v[1]); w.y = pk2(v[2], v[3]);
        *(u32x2*)(xb + (size_t)row * DM + j * 256 + lane * 4) = w;
        float s = (v[0] * v[0] + v[1] * v[1]) + (v[2] * v[2] + v[3] * v[3]);
        s += __shfl_xor(s, 1); s += __shfl_xor(s, 2); s += __shfl_xor(s, 4); s += __shfl_xor(s, 8);
        if (ss4 && (lane & 15) == 0) ss4[(size_t)row * 16 + j * 4 + (lane >> 4)] = s;
        s += __shfl_xor(s, 16); s += __shfl_xor(s, 32);
        tot += s;
    }
    if (ss1 && lane == 0) ss1[row] = tot;
}

#define MFMA32(a, b, c) __builtin_amdgcn_mfma_f32_32x32x16_bf16((a), (b), (c), 0, 0, 0)
struct SUnit { int p0, q0, aux0, aux1, aux2; };
template <class Prob> __global__ __launch_bounds__(256) void k_sgemm(Prob pr) {
    const int tid = threadIdx.x, wave = tid >> 6, lane = tid & 63, c = lane & 31, h = lane >> 5;
    SUnit u;
    if (!pr.unit((int)blockIdx.x, (int)blockIdx.y, u)) return;
    int pb[2], qb[2];
#pragma unroll
    for (int i = 0; i < 2; ++i) { pb[i] = u.p0 + (Prob::PAIRED ? 32 * wave + 128 * i : 64 * wave + 32 * i); qb[i] = u.q0 + 32 * i; }
    const bf16_t* pa[2]; const bf16_t* qa[2];
#pragma unroll
    for (int i = 0; i < 2; ++i) { pa[i] = pr.prow(u, pb[i] + c) + 8 * h; qa[i] = pr.qrow(u, qb[i] + c) + 8 * h; }
    f32x16 acc[2][2];
#pragma unroll
    for (int i = 0; i < 2; ++i)
#pragma unroll
        for (int j = 0; j < 2; ++j)
#pragma unroll
            for (int r = 0; r < 16; ++r) acc[i][j][r] = 0.f;
    constexpr int K = Prob::K;
#pragma unroll 1
    for (int kh = 0; kh < 2; ++kh) {
        if (Prob::MIDK && kh == 1) {
            const float r0 = pr.midscale(u, qb[0] + c), r1 = pr.midscale(u, qb[1] + c);
#pragma unroll
            for (int i = 0; i < 2; ++i)
#pragma unroll
                for (int r = 0; r < 16; ++r) { acc[i][0][r] *= r0; acc[i][1][r] *= r1; }
        }
#pragma unroll 4
        for (int k = kh * (K / 2); k < (kh + 1) * (K / 2); k += 16) {
            const bf16x8 a0 = *(const bf16x8*)(pa[0] + k), a1 = *(const bf16x8*)(pa[1] + k), b0 = *(const bf16x8*)(qa[0] + k), b1 = *(const bf16x8*)(qa[1] + k);
            acc[0][0] = MFMA32(a0, b0, acc[0][0]); acc[0][1] = MFMA32(a0, b1, acc[0][1]); acc[1][0] = MFMA32(a1, b0, acc[1][0]); acc[1][1] = MFMA32(a1, b1, acc[1][1]);
        }
    }
    float ss[2] = {0.f, 0.f};
#pragma unroll
    for (int j = 0; j < 2; ++j)
#pragma unroll
        for (int g = 0; g < 4; ++g) {
            if (Prob::PAIRED) {
                const f32x4 va = {acc[0][j][4 * g], acc[0][j][4 * g + 1], acc[0][j][4 * g + 2], acc[0][j][4 * g + 3]};
                const f32x4 vb = {acc[1][j][4 * g], acc[1][j][4 * g + 1], acc[1][j][4 * g + 2], acc[1][j][4 * g + 3]};
                pr.epi2(u, pb[0] + 8 * g + 4 * h, qb[j] + c, va, vb);
            } else {
#pragma unroll
                for (int i = 0; i < 2; ++i) {
                    const f32x4 v = {acc[i][j][4 * g], acc[i][j][4 * g + 1], acc[i][j][4 * g + 2], acc[i][j][4 * g + 3]};
                    ss[j] += pr.epi(u, pb[i] + 8 * g + 4 * h, qb[j] + c, v);
                }
            }
        }
    if (Prob::ROWSS) {
#pragma unroll
        for (int j = 0; j < 2; ++j) { ss[j] += __shfl_xor(ss[j], 32); if (h == 0) pr.rowss(u, qb[j] + c, wave, ss[j]); }
    }
}

struct Ptrs {
    unsigned char* ws; const float* x_in; float* out; int l;
    __device__ __forceinline__ bf16_t* b(size_t off) const { return (bf16_t*)(ws + off); }
    __device__ __forceinline__ float* f(size_t off) const { return (float*)(ws + off); }
    __device__ __forceinline__ int* i(size_t off) const { return (int*)(ws + off); }
};
__device__ __forceinline__ void st4bf(bf16_t* p, f32x4 v) { u32x2 w; w.x = pk2(v[0], v[1]); w.y = pk2(v[2], v[3]); *(u32x2*)p = w; }

struct ProbIn { static constexpr int K = DM; static constexpr bool PAIRED = false, MIDK = false, ROWSS = false; Ptrs P;
    __device__ bool unit(int bx, int, SUnit& u) const { u.p0 = (bx % 6) * 256; u.q0 = (bx / 6) * 64; return true; }
    __device__ const bf16_t* prow(const SUnit&, int p) const { return P.b(OFF_WIN + P.l * SZ_WIN) + (size_t)p * DM; }
    __device__ const bf16_t* qrow(const SUnit&, int q) const { return P.b(OFF_XB) + (size_t)q * DM; }
    __device__ float midscale(const SUnit&, int) const { return 1.f; }
    __device__ float epi(const SUnit&, int p, int q, f32x4 v) const {
        const float rs = rs4(P.f(OFF_SSX), q); v = v * rs;
        if (p < 512) { for (int i = 0; i < 4; ++i) v[i] = gelu_tanh(v[i]); st4bf(P.b(OFF_U) + (size_t)q * 512 + p, v); }
        else if (p < 1024) st4bf(P.b(OFF_Q) + (size_t)q * 512 + (p - 512), v);
        else st4bf(P.b(OFF_K) + (size_t)q * 512 + (p - 1024), v);
        return 0.f; }
    __device__ void epi2(const SUnit&, int, int, f32x4, f32x4) const {}
    __device__ void rowss(const SUnit&, int, int, float) const {}
};
struct ProbInT { static constexpr int K = DM; static constexpr bool PAIRED = false, MIDK = false, ROWSS = false; Ptrs P;
    __device__ bool unit(int bx, int, SUnit& u) const { u.p0 = (bx % 64) * 256; u.q0 = (bx / 64) * 64; return true; }
    __device__ const bf16_t* prow(const SUnit&, int p) const { return P.b(OFF_XB) + (size_t)p * DM; }
    __device__ const bf16_t* qrow(const SUnit&, int q) const { return P.b(OFF_WIN + P.l * SZ_WIN) + (size_t)(1536 + q) * DM; }
    __device__ float midscale(const SUnit&, int) const { return 1.f; }
    __device__ float epi(const SUnit&, int p, int q, f32x4 v) const {
        for (int i = 0; i < 4; ++i) v[i] *= rs4(P.f(OFF_SSX), p + i);
        if (q < 512) { for (int i = 0; i < 4; ++i) v[i] = gelu_tanh(v[i]); st4bf(P.b(OFF_VGT) + (size_t)q * T + p, v); }
        else st4bf(P.b(OFF_VBT) + (size_t)(q - 512) * T + p, v);
        return 0.f; }
    __device__ void epi2(const SUnit&, int, int, f32x4, f32x4) const {}
    __device__ void rowss(const SUnit&, int, int, float) const {}
};
struct ProbMemK { static constexpr int K = DM; static constexpr bool PAIRED = false, MIDK = false, ROWSS = false; Ptrs P;
    __device__ bool unit(int bx, int by, SUnit& u) const { u.p0 = (bx % 4) * 256; u.q0 = (bx / 4) * 64; u.aux0 = by; return true; }
    __device__ const bf16_t* prow(const SUnit& u, int p) const { return P.b(OFF_WXK + u.aux0 * SZ_SQ) + (size_t)p * DM; }
    __device__ const bf16_t* qrow(const SUnit&, int q) const { return P.b(OFF_MB) + (size_t)q * DM; }
    __device__ float midscale(const SUnit&, int) const { return 1.f; }
    __device__ float epi(const SUnit& u, int p, int q, f32x4 v) const {
        const float rs = rsqrtf(P.f(OFF_SSM)[q] * (1.0f / 1024.0f) + EPS); v = v * rs;
        st4bf(P.b(OFF_KX) + ((size_t)u.aux0 * MT + q) * DM + p, v); return 0.f; }
    __device__ void epi2(const SUnit&, int, int, f32x4, f32x4) const {}
    __device__ void rowss(const SUnit&, int, int, float) const {}
};
struct ProbMemVT { static constexpr int K = DM; static constexpr bool PAIRED = false, MIDK = false, ROWSS = false; Ptrs P;
    __device__ bool unit(int bx, int by, SUnit& u) const { u.p0 = (bx % 4) * 256; u.q0 = (bx / 4) * 64; u.aux0 = by; return true; }
    __device__ const bf16_t* prow(const SUnit&, int p) const { return P.b(OFF_MB) + (size_t)p * DM; }
    __device__ const bf16_t* qrow(const SUnit& u, int q) const { return P.b(OFF_WXV + u.aux0 * SZ_SQ) + (size_t)q * DM; }
    __device__ float midscale(const SUnit&, int) const { return 1.f; }
    __device__ float epi(const SUnit& u, int p, int q, f32x4 v) const {
        for (int i = 0; i < 4; ++i) v[i] *= rsqrtf(P.f(OFF_SSM)[p + i] * (1.0f / 1024.0f) + EPS);
        st4bf(P.b(OFF_VXT) + ((size_t)u.aux0 * DM + q) * MT + p, v); return 0.f; }
    __device__ void epi2(const SUnit&, int, int, f32x4, f32x4) const {}
    __device__ void rowss(const SUnit&, int, int, float) const {}
};
__device__ __forceinline__ float resid_store(const Ptrs& P, const float* res, int tok, int col, f32x4 add) {
    const f32x4 r = *(const f32x4*)(res + (size_t)tok * DM + col);
    const f32x4 xn = r + add;
    *(f32x4*)(P.f(OFF_XF) + (size_t)tok * DM + col) = xn;
    st4bf(P.b(OFF_XB) + (size_t)tok * DM + col, xn);
    return (xn[0] * xn[0] + xn[1] * xn[1]) + (xn[2] * xn[2] + xn[3] * xn[3]);
}
struct ProbOut { static constexpr int K = DM; static constexpr bool PAIRED = false, MIDK = true, ROWSS = true; Ptrs P;
    __device__ float rsa(int q) const { const f32x4 v = *(const f32x4*)(P.f(OFF_SSA) + (size_t)q * 4); return rsqrtf(((v[0] + v[1]) + (v[2] + v[3])) * (1.0f / 512.0f) + EPS); }
    __device__ float rsb(int q) const { const f32x4 v = *(const f32x4*)(P.f(OFF_SSB) + (size_t)q * 8), w = *(const f32x4*)(P.f(OFF_SSB) + (size_t)q * 8 + 4);
        return rsqrtf((((v[0] + v[1]) + (v[2] + v[3])) + ((w[0] + w[1]) + (w[2] + w[3]))) * (1.0f / 512.0f) + EPS); }
    __device__ bool unit(int bx, int, SUnit& u) const { u.p0 = (bx % 4) * 256; u.q0 = (bx / 4) * 64; return true; }
    __device__ const bf16_t* prow(const SUnit&, int p) const { return P.b(OFF_WOUT + P.l * SZ_SQ) + (size_t)p * DM; }
    __device__ const bf16_t* qrow(const SUnit&, int q) const { return P.b(OFF_Y) + (size_t)q * DM; }
    __device__ float midscale(const SUnit&, int q) const { return rsa(q) / rsb(q); }
    __device__ float epi(const SUnit&, int p, int q, f32x4 v) const { const float* res = (P.l == 0) ? P.x_in : P.f(OFF_XF); return resid_store(P, res, q, p, v * rsb(q)); }
    __device__ void epi2(const SUnit&, int, int, f32x4, f32x4) const {}
    __device__ void rowss(const SUnit& u, int q, int w, float s) const { P.f(OFF_SSX)[(size_t)q * 16 + (u.p0 / 256) * 4 + w] = s; }
};
struct ProbXq { static constexpr int K = DM; static constexpr bool PAIRED = false, MIDK = false, ROWSS = false; Ptrs P;
    __device__ bool unit(int bx, int, SUnit& u) const { u.p0 = (bx % 4) * 256; u.q0 = (bx / 4) * 64; return true; }
    __device__ const bf16_t* prow(const SUnit&, int p) const { return P.b(OFF_WXQ + P.l * SZ_SQ) + (size_t)p * DM; }
    __device__ const bf16_t* qrow(const SUnit&, int q) const { return P.b(OFF_XB) + (size_t)q * DM; }
    __device__ float midscale(const SUnit&, int) const { return 1.f; }
    __device__ float epi(const SUnit&, int p, int q, f32x4 v) const { st4bf(P.b(OFF_QX) + (size_t)q * DM + p, v * rs4(P.f(OFF_SSX), q)); return 0.f; }
    __device__ void epi2(const SUnit&, int, int, f32x4, f32x4) const {}
    __device__ void rowss(const SUnit&, int, int, float) const {}
};
struct ProbXo { static constexpr int K = DM; static constexpr bool PAIRED = false, MIDK = false, ROWSS = true; Ptrs P;
    __device__ bool unit(int bx, int, SUnit& u) const { u.p0 = (bx % 4) * 256; u.q0 = (bx / 4) * 64; return true; }
    __device__ const bf16_t* prow(const SUnit&, int p) const { return P.b(OFF_WXO + P.l * SZ_SQ) + (size_t)p * DM; }
    __device__ const bf16_t* qrow(const SUnit&, int q) const { return P.b(OFF_OX) + (size_t)q * DM; }
    __device__ float midscale(const SUnit&, int) const { return 1.f; }
    __device__ float epi(const SUnit&, int p, int q, f32x4 v) const { return resid_store(P, P.f(OFF_XF), q, p, v); }
    __device__ void epi2(const SUnit&, int, int, f32x4, f32x4) const {}
    __device__ void rowss(const SUnit& u, int q, int w, float s) const { P.f(OFF_SSX)[(size_t)q * 16 + (u.p0 / 256) * 4 + w] = s; }
};
template <int TQ> __device__ __forceinline__ bool moe_decode(const int* cnt, int sg_lo, int sg_hi, int qt_flat, int& sg, int& qt, int& n, int& rowbase) {
    int rb = 0, base = 0; bool found = false;
    for (int s = 0; s < 64; ++s) {
        const int c = cnt[s];
        if (s >= sg_lo && s < sg_hi && !found) { const int nt = (c + TQ - 1) / TQ; if (qt_flat < base + nt) { sg = s; qt = qt_flat - base; n = c; rowbase = rb; found = true; } base += nt; }
        rb += (c + 255) & ~255;
    }
    return found;
}
struct ProbMoe1 { static constexpr int K = DM; static constexpr bool PAIRED = true, MIDK = false, ROWSS = false; Ptrs P;
    __device__ bool unit(int bx, int, SUnit& u) const { int sg, qt, n, rb; if (!moe_decode<64>(P.i(OFF_CTL) + CW_CNT + P.l * 64, 0, 64, bx / 4, sg, qt, n, rb)) return false;
        u.p0 = (bx % 4) * 256; u.q0 = qt * 64; u.aux0 = sg; u.aux1 = n; u.aux2 = rb; return true; }
    __device__ const bf16_t* prow(const SUnit& u, int p) const { return P.b(OFF_W13 + ((size_t)P.l * NE + (u.aux0 & 31)) * SZ_W13) + (size_t)p * DM; }
    __device__ int tok(const SUnit& u, int q) const { return P.i(OFF_PERM)[(size_t)u.aux0 * T + (q < u.aux1 ? q : u.aux1 - 1)]; }
    __device__ const bf16_t* qrow(const SUnit& u, int q) const { return P.b(OFF_XB) + (size_t)tok(u, q) * DM; }
    __device__ float midscale(const SUnit&, int) const { return 1.f; }
    __device__ float epi(const SUnit&, int, int, f32x4) const { return 0.f; }
    __device__ void epi2(const SUnit& u, int p, int q, f32x4 a, f32x4 b) const {
        const float rs = rs4(P.f(OFF_SSX), tok(u, q)); f32x4 r;
        for (int i = 0; i < 4; ++i) r[i] = silu(a[i] * rs) * (b[i] * rs);
        st4bf(P.b(OFF_ACT) + (size_t)(u.aux2 + q) * DE + (p >> 8) * 128 + (p & 127), r); }
    __device__ void rowss(const SUnit&, int, int, float) const {}
};
template <int SLOT> struct ProbMoe2 { static constexpr int K = DE; static constexpr bool PAIRED = false, MIDK = false, ROWSS = (SLOT == 1); Ptrs P;
    __device__ bool unit(int bx, int, SUnit& u) const { int sg, qt, n, rb; if (!moe_decode<64>(P.i(OFF_CTL) + CW_CNT + P.l * 64, SLOT * 32, SLOT * 32 + 32, bx / 4, sg, qt, n, rb)) return false;
        u.p0 = (bx % 4) * 256; u.q0 = qt * 64; u.aux0 = sg; u.aux1 = n; u.aux2 = rb; return true; }
    __device__ const bf16_t* prow(const SUnit& u, int p) const { return P.b(OFF_W2 + ((size_t)P.l * NE + (u.aux0 & 31)) * SZ_W2) + (size_t)p * DE; }
    __device__ const bf16_t* qrow(const SUnit& u, int q) const { return P.b(OFF_ACT) + (size_t)(u.aux2 + q) * DE; }
    __device__ float midscale(const SUnit&, int) const { return 1.f; }
    __device__ float epi(const SUnit& u, int p, int q, f32x4 v) const {
        if (q >= u.aux1) return 0.f;
        const int tok = P.i(OFF_PERM)[(size_t)u.aux0 * T + q]; const float g = P.f(OFF_GATE)[(size_t)tok * 2 + SLOT]; v = v * g;
        if (SLOT == 0) { float* xp = P.f(OFF_XF) + (size_t)tok * DM + p; *(f32x4*)xp = *(const f32x4*)xp + v; return 0.f; }
        return resid_store(P, P.f(OFF_XF), tok, p, v); }
    __device__ void epi2(const SUnit&, int, int, f32x4, f32x4) const {}
    __device__ void rowss(const SUnit& u, int q, int w, float s) const { if (q < u.aux1) { const int tok = P.i(OFF_PERM)[(size_t)u.aux0 * T + q]; P.f(OFF_SSX)[(size_t)tok * 16 + (u.p0 / 256) * 4 + w] = s; } }
};

__global__ __launch_bounds__(256) void k_attn_naive(Ptrs P) {
    const int idx = blockIdx.x * 256 + threadIdx.x, h = idx & 7, tok = idx >> 3, b = tok / SEQ, t = tok % SEQ;
    const bf16_t* Qp = P.b(OFF_Q) + (size_t)tok * 512 + h * 64;
    float q[64], o[64];
#pragma unroll
    for (int d = 0; d < 64; ++d) { q[d] = bf2f(Qp[d]); o[d] = 0.f; }
    float R = 0.f;
    for (int s = t - 1; s >= 0; --s) {
        const bf16_t* kr = P.b(OFF_K) + (size_t)(b * SEQ + s) * 512 + h * 64;
        float u = 0.f;
#pragma unroll
        for (int d = 0; d < 64; ++d) u += q[d] * bf2f(kr[d]);
        const float sp = softplus2(u), a = exp2f(u - sp - R);
        const bf16_t* vc = P.b(OFF_VBT) + (size_t)(h * 64) * T + b * SEQ + s;
#pragma unroll
        for (int d = 0; d < 64; ++d) o[d] += a * bf2f(vc[(size_t)d * T]);
        R += sp; if (R > RSTOP) break;
    }
    float ss = 0.f;
#pragma unroll
    for (int d = 0; d < 64; ++d) { const bf16_t ob = f2bf(o[d]); P.b(OFF_Y)[(size_t)tok * DM + 512 + h * 64 + d] = ob; const float of = bf2f(ob); ss += of * of; }
    P.f(OFF_SSB)[(size_t)tok * 8 + h] = ss;
}
__global__ __launch_bounds__(256) void k_gmlp_naive(Ptrs P, const float* __restrict__ v_norm, const float* __restrict__ b_sp) {
    __shared__ bf16_t vgs[128][130];
    __shared__ float rs[128];
    __shared__ float part[128][2];
    const int g = blockIdx.x & 3, bc = blockIdx.x >> 2, tok0 = bc * 128, tid = threadIdx.x, l = P.l;
    for (int idx = tid; idx < 128 * 128; idx += 256) { const int c = idx >> 7, s = idx & 127; vgs[s][c] = P.b(OFF_VGT)[(size_t)(g * 128 + c) * T + tok0 + s]; }
    __syncthreads();
    if (tid < 128) { float s2 = 0.f; for (int c = 0; c < 128; ++c) { const float v = bf2f(vgs[tid][c]); s2 += v * v; } rs[tid] = rsqrtf(s2 * (1.0f / 128.0f) + EPS); }
    __syncthreads();
    const int c = tid & 127, th = tid >> 7;
    const float gain = v_norm[(size_t)l * AW + g * 128 + c];
    const bf16_t* W = P.b(OFF_WS + l * SZ_WS) + (size_t)g * CHUNK * CHUNK;
    for (int t = th * 64; t < th * 64 + 64; ++t) {
        float acc = 0.f;
        for (int s = 0; s <= t; ++s) acc += bf2f(W[t * 128 + s]) * rs[s] * bf2f(vgs[s][c]);
        const float mixed = gain * acc + b_sp[(size_t)l * AG * CHUNK + g * CHUNK + t];
        const float y = bf2f(P.b(OFF_U)[(size_t)(tok0 + t) * 512 + g * 128 + c]) * mixed;
        const bf16_t yb = f2bf(y); P.b(OFF_Y)[(size_t)(tok0 + t) * DM + g * 128 + c] = yb;
        const float yf = bf2f(yb); const float sq = wave_sum(yf * yf);
        if ((tid & 63) == 0) part[t][(tid >> 6) & 1] = sq;
    }
    __syncthreads();
    if (tid < 128) P.f(OFF_SSA)[(size_t)(tok0 + tid) * 4 + g] = part[tid][0] + part[tid][1];
}
__global__ __launch_bounds__(256) void k_xattn_naive(Ptrs P) {
    __shared__ float qs[16][256];
    __shared__ float pp[16][256];
    const int h = blockIdx.x & 3, tok0 = (blockIdx.x >> 2) * 16, b = tok0 / SEQ, tid = threadIdx.x, l = P.l;
    for (int i = 0; i < 16; ++i) qs[i][tid] = bf2f(P.b(OFF_QX)[(size_t)(tok0 + i) * DM + h * 256 + tid]);
    __syncthreads();
    {
        const bf16_t* kr = P.b(OFF_KX) + ((size_t)l * MT + b * MEML + tid) * DM + h * 256;
        float s[16];
#pragma unroll
        for (int i = 0; i < 16; ++i) s[i] = 0.f;
        for (int d = 0; d < 256; d += 8) {
            const bf16x8 kv = *(const bf16x8*)(kr + d);
#pragma unroll
            for (int j = 0; j < 8; ++j) { const float kf = bf2f((bf16_t)kv[j]);
#pragma unroll
                for (int i = 0; i < 16; ++i) s[i] += qs[i][d + j] * kf; }
        }
#pragma unroll
        for (int i = 0; i < 16; ++i) pp[i][tid] = s[i];
    }
    __syncthreads();
    {
        const int wave = tid >> 6, lane = tid & 63;
        for (int i = wave * 4; i < wave * 4 + 4; ++i) {
            float v[4]; float m = -INFINITY;
#pragma unroll
            for (int j = 0; j < 4; ++j) { v[j] = pp[i][lane + 64 * j]; m = fmaxf(m, v[j]); }
            m = wave_max(m); float sum = 0.f;
#pragma unroll
            for (int j = 0; j < 4; ++j) { v[j] = exp2f(v[j] - m); sum += v[j]; }
            sum = wave_sum(sum); const float inv = 1.0f / sum;
#pragma unroll
            for (int j = 0; j < 4; ++j) pp[i][lane + 64 * j] = v[j] * inv;
        }
    }
    __syncthreads();
    {
        const bf16_t* vr = P.b(OFF_VXT) + ((size_t)l * DM + h * 256 + tid) * MT + b * MEML;
        float o[16];
#pragma unroll
        for (int i = 0; i < 16; ++i) o[i] = 0.f;
        for (int m = 0; m < 256; m += 8) {
            const bf16x8 vv = *(const bf16x8*)(vr + m);
#pragma unroll
            for (int j = 0; j < 8; ++j) { const float vf = bf2f((bf16_t)vv[j]);
#pragma unroll
                for (int i = 0; i < 16; ++i) o[i] += pp[i][m + j] * vf; }
        }
#pragma unroll
        for (int i = 0; i < 16; ++i) P.b(OFF_OX)[(size_t)(tok0 + i) * DM + h * 256 + tid] = f2bf(o[i]);
    }
}
__global__ __launch_bounds__(256) void k_router_naive(Ptrs P, const float* __restrict__ b_group, const float* __restrict__ b_router) {
    __shared__ float lg[4][64];
    const int tid = threadIdx.x, w = tid >> 6, n = tid & 63, tok = blockIdx.x * 4 + w, l = P.l;
    if (n < 36) {
        const bf16_t* xr = P.b(OFF_XB) + (size_t)tok * DM; const bf16_t* wr = P.b(OFF_WR + l * SZ_WR) + (size_t)n * DM;
        float dot = 0.f;
        for (int k = 0; k < DM; k += 8) { const bf16x8 a = *(const bf16x8*)(xr + k), bb = *(const bf16x8*)(wr + k);
#pragma unroll
            for (int j = 0; j < 8; ++j) dot += bf2f((bf16_t)a[j]) * bf2f((bf16_t)bb[j]); }
        lg[w][n] = dot * rs4(P.f(OFF_SSX), tok) + (n < 32 ? b_router[l * NE + n] : b_group[l * NG + (n - 32)]);
    }
    __syncthreads();
    if (n == 0) {
        int gs = 0; float gm = lg[w][32];
        for (int i = 1; i < 4; ++i) if (lg[w][32 + i] > gm) { gm = lg[w][32 + i]; gs = i; }
        float den = 0.f; for (int i = 0; i < 4; ++i) den += __expf(lg[w][32 + i] - gm);
        const float pg = 1.0f / den;
        int i1 = 0; float v1 = lg[w][gs * 8];
        for (int i = 1; i < 8; ++i) if (lg[w][gs * 8 + i] > v1) { v1 = lg[w][gs * 8 + i]; i1 = i; }
        int i2 = -1; float v2 = -INFINITY;
        for (int i = 0; i < 8; ++i) if (i != i1 && lg[w][gs * 8 + i] > v2) { v2 = lg[w][gs * 8 + i]; i2 = i; }
        const float w1 = 1.0f / (1.0f + __expf(v2 - v1)), w2 = 1.0f - w1;
        const int e1 = gs * 8 + i1, e2 = gs * 8 + i2;
        int* cnt = P.i(OFF_CTL) + CW_CNT + l * 64;
        const int p1 = atomicAdd(cnt + e1, 1), p2 = atomicAdd(cnt + 32 + e2, 1);
        P.i(OFF_PERM)[(size_t)e1 * T + p1] = tok; P.i(OFF_PERM)[(size_t)(32 + e2) * T + p2] = tok;
        P.f(OFF_GATE)[(size_t)tok * 2] = pg * w1; P.f(OFF_GATE)[(size_t)tok * 2 + 1] = pg * w2;
    }
}
__global__ __launch_bounds__(256) void k_final(Ptrs P, const float* __restrict__ norm_final) {
    const int row = blockIdx.x * 4 + (threadIdx.x >> 6), lane = threadIdx.x & 63;
    const float rs = rs4(P.f(OFF_SSX), row);
#pragma unroll
    for (int j = 0; j < 4; ++j) {
        const f32x4 v = *(const f32x4*)(P.f(OFF_XF) + (size_t)row * DM + j * 256 + lane * 4), g = *(const f32x4*)(norm_final + j * 256 + lane * 4);
        *(f32x4*)(P.out + (size_t)row * DM + j * 256 + lane * 4) = v * rs * g;
    }
}


#define LAS __attribute__((address_space(3)))
#define GAS __attribute__((address_space(1)))
template <int M> __device__ __forceinline__ float sx(float v) {
    const int i = __float_as_int(v); int r;
    if constexpr (M == 1) r = __builtin_amdgcn_mov_dpp(i, 0xB1, 0xF, 0xF, true);
    else if constexpr (M == 2) r = __builtin_amdgcn_mov_dpp(i, 0x4E, 0xF, 0xF, true);
    else if constexpr (M == 32) { auto p = __builtin_amdgcn_permlane32_swap((unsigned)i, (unsigned)i, false, false); const unsigned lo = p[0], hi = p[1]; r = (int)((__builtin_amdgcn_mbcnt_hi(~0u, __builtin_amdgcn_mbcnt_lo(~0u, 0u)) < 32u) ? hi : lo); }
    else r = __builtin_amdgcn_ds_swizzle(i, (M << 10) | 0x1F);
    return __int_as_float(r);
}
typedef float f32x2h __attribute__((ext_vector_type(2))); typedef __bf16 bf16x2h __attribute__((ext_vector_type(2)));
__device__ __forceinline__ unsigned pk2h(float lo, float hi) { f32x2h v = {lo, hi}; bf16x2h b = __builtin_convertvector(v, bf16x2h); return __builtin_bit_cast(unsigned, b); }
__device__ __forceinline__ bf16_t f2bfh(float f) { return (bf16_t)(pk2h(f, 0.f) & 0xffffu); }

constexpr int NWAVES = 8;
constexpr int RING_BYTES = 131072;
constexpr int L_MISC = RING_BYTES;
constexpr int L_SC = RING_BYTES + 12288;
constexpr int L_SC2 = RING_BYTES + 14336;
constexpr int L_ROWST = RING_BYTES + 2048;
constexpr int L_TOKL = RING_BYTES + 4096;
constexpr int L_SEG = RING_BYTES + 8192;
constexpr int LDS_BYTES = RING_BYTES + 20480;
constexpr int CW_CNTP = 150016;
constexpr int CW_BAR = 4096;

#define XB_TMO      128
#define XB_XCNT(j)  (256  + 64 * (j))
#define XB_XSUB(j)  (1280 + 64 * (j))
#define XB_XGEN(j)  (2304 + 64 * (j))
#define XB_TOP      3328
#define XB_TOPGEN   3392
#define XCD_BAR_WORDS 3456
#define XB_SPIN_CAP (1u << 18)
__device__ __forceinline__ unsigned xb_ld(unsigned* p)              { return __hip_atomic_load(p, __ATOMIC_RELAXED, __HIP_MEMORY_SCOPE_AGENT); }
__device__ __forceinline__ unsigned xb_add(unsigned* p, unsigned v) { return __hip_atomic_fetch_add(p, v, __ATOMIC_RELAXED, __HIP_MEMORY_SCOPE_AGENT); }
__device__ __forceinline__ unsigned xb_xcc_id() { return (unsigned)__builtin_amdgcn_s_getreg((3 << 11) | 20) & 0xFu; }
#define XB_SPIN(cond, bar) do { unsigned _sp = 0; while (cond) { __builtin_amdgcn_s_sleep(1); \
    if ((++_sp & 255u) == 0u) { if (xb_ld(&(bar)[XB_TMO])) break; if (_sp > XB_SPIN_CAP) { atomicAdd(&(bar)[XB_TMO], 1u); break; } } } } while (0)
struct XcdBarrier { unsigned* bar; unsigned x; volatile LAS unsigned* st; };
__device__ __forceinline__ XcdBarrier xcd_barrier_post(unsigned* bar, volatile LAS unsigned* st) {
    XcdBarrier b; b.bar = bar; b.x = xb_xcc_id(); b.st = st;
    if (threadIdx.x == 0) (void)xb_add(&bar[XB_XCNT(b.x)], 1u);
    return b;
}
__device__ __forceinline__ void xcd_barrier_complete(unsigned* bar, unsigned x, unsigned& nloc, unsigned& nx) {
    const unsigned G = gridDim.x * gridDim.y * gridDim.z;
    unsigned sum, cnt, mine, sp = 0u;
    for (;;) {
        sum = 0u; cnt = 0u; mine = 0u;
#pragma unroll
        for (unsigned j = 0; j < 16; ++j) { const unsigned c = xb_ld(&bar[XB_XCNT(j)]); sum += c; cnt += (c > 0u) ? 1u : 0u; mine = (j == x) ? c : mine; }
        if (sum == G) break;
        __builtin_amdgcn_s_sleep(1);
        if ((++sp & 255u) == 0u) { if (xb_ld(&bar[XB_TMO])) break; if (sp > XB_SPIN_CAP) { atomicAdd(&bar[XB_TMO], 1u); break; } }
    }
    nloc = mine > 0u ? mine : 1u; nx = cnt > 0u ? cnt : 1u;
}
__device__ __forceinline__ void xcd_barrier(const XcdBarrier& b, const bool leader  ) {
    asm volatile("s_waitcnt vmcnt(0)" ::: "memory");
    __syncthreads();
    if (leader) {
        unsigned* bar = b.bar; unsigned bx_ = b.x;
        asm volatile("" : "+s"(bar), "+s"(bx_));
        __builtin_amdgcn_s_waitcnt(0);
        unsigned nloc = b.st[0], nx = b.st[1];
        if (nloc == 0u) { xcd_barrier_complete(bar, bx_, nloc, nx); b.st[0] = nloc; b.st[1] = nx; }
        const unsigned old = xb_add(&bar[XB_XSUB(bx_)], 1u);
        const unsigned gen = old / nloc;
        if (old + 1u == (gen + 1u) * nloc) {
            __builtin_amdgcn_fence(__ATOMIC_RELEASE, "agent");
            asm volatile("s_waitcnt vmcnt(0)" ::: "memory");
            const unsigned og = xb_add(&bar[XB_TOP], 1u);
            const unsigned tg = og / nx;
            if (og + 1u == (tg + 1u) * nx) xb_add(&bar[XB_TOPGEN], 1u);
            else XB_SPIN(xb_ld(&bar[XB_TOPGEN]) == tg, bar);
            __builtin_amdgcn_fence(__ATOMIC_ACQUIRE, "agent");
            xb_add(&bar[XB_XGEN(bx_)], 1u);
            asm volatile("s_waitcnt vmcnt(0)" ::: "memory");
        } else {
            XB_SPIN(xb_ld(&bar[XB_XGEN(bx_)]) == gen, bar);
            __builtin_amdgcn_fence(__ATOMIC_ACQUIRE, "agent");
            asm volatile("s_waitcnt vmcnt(0)" ::: "memory");
        }
    }
    __syncthreads();
}

constexpr int CW_TEAM = 16384;
__device__ __forceinline__ void team_barrier(unsigned* cnt, const bool leader) {
    asm volatile("s_waitcnt vmcnt(0)" ::: "memory");
    __syncthreads();
    if (leader) {
        asm volatile("" : "+s"(cnt));
        (void)xb_add(cnt, 1u);
        unsigned sp = 0u;
        while (xb_ld(cnt) < 4u) { __builtin_amdgcn_s_sleep(1); if (++sp > (1u << 22)) break; }
        __builtin_amdgcn_fence(__ATOMIC_ACQUIRE, "agent");
        asm volatile("s_waitcnt vmcnt(0)" ::: "memory");
    }
    __syncthreads();
}

namespace g8 {
constexpr int BM = 256, BK = 64, HALF = 128, HTB = HALF * BK * 2, STAGE_BYTES = 8 * HTB;
__host__ __device__ __forceinline__ int lds_byte(int r, int c) { const int st = (r >> 4) * 2 + (c >> 5), rr = r & 15, cc = c & 31, ob = rr * 64 + cc * 2; return st * 1024 + (ob ^ (((ob >> 9) & 1) << 5)); }
__host__ __device__ __forceinline__ int perm32(int rho) { const int n = rho >> 4, i = rho & 15; return 8 * (i >> 2) + 4 * n + (i & 3); }
__host__ __device__ __forceinline__ void stage_rc(int b, int& R, int& C) { const int st = b / 1024, sb = b % 1024, swz = sb ^ (((sb >> 9) & 1) << 5); R = (st >> 1) * 16 + swz / 64; C = (st & 1) * 32 + (swz % 64) / 2; }
enum Kind { K_IN = 0, K_INT, K_MEMK, K_MEMVT, K_OUT, K_XQ, K_XO, K_MOE1, K_MOE2A, K_MOE2B };
struct Unit { int q0, p0, kind, a0, a1, a2, slot; };

template <bool GATHER, class Sched, class Epi>
__device__ __forceinline__ void gemm_phase(LAS unsigned char* lds, const int K, const Sched& S, const Epi& E, const int tid) {
    const int wid = __builtin_amdgcn_readfirstlane(tid >> 6), lane = tid & 63, wr = wid >> 2, wc = wid & 3, fr = lane & 15, fq = lane >> 4;
    const int nt = K / BK;
    int sR[2], sC[2]; unsigned voff[2], voffB[2];
#pragma unroll
    for (int i = 0; i < 2; ++i) { int R, C; stage_rc(tid * 16 + i * 8192, R, C); sR[i] = R; sC[i] = C; voff[i] = (unsigned)(R * K + C) * 2u;
        const int Rb = (R & ~31) + perm32(R & 31); voffB[i] = (unsigned)(Rb * K + C) * 2u; }
    const size_t kstep = (size_t)(BK * 2);
    const size_t hstep = (size_t)HALF * K * 2;
    const unsigned ldsw = (unsigned)wid * 1024u;
    const int aoff = lds_byte(wr * 64 + fr, fq * 8), boff = lds_byte(wc * 32 + fr, fq * 8);
#define G8_SA(b, h) (((b) * 2 + (h)) * HTB)
#define G8_SB(b, h) ((4 + (b) * 2 + (h)) * HTB)
#define G8_STAGE(bufoff, gbase, vo0, vo1) do { \
        __builtin_amdgcn_global_load_lds((const GAS unsigned*)((const GAS char*)(gbase) + (vo0)), (LAS unsigned*)(lds + (bufoff) + ldsw), 16, 0, 0); \
        __builtin_amdgcn_global_load_lds((const GAS unsigned*)((const GAS char*)(gbase) + (vo1)), (LAS unsigned*)(lds + (bufoff) + ldsw + 8192), 16, 0, 0); } while (0)
#define G8_STA(bufoff, base, h, g0, g1) do { if (GATHER) { G8_STAGE(bufoff, base, g0, g1); } else { G8_STAGE(bufoff, (base) + (h) * hstep, voff[0], voff[1]); } } while (0)
#define G8_STB(bufoff, base) G8_STAGE(bufoff, base, voffB[0], voffB[1])
#define G8_LDA(dst, b, h) do { _Pragma("unroll") for (int m = 0; m < 4; ++m) _Pragma("unroll") for (int k = 0; k < 2; ++k) dst[m][k] = *(const LAS bf16x8*)(lds + G8_SA(b, h) + aoff + m * 2048 + k * 1024); } while (0)
#define G8_LDB(dst, b, h) do { _Pragma("unroll") for (int n = 0; n < 2; ++n) _Pragma("unroll") for (int k = 0; k < 2; ++k) dst[n][k] = *(const LAS bf16x8*)(lds + G8_SB(b, h) + boff + n * 2048 + k * 1024); } while (0)
#define G8_MMA(ai, bj, At, Bt) do { __builtin_amdgcn_s_setprio(1); _Pragma("unroll") for (int m = 0; m < 4; ++m) _Pragma("unroll") for (int n = 0; n < 2; ++n) _Pragma("unroll") for (int k = 0; k < 2; ++k) \
        acc[ai][bj][m][n] = __builtin_amdgcn_mfma_f32_16x16x32_bf16(Bt[n][k], At[m][k], acc[ai][bj][m][n], 0, 0, 0); __builtin_amdgcn_s_setprio(0); } while (0)
#define G8_WAIT_V(n) asm volatile("s_waitcnt vmcnt(" #n ")" ::: "memory")
#define G8_WAIT_L(n) asm volatile("s_waitcnt lgkmcnt(" #n ")" ::: "memory")
#define G8_BAR __builtin_amdgcn_s_barrier()
#define G8_SCHED __builtin_amdgcn_sched_barrier(0)
    Unit cur, nxt; int ui = 0;
    if (!S.next(0, cur)) return;
    f32x4 acc[2][2][4][2];
#pragma unroll
    for (int a = 0; a < 2; ++a)
#pragma unroll
        for (int b = 0; b < 2; ++b)
#pragma unroll
            for (int m = 0; m < 4; ++m)
#pragma unroll
                for (int n = 0; n < 2; ++n) acc[a][b][m][n] = (f32x4){0.f, 0.f, 0.f, 0.f};
    bf16x8 At[4][2], B0[2][2], B1[2][2];
    const GAS char* cA = S.ptrA(cur); const GAS char* cB = S.ptrB(cur);
    unsigned g00 = 0, g01 = 0, g10 = 0, g11 = 0;
    if (GATHER) { const LAS int* tl = E.tokl(cur.slot); g00 = (unsigned)tl[sR[0]] * (unsigned)(K * 2) + sC[0] * 2; g01 = (unsigned)tl[sR[1]] * (unsigned)(K * 2) + sC[1] * 2;
                  g10 = (unsigned)tl[sR[0] + 128] * (unsigned)(K * 2) + sC[0] * 2; g11 = (unsigned)tl[sR[1] + 128] * (unsigned)(K * 2) + sC[1] * 2; G8_WAIT_L(0); }
    G8_STB(G8_SB(0, 0), cB); G8_STB(G8_SB(0, 1), cB + hstep); G8_STA(G8_SA(0, 0), cA, 0, g00, g01); G8_STA(G8_SA(0, 1), cA, 1, g10, g11);
    E.prep(cur, 0, tid); asm volatile("s_waitcnt lgkmcnt(0)" ::: "memory"); G8_BAR;
    if (wr == 1) G8_BAR;
    G8_WAIT_V(2); G8_BAR;
    G8_STB(G8_SB(1, 0), cB + kstep); G8_STA(G8_SA(1, 0), cA + kstep, 0, g00, g01); G8_STB(G8_SB(1, 1), cB + hstep + kstep);
    G8_WAIT_V(6); G8_BAR;
    for (;;) {
        const bool has_next = S.next(ui + 1, nxt);
        const GAS char* nA = has_next ? S.ptrA(nxt) : cA; const GAS char* nB = has_next ? S.ptrB(nxt) : cB;
        for (int t = 0; t < nt; t += 2) {
            const bool last = (t == nt - 2);
            if (Epi::MIDK) { if (t == nt / 2) E.midk(acc, cur, wr, fr); }
            const GAS char* a1 = cA + (size_t)(t + 1) * kstep;
            const GAS char* a2 = last ? nA : cA + (size_t)(t + 2) * kstep; const GAS char* b2 = last ? nB : cB + (size_t)(t + 2) * kstep;
            const GAS char* a3 = a2 + kstep; const GAS char* b3 = b2 + kstep;
            G8_LDB(B0, 0, 0); G8_LDB(B1, 0, 1); G8_SCHED; G8_LDA(At, 0, 0); G8_STA(G8_SA(1, 1), a1, 1, g10, g11);
            if (GATHER) { if (last && has_next) { const LAS int* tl = E.tokl(nxt.slot); int t2 = tid; asm volatile("" : "+v"(t2)); int R0, C0, R1, C1; stage_rc(t2 * 16, R0, C0); stage_rc(t2 * 16 + 8192, R1, C1);
                  g00 = (unsigned)tl[R0] * (unsigned)(K * 2) + C0 * 2; g01 = (unsigned)tl[R1] * (unsigned)(K * 2) + C1 * 2;
                  g10 = (unsigned)tl[R0 + 128] * (unsigned)(K * 2) + C0 * 2; g11 = (unsigned)tl[R1 + 128] * (unsigned)(K * 2) + C1 * 2; } }
            G8_WAIT_V(8); G8_WAIT_L(0); G8_BAR; if (!(Epi::RAGGED && cur.a1 <= wr * 64)) { G8_MMA(0, 0, At, B0); G8_MMA(0, 1, At, B1); } G8_BAR; G8_SCHED;
            G8_LDA(At, 0, 1); G8_STB(G8_SB(0, 0), b2); G8_STB(G8_SB(0, 1), b2 + hstep); G8_STA(G8_SA(0, 0), a2, 0, g00, g01);
            G8_WAIT_V(8); G8_WAIT_L(0); G8_BAR; if (!(Epi::RAGGED && cur.a1 <= 128 + wr * 64)) { G8_MMA(1, 0, At, B0); G8_MMA(1, 1, At, B1); } G8_BAR; G8_SCHED;
            G8_LDB(B0, 1, 0); G8_LDB(B1, 1, 1); G8_SCHED; G8_LDA(At, 1, 0); G8_STA(G8_SA(0, 1), a2, 1, g10, g11);
            G8_WAIT_V(8); G8_WAIT_L(0); G8_BAR; if (!(Epi::RAGGED && cur.a1 <= wr * 64)) { G8_MMA(0, 0, At, B0); G8_MMA(0, 1, At, B1); } G8_BAR; G8_SCHED;
            G8_LDA(At, 1, 1); G8_STB(G8_SB(1, 0), b3); G8_STB(G8_SB(1, 1), b3 + hstep); G8_STA(G8_SA(1, 0), a3, 0, g00, g01);
            G8_WAIT_V(8); G8_WAIT_L(0); G8_BAR; if (!(Epi::RAGGED && cur.a1 <= 128 + wr * 64)) { G8_MMA(1, 0, At, B0); G8_MMA(1, 1, At, B1); } G8_BAR; G8_SCHED;
        }
        if (wr == 0) G8_BAR;
        if (has_next) E.prep(nxt, (ui + 1) & 1, tid);
        E(acc, cur, wid, wr, wc, fr, fq, tid, ui & 1);
        if (!has_next) break;
#pragma unroll
        for (int a = 0; a < 2; ++a)
#pragma unroll
            for (int b = 0; b < 2; ++b)
#pragma unroll
                for (int m = 0; m < 4; ++m)
#pragma unroll
                    for (int n = 0; n < 2; ++n) acc[a][b][m][n] = (f32x4){0.f, 0.f, 0.f, 0.f};
        cur = nxt; cA = nA; cB = nB; ++ui;
        if (wr == 1) G8_BAR;
    }
    G8_WAIT_V(0);
    G8_BAR;
#undef G8_SA
#undef G8_SB
#undef G8_STAGE
#undef G8_STA
#undef G8_STB
#undef G8_LDA
#undef G8_LDB
#undef G8_MMA
#undef G8_WAIT_V
#undef G8_WAIT_L
#undef G8_BAR
#undef G8_SCHED
}
}

struct MArgs { const float* in[25]; float* out; unsigned char* ws; int ph_lo, ph_hi, li, pad; };
typedef GAS bf16_t gbf; typedef GAS float gfl; typedef GAS int gint;
struct GP {
    GAS unsigned char* ws; int l;
    __device__ __forceinline__ gbf* b(size_t off) const { return (gbf*)(ws + off); }
    __device__ __forceinline__ gfl* f(size_t off) const { return (gfl*)(ws + off); }
    __device__ __forceinline__ gint* i(size_t off) const { return (gint*)(ws + off); }
};
struct Frame {
    LAS unsigned char* lds; GP P; int tid, lane, wave, vcu, G;
};
__device__ __forceinline__ void gst4bf(gbf* p, f32x4 v) { u32x2 w; w.x = pk2h(v[0], v[1]); w.y = pk2h(v[2], v[3]); *(GAS u32x2*)p = w; }
__device__ __forceinline__ void gst8bf(gbf* p, f32x4 a, f32x4 b) { u32x4 w; w.x = pk2h(a[0], a[1]); w.y = pk2h(a[2], a[3]); w.z = pk2h(b[0], b[1]); w.w = pk2h(b[2], b[3]); *(GAS u32x4*)p = w; }
__device__ __forceinline__ void st16_wt(GAS void* p, u32x4 v) { asm volatile("global_store_dwordx4 %0, %1, off sc1\n\ts_nop 1" :: "v"(p), "v"(v) : "memory"); }
__device__ __forceinline__ void st4_wt(GAS float* p, float v) { asm volatile("global_store_dword %0, %1, off sc1\n\ts_nop 1" :: "v"(p), "v"(v) : "memory"); }
__device__ __forceinline__ float gresid8(gbf* xp, f32x4 a, f32x4 b) {
    const u32x4 o = *(const GAS u32x4*)xp; u32x4 w; float ss = 0.f;
#pragma unroll
    for (int j = 0; j < 4; ++j) {
        const float lo = __uint_as_float(o[j] << 16) + (j < 2 ? a[2 * j] : b[2 * j - 4]), hi = __uint_as_float(o[j] & 0xffff0000u) + (j < 2 ? a[2 * j + 1] : b[2 * j - 3]);
        const unsigned pw = pk2h(lo, hi); w[j] = pw;
        const float rl = __uint_as_float(pw << 16), rh = __uint_as_float(pw & 0xffff0000u); ss += rl * rl + rh * rh;
    }
    *(GAS u32x4*)xp = w; return ss;
}
__device__ __forceinline__ int xcd_remap(int L, int nwg) { const int q = nwg / 8, r = nwg % 8, x = L % 8, off = L / 8; return (x < r ? x * (q + 1) : r * (q + 1) + (x - r) * q) + off; }
__device__ __forceinline__ float rsum16(const gfl* ss, int row) { const GAS f32x4* p = (const GAS f32x4*)(ss + (unsigned)row * 16); const f32x4 a = p[0], b = p[1], c = p[2], d = p[3];
    return ((((a[0] + a[1]) + (a[2] + a[3])) + ((b[0] + b[1]) + (b[2] + b[3]))) + (((c[0] + c[1]) + (c[2] + c[3])) + ((d[0] + d[1]) + (d[2] + d[3])))); }

struct DenseSched {
    GP P; int type, G, c;
    __device__ __forceinline__ bool next(int i, g8::Unit& u) const {
        const int L = i * G + c;
        u.a0 = 0; u.a1 = 0; u.a2 = 0; u.slot = 0;
        if (type == 1) {
            const int nwg = 672; if (L >= nwg) return false;
            const int w = xcd_remap(L, nwg);
            if (w < 384) { const int gid = w / 48, r = w % 48, pm = gid * 8 + (r % 8), pn = r / 8; u.kind = g8::K_IN; u.q0 = pm * 256; u.p0 = pn * 256; }
            else if (w < 640) { const int v = w - 384, ch = v % 4, tk = v / 4; u.kind = g8::K_INT; u.q0 = ch * 256; u.p0 = tk * 256; }
            else { const int r = w - 640; u.a0 = P.l;
                if (r < 16) { u.kind = g8::K_MEMK; u.q0 = (r % 4) * 256; u.p0 = (r / 4) * 256; }
                else { const int r2 = r - 16; u.kind = g8::K_MEMVT; u.q0 = (r2 % 4) * 256; u.p0 = (r2 / 4) * 256; } }
            return true;
        }
        if (L >= 256) return false;
        const int w = xcd_remap(L, 256), gid = w / 32, r = w % 32, pm = gid * 8 + (r % 8), pn = r / 8;
        u.q0 = pm * 256; u.p0 = pn * 256; u.kind = (type == 3) ? g8::K_OUT : (type == 4) ? g8::K_XQ : g8::K_XO;
        return true;
    }
    __device__ __forceinline__ const GAS char* ptrA(const g8::Unit& u) const { const int l = P.l;
        const size_t off = (u.kind == g8::K_IN || u.kind == g8::K_XQ) ? OFF_XB : (u.kind == g8::K_INT) ? OFF_WIN + l * SZ_WIN + (size_t)1536 * DM * 2 : (u.kind == g8::K_MEMK) ? OFF_MB : (u.kind == g8::K_MEMVT) ? OFF_WXV + l * SZ_SQ : (u.kind == g8::K_OUT) ? OFF_Y : OFF_OX;
        return (const GAS char*)(P.ws + off) + (size_t)u.q0 * (DM * 2); }
    __device__ __forceinline__ const GAS char* ptrB(const g8::Unit& u) const { const int l = P.l;
        const size_t off = (u.kind == g8::K_IN) ? OFF_WIN + l * SZ_WIN : (u.kind == g8::K_INT) ? OFF_XB : (u.kind == g8::K_MEMK) ? OFF_WXK + l * SZ_SQ : (u.kind == g8::K_MEMVT) ? OFF_MB : (u.kind == g8::K_OUT) ? OFF_WOUT + l * SZ_SQ : (u.kind == g8::K_XQ) ? OFF_WXQ + l * SZ_SQ : OFF_WXO + l * SZ_SQ;
        return (const GAS char*)(P.ws + off) + (size_t)u.p0 * (DM * 2); }
};
struct MoeSched {
    GP P; int type, G, c, sg_lo, sg_hi; const LAS int* seg; int ibase;
    __device__ __forceinline__ bool next(int i, g8::Unit& u) const {
        if (i >= 4) return false;
        const int sg = seg[256 + 4 * i]; if (sg < 0) return false;
        const int qt = seg[256 + 4 * i + 1], pt = seg[256 + 4 * i + 2];
        u.a0 = sg; u.a1 = seg[sg] - qt * 256; u.a2 = seg[64 + sg] + qt * 256; u.slot = i; u.q0 = qt * 256; u.p0 = pt * 256;
        u.kind = (type == 8) ? g8::K_MOE1 : g8::K_MOE2A;
        return true;
    }
    __device__ __forceinline__ const GAS char* ptrA(const g8::Unit& u) const { return (type == 8) ? (const GAS char*)(P.ws + OFF_XB) : (const GAS char*)(P.ws + OFF_ACT) + (size_t)u.a2 * (DE * 2); }
    __device__ __forceinline__ const GAS char* ptrB(const g8::Unit& u) const { const size_t e = (size_t)P.l * NE + (u.a0 & 31);
        return (type == 8) ? (const GAS char*)(P.ws + OFF_W13) + e * SZ_W13 + (size_t)u.p0 * (DM * 2) : (const GAS char*)(P.ws + OFF_W2) + e * SZ_W2 + (size_t)u.p0 * (DE * 2); }
};

template <bool MIDK_, unsigned KSET> struct Epi {
    static constexpr bool MIDK = MIDK_;
    static constexpr bool RAGGED = (KSET & 0x380u) != 0u;
    GP P; LAS unsigned char* lds;
    __device__ __forceinline__ const LAS int* tokl(int slot) const { return (const LAS int*)(lds + L_TOKL) + (slot & 3) * 256; }
    __device__ __forceinline__ void midk(f32x4 (&acc)[2][2][4][2], const g8::Unit&, int wr, int fr) const {
        const LAS float* rst = (const LAS float*)(lds + L_ROWST);
#pragma unroll
        for (int ai = 0; ai < 2; ++ai)
#pragma unroll
            for (int m = 0; m < 4; ++m) { const float ratio = rst[2 * (ai * 128 + wr * 64 + m * 16 + fr)];
#pragma unroll
                for (int bj = 0; bj < 2; ++bj)
#pragma unroll
                    for (int n = 0; n < 2; ++n) acc[ai][bj][m][n] = acc[ai][bj][m][n] * ratio; }
    }
    __device__ __forceinline__ void prep(const g8::Unit& u, int b, int tid) const {
        const int kind = u.kind;
        if constexpr (MIDK_) {
            if (kind == g8::K_OUT && tid < 256) { const int q = u.q0 + tid; const f32x4 va = *(const GAS f32x4*)(P.f(OFF_SSA) + (size_t)q * 4), v0 = *(const GAS f32x4*)(P.f(OFF_SSB) + (size_t)q * 8), v1 = *(const GAS f32x4*)(P.f(OFF_SSB) + (size_t)q * 8 + 4);
                const float ra = rsqrtf(((va[0] + va[1]) + (va[2] + va[3])) * (1.0f / 512.0f) + EPS), rb = rsqrtf((((v0[0] + v0[1]) + (v0[2] + v0[3])) + ((v1[0] + v1[1]) + (v1[2] + v1[3]))) * (1.0f / 512.0f) + EPS);
                LAS float* rst = (LAS float*)(lds + L_ROWST); rst[2 * tid] = ra / rb; rst[2 * tid + 1] = rb; } }
        if (kind == g8::K_OUT || kind == g8::K_XO || kind == g8::K_MOE2A) return;
        if (tid < 256) {
            float s = 1.f;
            if (kind == g8::K_IN || kind == g8::K_XQ) s = rsqrtf(rsum16(P.f(OFF_SSX), u.q0 + tid) * (1.0f / 1024.0f) + EPS);
            else if (kind == g8::K_INT) s = rsqrtf(rsum16(P.f(OFF_SSX), u.p0 + tid) * (1.0f / 1024.0f) + EPS);
            else if (kind == g8::K_MEMK) s = rsqrtf(P.f(OFF_SSM)[u.q0 + tid] * (1.0f / 1024.0f) + EPS);
            else if (kind == g8::K_MEMVT) s = rsqrtf(P.f(OFF_SSM)[u.p0 + tid] * (1.0f / 1024.0f) + EPS);
            else if (kind == g8::K_MOE1) { const int tk = tokl(u.slot)[tid]; s = rsqrtf(rsum16(P.f(OFF_SSX), tk) * (1.0f / 1024.0f) + EPS);
                ((LAS float*)(lds + L_SC2))[b * 256 + tid] = P.f(OFF_GATE)[(unsigned)tk * 2 + (u.a0 >> 5)]; }
            ((LAS float*)(lds + L_SC))[b * 256 + tid] = s;
        }
    }
    __device__ __forceinline__ void operator()(f32x4 (&acc)[2][2][4][2], const g8::Unit& u, int wid, int wr, int wc, int fr, int fq, int tid, int b) const {
        asm volatile("" : "+v"(fr), "+v"(fq), "+v"(tid));
        const int kind = u.kind;
#define EPI_CASE(K) if ((KSET >> (K)) & 1u) { if (kind == (K)) { apply<(K)>(acc, u, wr, wc, fr, fq, b); return; } }
        EPI_CASE(g8::K_IN) EPI_CASE(g8::K_INT) EPI_CASE(g8::K_MEMK) EPI_CASE(g8::K_MEMVT) EPI_CASE(g8::K_OUT) EPI_CASE(g8::K_XQ) EPI_CASE(g8::K_XO) EPI_CASE(g8::K_MOE1) EPI_CASE(g8::K_MOE2A) EPI_CASE(g8::K_MOE2B)
#undef EPI_CASE
    }
    template <int KIND> __device__ __forceinline__ void apply(f32x4 (&acc)[2][2][4][2], const g8::Unit& u, int wr, int wc, int fr, int fq, int b) const {
        const LAS float* sc = (const LAS float*)(lds + L_SC) + b * 256;
        const int cb = wc * 32 + 8 * fq;
        gbf* dst = nullptr; unsigned pitch = 0; bool act = false;
        if constexpr (KIND == g8::K_IN) { const int pt = u.p0 >> 9; dst = (pt == 0 ? P.b(OFF_U) : pt == 1 ? P.b(OFF_Q) : P.b(OFF_K)) + (size_t)u.q0 * 512 + (u.p0 & 511); pitch = 512; act = (pt == 0); }
        else if constexpr (KIND == g8::K_INT) { act = u.q0 < 512; dst = (act ? P.b(OFF_VGT) : P.b(OFF_VBT)) + (size_t)(u.q0 & 511) * T + u.p0; pitch = T; }
        else if constexpr (KIND == g8::K_MEMK) { dst = P.b(OFF_KX) + ((size_t)u.a0 * MT + u.q0) * DM + u.p0; pitch = DM; }
        else if constexpr (KIND == g8::K_MEMVT) { dst = P.b(OFF_VXT) + ((size_t)u.a0 * DM + u.q0) * MT + u.p0; pitch = MT; }
        else if constexpr (KIND == g8::K_XQ) { dst = P.b(OFF_QX) + (size_t)u.q0 * DM + u.p0; pitch = DM; }
        else if constexpr (KIND == g8::K_MOE1) { dst = P.b(OFF_ACT) + (size_t)u.a2 * DE + (u.p0 >> 8) * 128; pitch = DE; }
        else if constexpr (KIND == g8::K_MOE2A) { dst = P.b(OFF_YM) + (size_t)(u.a0 >> 5) * DM + u.p0; pitch = 2 * DM; }
        else { dst = P.b(OFF_XB) + u.p0; pitch = DM; }
        if constexpr (KIND == g8::K_OUT || KIND == g8::K_XO) {
#pragma unroll
            for (int am = 0; am < 4; ++am) { const int ai = am >> 1;
                u32x4 pre[2][2];
#pragma unroll
                for (int mm = 0; mm < 2; ++mm)
#pragma unroll
                    for (int bj = 0; bj < 2; ++bj) pre[mm][bj] = *(const GAS u32x4*)(dst + ((unsigned)(u.q0 + ai * 128 + wr * 64 + ((am & 1) * 2 + mm) * 16 + fr) * pitch + cb + bj * 128));
#pragma unroll
                for (int mm = 0; mm < 2; ++mm) { const int m = (am & 1) * 2 + mm;
                    const int r = ai * 128 + wr * 64 + m * 16 + fr, tok = u.q0 + r; float ss = 0.f;
                    float rowsc = 1.f; if constexpr (KIND == g8::K_OUT) rowsc = ((const LAS float*)(lds + L_ROWST))[2 * r + 1];
#pragma unroll
                    for (int bj = 0; bj < 2; ++bj) {
                        const f32x4 a = acc[ai][bj][m][0] * rowsc, b = acc[ai][bj][m][1] * rowsc; const u32x4 o = pre[mm][bj]; u32x4 w;
#pragma unroll
                        for (int j = 0; j < 4; ++j) {
                            const float lo = __uint_as_float(o[j] << 16) + (j < 2 ? a[2 * j] : b[2 * j - 4]), hi = __uint_as_float(o[j] & 0xffff0000u) + (j < 2 ? a[2 * j + 1] : b[2 * j - 3]);
                            const unsigned pw = pk2h(lo, hi); w[j] = pw;
                            const float rl = __uint_as_float(pw << 16), rh = __uint_as_float(pw & 0xffff0000u); ss += rl * rl + rh * rh;
                        }
                        st16_wt(dst + ((unsigned)tok * pitch + cb + bj * 128), w);
                    }
                    ss += sx<16>(ss); ss += sx<32>(ss);
                    if (fq == 0) st4_wt(P.f(OFF_SSX) + ((unsigned)tok * 16 + (u.p0 >> 8) * 4 + wc), ss);
                }
                asm volatile("" ::: "memory");
            }
            return;
        }
#pragma unroll
        for (int ai = 0; ai < 2; ++ai)
#pragma unroll
            for (int m = 0; m < 4; ++m) {
                if constexpr (KIND == g8::K_MOE1 || KIND == g8::K_MOE2A || KIND == g8::K_MOE2B) { if (ai * 128 + wr * 64 + m * 16 >= u.a1) continue; }
                const int r = ai * 128 + wr * 64 + m * 16 + fr;
                float ss = 0.f;
                float rowsc = 1.f; if constexpr (KIND == g8::K_IN || KIND == g8::K_MEMK || KIND == g8::K_XQ || KIND == g8::K_MOE1) rowsc = sc[r];
                float gate = 1.f; if constexpr (KIND == g8::K_MOE1) gate = ((const LAS float*)(lds + L_SC2))[b * 256 + r];
                if constexpr (KIND == g8::K_OUT) rowsc = ((const LAS float*)(lds + L_ROWST))[2 * r + 1];
                int tok = u.q0 + r; bool rowok = true;
                if constexpr (KIND == g8::K_MOE2A || KIND == g8::K_MOE2B) { rowok = r < u.a1; tok = tokl(u.slot)[r]; }
#pragma unroll
                for (int bj = 0; bj < 2; ++bj) {
                    const int c = cb + bj * 128;
                    f32x4 v0 = acc[ai][bj][m][0], v1 = acc[ai][bj][m][1];
                    if constexpr (KIND == g8::K_IN || KIND == g8::K_MEMK || KIND == g8::K_XQ) { v0 = v0 * rowsc; v1 = v1 * rowsc;
                        if (KIND == g8::K_IN && act) {
#pragma unroll
                            for (int e = 0; e < 4; ++e) { v0[e] = gelu_tanh(v0[e]); v1[e] = gelu_tanh(v1[e]); } }
                        gst8bf(dst + ((unsigned)r * pitch + c), v0, v1);
                    } else if constexpr (KIND == g8::K_INT || KIND == g8::K_MEMVT) { v0 = v0 * *(const LAS f32x4*)(sc + c); v1 = v1 * *(const LAS f32x4*)(sc + c + 4);
                        if (KIND == g8::K_INT && act) {
#pragma unroll
                            for (int e = 0; e < 4; ++e) { v0[e] = gelu_tanh(v0[e]); v1[e] = gelu_tanh(v1[e]); } }
                        gst8bf(dst + ((unsigned)r * pitch + c), v0, v1);
                    } else if constexpr (KIND == g8::K_OUT || KIND == g8::K_XO) { ss += gresid8(dst + ((unsigned)tok * pitch + c), v0 * rowsc, v1 * rowsc);
                    } else if constexpr (KIND == g8::K_MOE1) {
                        if (bj == 0) { const f32x4 b0 = acc[ai][1][m][0], b1 = acc[ai][1][m][1]; f32x4 o0, o1;
#pragma unroll
                            for (int e = 0; e < 4; ++e) { o0[e] = silu(v0[e] * rowsc) * (b0[e] * rowsc) * gate; o1[e] = silu(v1[e] * rowsc) * (b1[e] * rowsc) * gate; }
                            gst8bf(dst + ((unsigned)r * pitch + c), o0, o1); }
                    } else {
                        if (rowok) gst8bf(dst + ((unsigned)tok * pitch + c), v0 * rowsc, v1 * rowsc);
                    }
                }
                if constexpr (KIND == g8::K_OUT || KIND == g8::K_XO) {
                    ss += sx<16>(ss); ss += sx<32>(ss);
                    if (fq == 0 && rowok) P.f(OFF_SSX)[(unsigned)tok * 16 + (u.p0 >> 8) * 4 + wc] = ss;
                }
                asm volatile("" ::: "memory");
            }
    }
};

__device__ __forceinline__ bf16x8 pack8(float a0, float a1, float a2, float a3, float a4, float a5, float a6, float a7) {
    u32x4 w; w.x = pk2h(a0, a1); w.y = pk2h(a2, a3); w.z = pk2h(a4, a5); w.w = pk2h(a6, a7); return __builtin_bit_cast(bf16x8, w);
}
__device__ __forceinline__ void attn_wave_unit(const GP& P, int b, int hh, int qblk, LAS unsigned char* stg, int lane) {
    const int c = lane & 31, hi = lane >> 5, t0 = qblk * 32;
    const int pic = (c & ~12) | ((c & 4) << 1) | ((c & 8) >> 1);
    const gbf* Qp = P.b(OFF_Q) + ((size_t)b * SEQ + t0 + c) * 512 + hh * 64 + 8 * hi;
    bf16x8 qf[4];
#pragma unroll
    for (int s = 0; s < 4; ++s) qf[s] = *(const GAS bf16x8*)(Qp + 16 * s);
    const gbf* Kb = P.b(OFF_K) + ((size_t)b * SEQ + pic) * 512 + hh * 64 + 8 * hi;
    const gbf* Vb = P.b(OFF_VBT) + ((size_t)hh * 64 + c) * T + (size_t)b * SEQ + 8 * hi;
    f32x16 o0, o1;
#pragma unroll
    for (int r = 0; r < 16; ++r) { o0[r] = 0.f; o1[r] = 0.f; }
    float R = 1.f;
    bf16x8 kf[4], vf[2][2], kn[4], vn[2][2];
#pragma unroll
    for (int s = 0; s < 4; ++s) kf[s] = *(const GAS bf16x8*)(Kb + (size_t)t0 * 512 + 16 * s);
#pragma unroll
    for (int s = 0; s < 2; ++s)
#pragma unroll
        for (int d = 0; d < 2; ++d) vf[s][d] = *(const GAS bf16x8*)(Vb + (size_t)d * 32 * T + t0 + 16 * s);
#define ATT_TILE(DIAG, key0) do { \
        const int kp = (key0) >= 32 ? (key0) - 32 : 0;                    \
        _Pragma("unroll") for (int s = 0; s < 4; ++s) kn[s] = *(const GAS bf16x8*)(Kb + (size_t)kp * 512 + 16 * s); \
        _Pragma("unroll") for (int s = 0; s < 2; ++s) _Pragma("unroll") for (int d = 0; d < 2; ++d) vn[s][d] = *(const GAS bf16x8*)(Vb + (size_t)d * 32 * T + kp + 16 * s); \
        f32x16 x; _Pragma("unroll") for (int r = 0; r < 16; ++r) x[r] = 0.f; \
        _Pragma("unroll") for (int s = 0; s < 4; ++s) x = MFMA32(kf[s], qf[s], x); \
        float rr[16], be[16];                                             \
        _Pragma("unroll") for (int r = 0; r < 16; ++r) { \
            float e = __builtin_amdgcn_exp2f(fminf(x[r], 100.0f));        \
            if (DIAG) { const int krel = 16 * (r >> 3) + 8 * hi + (r & 7); e = (krel < c) ? e : 0.f; }                    \
            const float rc = __builtin_amdgcn_rcpf(1.0f + e); rr[r] = rc; be[r] = e * rc; } \
        float pA = 1.f, pB = 1.f; \
        _Pragma("unroll") for (int r = 7; r >= 0; --r) { const float t = rr[r]; rr[r] = pA; pA *= t; } \
        _Pragma("unroll") for (int r = 15; r >= 8; --r) { const float t = rr[r]; rr[r] = pB; pB *= t; } \
        const float pAp = sx<32>(pA), pBp = sx<32>(pB); \
        const float baseA = R * ((hi ? 1.f : pAp) * (pB * pBp)), baseB = R * (hi ? 1.f : pBp); \
        float a[16]; \
        _Pragma("unroll") for (int r = 0; r < 8; ++r) a[r] = be[r] * (rr[r] * baseA); \
        _Pragma("unroll") for (int r = 8; r < 16; ++r) a[r] = be[r] * (rr[r] * baseB); \
        R *= (pA * pAp) * (pB * pBp); \
        const bf16x8 pa0 = pack8(a[0], a[1], a[2], a[3], a[4], a[5], a[6], a[7]), pa1 = pack8(a[8], a[9], a[10], a[11], a[12], a[13], a[14], a[15]); \
        o0 = MFMA32(pa0, vf[0][0], o0); o1 = MFMA32(pa0, vf[0][1], o1); \
        o0 = MFMA32(pa1, vf[1][0], o0); o1 = MFMA32(pa1, vf[1][1], o1); \
        _Pragma("unroll") for (int s = 0; s < 4; ++s) kf[s] = kn[s]; \
        _Pragma("unroll") for (int s = 0; s < 2; ++s) _Pragma("unroll") for (int d = 0; d < 2; ++d) vf[s][d] = vn[s][d]; } while (0)
    ATT_TILE(true, t0);
    for (int key0 = t0 - 32; key0 >= 0; key0 -= 32) {
        if (__all(R == 0.f)) break;
        ATT_TILE(false, key0);
    }
#undef ATT_TILE
    LAS bf16_t* st = (LAS bf16_t*)stg;
#pragma unroll
    for (int r = 0; r < 16; ++r) { const int row = (r & 3) + 8 * (r >> 2) + 4 * hi; st[row * 64 + c] = f2bfh(o0[r]); st[row * 64 + 32 + c] = f2bfh(o1[r]); }
    asm volatile("s_waitcnt lgkmcnt(0)" ::: "memory");
#pragma unroll
    for (int i = 0; i < 4; ++i) {
        const int row = i * 8 + (lane >> 3), ch = lane & 7; const u32x4 v = *(const LAS u32x4*)(st + row * 64 + ch * 8);
        const size_t tok = (size_t)b * SEQ + t0 + row;
        *(GAS u32x4*)(P.b(OFF_Y) + tok * DM + 512 + hh * 64 + ch * 8) = v;
        float ss = 0.f;
#pragma unroll
        for (int j = 0; j < 4; ++j) { const float lo = __uint_as_float(v[j] << 16), hi2 = __uint_as_float(v[j] & 0xffff0000u); ss += lo * lo + hi2 * hi2; }
        ss += sx<1>(ss); ss += sx<2>(ss); ss += sx<4>(ss);
        if (ch == 0) P.f(OFF_SSB)[tok * 8 + hh] = ss;
    }
    asm volatile("s_waitcnt lgkmcnt(0)" ::: "memory");
}
constexpr int AT_RING = 0, AT_STG = L_TOKL, AT_FLAGS = L_MISC + 256;
__device__ __forceinline__ void attn_block(const GP& P, int b, int hh, int sub, LAS unsigned char* lds, int tid, int wave, int lane) {
    const int c = lane & 31, hi = lane >> 5;
    const int pic = (c & ~12) | ((c & 4) << 1) | ((c & 8) >> 1);
    const GAS char* src0; int tstride;
    if (wave < 4) { const int row = tid >> 3, ch = (tid & 7) ^ ((row >> 1) & 7); src0 = (const GAS char*)(P.b(OFF_K) + ((size_t)b * SEQ + row) * 512 + hh * 64 + ch * 8); tstride = 32 * 512 * 2; }
    else { const int t2 = tid - 256, row = t2 >> 2, ch = (t2 & 3) ^ ((row >> 2) & 3); src0 = (const GAS char*)(P.b(OFF_VBT) + ((size_t)hh * 64 + row) * T + (size_t)b * SEQ + ch * 8); tstride = 32 * 2; }
    tstride = __builtin_amdgcn_readfirstlane(tstride);
    int koff[4], voff[2][2];
#pragma unroll
    for (int s = 0; s < 4; ++s) koff[s] = pic * 128 + (((hi + 2 * s) ^ ((pic >> 1) & 7)) * 16);
#pragma unroll
    for (int s = 0; s < 2; ++s)
#pragma unroll
        for (int d = 0; d < 2; ++d) { const int vr = c + 32 * d; voff[s][d] = 4096 + vr * 64 + (((hi + 2 * s) ^ ((vr >> 2) & 3)) * 16); }
    LAS unsigned char* ring = lds + AT_RING;
    volatile LAS int* flags = (volatile LAS int*)(lds + AT_FLAGS);
    bool resident = false;
#pragma unroll 1
    for (int sweep = 0; sweep < 2; ++sweep) {
        const int base = sub * 16 + (sweep == 0 ? 8 : 0), qi = base + wave, top = base + 7, t0 = qi * 32;
        const gbf* Qp = P.b(OFF_Q) + ((size_t)b * SEQ + t0 + c) * 512 + hh * 64 + 8 * hi;
        bf16x8 qf[4];
#pragma unroll
        for (int s = 0; s < 4; ++s) qf[s] = *(const GAS bf16x8*)(Qp + 16 * s);
        f32x16 o0, o1;
#pragma unroll
        for (int r = 0; r < 16; ++r) { o0[r] = 0.f; o1[r] = 0.f; }
        float R = 1.f;
        int done = 0;
        __syncthreads();
        int jhi = top;
#pragma unroll 1
        for (int round = 0;; ++round) {
            if (round > 0) {
                if (lane == 0) flags[wave] = done;
                asm volatile("s_waitcnt lgkmcnt(0)" ::: "memory"); __builtin_amdgcn_s_barrier(); asm volatile("" ::: "memory");
                const LAS unsigned* fl = (const LAS unsigned*)(lds + AT_FLAGS); const u32x4 f0 = *(const LAS u32x4*)fl, f1 = *(const LAS u32x4*)(fl + 4);
                if (((f0[0] & f0[1]) & (f0[2] & f0[3])) & ((f1[0] & f1[1]) & (f1[2] & f1[3]))) break;
                resident = false;
            }
#pragma unroll
            for (int p = 0; p < 16; ++p) { const int tile = jhi - p;
                if (tile >= 0 && !(round == 0 && resident && p < 8))
                    __builtin_amdgcn_global_load_lds((const GAS unsigned*)(src0 + (size_t)tile * (size_t)tstride), (LAS unsigned*)(ring + (tile & 15) * 8192 + wave * 1024), 16, 0, 0); }
            asm volatile("s_waitcnt vmcnt(0)" ::: "memory"); __builtin_amdgcn_s_barrier(); asm volatile("" ::: "memory");
            const int jend = (jhi - 15) > 0 ? (jhi - 15) : 0;
#pragma unroll 1
            for (int j = (qi < jhi ? qi : jhi); j >= jend && !done; --j) {
                const LAS unsigned char* sl = ring + (j & 15) * 8192;
                bf16x8 kf[4], vf[2][2];
#pragma unroll
                for (int s = 0; s < 4; ++s) kf[s] = *(const LAS bf16x8*)(sl + koff[s]);
#pragma unroll
                for (int s = 0; s < 2; ++s)
#pragma unroll
                    for (int d = 0; d < 2; ++d) vf[s][d] = *(const LAS bf16x8*)(sl + voff[s][d]);
                const f32x16 zero16 = {0.f, 0.f, 0.f, 0.f, 0.f, 0.f, 0.f, 0.f, 0.f, 0.f, 0.f, 0.f, 0.f, 0.f, 0.f, 0.f};
                f32x16 x = MFMA32(kf[0], qf[0], zero16);
#pragma unroll
                for (int s = 1; s < 4; ++s) x = MFMA32(kf[s], qf[s], x);
                float ee[16];
#pragma unroll
                for (int r = 0; r < 16; ++r) ee[r] = __builtin_amdgcn_exp2f(__builtin_amdgcn_fmed3f(x[r], -1000.0f, 15.0f));
                if (j == qi) {
#pragma unroll
                    for (int r = 0; r < 16; ++r) { const int krel = 16 * (r >> 3) + 8 * hi + (r & 7); ee[r] = (krel < c) ? ee[r] : 0.f; } }
                float FA[9], FB[9]; FA[0] = 1.f; FB[0] = 1.f;
#pragma unroll
                for (int r = 0; r < 8; ++r) { FA[r + 1] = FA[r] * (1.0f + ee[r]); FB[r + 1] = FB[r] * (1.0f + ee[8 + r]); }
                const float pA = __builtin_amdgcn_rcpf(FA[8]), pB = __builtin_amdgcn_rcpf(FB[8]), pAp = sx<32>(pA), pBp = sx<32>(pB);
                const float baseA = R * ((hi ? 1.f : pAp) * (pB * pBp)), baseB = R * (hi ? 1.f : pBp);
                float a[16];
#pragma unroll
                for (int r = 0; r < 8; ++r) { a[r] = ee[r] * ((FA[r] * pA) * baseA); a[8 + r] = ee[8 + r] * ((FB[r] * pB) * baseB); }
                R *= (pA * pAp) * (pB * pBp);
                const bf16x8 pa0 = pack8(a[0], a[1], a[2], a[3], a[4], a[5], a[6], a[7]), pa1 = pack8(a[8], a[9], a[10], a[11], a[12], a[13], a[14], a[15]);
                o0 = MFMA32(pa0, vf[0][0], o0); o1 = MFMA32(pa0, vf[0][1], o1);
                o0 = MFMA32(pa1, vf[1][0], o0); o1 = MFMA32(pa1, vf[1][1], o1);
                done = __all(R == 0.f) ? 1 : 0;
            }
            jhi -= 16;
            if (jhi < 0) break;
        }
        resident = (sweep == 0) && (jhi == top - 16);
        LAS bf16_t* st = (LAS bf16_t*)(lds + AT_STG + wave * 2048);
        float ss2[2] = {0.f, 0.f};
#pragma unroll
        for (int half = 0; half < 2; ++half) {
#pragma unroll
            for (int r = 0; r < 16; ++r) { const int row = (r & 3) + 8 * (r >> 2) + 4 * hi; st[row * 32 + c] = f2bfh(half ? o1[r] : o0[r]); }
            asm volatile("s_waitcnt lgkmcnt(0)" ::: "memory");
#pragma unroll
            for (int i = 0; i < 2; ++i) {
                const int row = i * 16 + (lane >> 2), ch = lane & 3; const u32x4 v = *(const LAS u32x4*)(st + row * 32 + ch * 8);
                const size_t tok = (size_t)b * SEQ + t0 + row;
                *(GAS u32x4*)(P.b(OFF_Y) + tok * DM + 512 + hh * 64 + half * 32 + ch * 8) = v;
#pragma unroll
                for (int j2 = 0; j2 < 4; ++j2) { const float lo = __uint_as_float(v[j2] << 16), hi2 = __uint_as_float(v[j2] & 0xffff0000u); ss2[i] += lo * lo + hi2 * hi2; }
            }
            asm volatile("s_waitcnt lgkmcnt(0)" ::: "memory");
        }
#pragma unroll
        for (int i = 0; i < 2; ++i) { float ss = ss2[i]; ss += sx<1>(ss); ss += sx<2>(ss);
            if ((lane & 3) == 0) P.f(OFF_SSB)[((size_t)b * SEQ + t0 + i * 16 + (lane >> 2)) * 8 + hh] = ss; }
    }
}
constexpr int GM_RS = L_TOKL;
__device__ __forceinline__ void gmlp_block(const GP& P, const gfl* v_norm, const gfl* b_sp, int vcu, LAS unsigned char* lds, int tid, int wave, int lane) {
    const int c = lane & 31, hi = lane >> 5, bc = vcu >> 1, g2 = wave >> 2, g = (vcu & 1) * 2 + g2, tblk = wave & 3, tok0 = bc * 128, l = P.l;
    { const GAS char* vsrc = (const GAS char*)(P.b(OFF_VGT) + (size_t)((vcu & 1) * 256) * T + tok0);
      const GAS char* wsrc = (const GAS char*)(P.b(OFF_WS + l * SZ_WS) + (size_t)((vcu & 1) * 256) * CHUNK);
#pragma unroll
      for (int i = 0; i < 8; ++i) { const int row = i * 32 + (tid >> 4), ch = (tid & 15) ^ (row & 15);
          __builtin_amdgcn_global_load_lds((const GAS unsigned*)(vsrc + ((size_t)row * T + ch * 8) * 2), (LAS unsigned*)(lds + i * 8192 + wave * 1024), 16, 0, 0); }
#pragma unroll
      for (int i = 0; i < 8; ++i) { const int row = i * 32 + (tid >> 4), ch = (tid & 15) ^ (row & 15);
          __builtin_amdgcn_global_load_lds((const GAS unsigned*)(wsrc + ((size_t)row * CHUNK + ch * 8) * 2), (LAS unsigned*)(lds + 65536 + i * 8192 + wave * 1024), 16, 0, 0); } }
    const int row = lane >> 1, half = lane & 1, t = tblk * 32 + row;
    const size_t tok = (size_t)tok0 + t;
    u32x4 uq[4][2]; float gains[4];
#pragma unroll
    for (int cb = 0; cb < 4; ++cb) { const int col = g * 128 + cb * 32 + half * 16;
        uq[cb][0] = *(const GAS u32x4*)(P.b(OFF_U) + tok * 512 + col); uq[cb][1] = *(const GAS u32x4*)(P.b(OFF_U) + tok * 512 + col + 8);
        gains[cb] = v_norm[(size_t)l * AW + g * 128 + cb * 32 + c]; }
    const float bt = b_sp[(size_t)l * AG * CHUNK + g * CHUNK + t];
    f32x16 acc[4];
#pragma unroll
    for (int cb = 0; cb < 4; ++cb)
#pragma unroll
        for (int r = 0; r < 16; ++r) acc[cb][r] = 0.f;
    asm volatile("s_waitcnt vmcnt(0)" ::: "memory"); __builtin_amdgcn_s_barrier(); asm volatile("" ::: "memory");
    {
      const int gs = tid >> 8, pos = (tid >> 1) & 127, hf = tid & 1; float s = 0.f;
#pragma unroll 16
      for (int k = 0; k < 64; ++k) { const int row = gs * 128 + hf * 64 + k;
          const float f = bf2f(*(const LAS bf16_t*)(lds + row * 256 + ((((pos >> 3) ^ (row & 15))) << 4) + (pos & 7) * 2)); s += f * f; }
      s += sx<1>(s);
      if (hf == 0) ((LAS float*)(lds + GM_RS))[gs * 128 + pos] = rsqrtf(s * (1.0f / 128.0f) + EPS); }
    asm volatile("s_waitcnt lgkmcnt(0)" ::: "memory"); __builtin_amdgcn_s_barrier(); asm volatile("" ::: "memory");
    const int nks = 2 * (tblk + 1);
    const LAS unsigned char* vb = lds + (g2 * 128 + c) * 256; const LAS unsigned char* wb = lds + 65536 + (g2 * 128 + tblk * 32 + c) * 256; const LAS float* rsl = (const LAS float*)(lds + GM_RS) + g2 * 128 + 8 * hi;
#pragma unroll 2
    for (int ks = 0; ks < nks; ++ks) {
        const int so = ((2 * ks + hi) ^ (c & 15)) << 4;
        bf16x8 vf[4];
#pragma unroll
        for (int cb = 0; cb < 4; ++cb) vf[cb] = *(const LAS bf16x8*)(vb + cb * 32 * 256 + so);
        const bf16x8 wf = *(const LAS bf16x8*)(wb + so);
        const f32x4 r0 = *(const LAS f32x4*)(rsl + 16 * ks), r1 = *(const LAS f32x4*)(rsl + 16 * ks + 4);
        float w[8];
#pragma unroll
        for (int j = 0; j < 8; ++j) w[j] = bf2f((bf16_t)wf[j]) * (j < 4 ? r0[j] : r1[j - 4]);
        const bf16x8 ws = pack8(w[0], w[1], w[2], w[3], w[4], w[5], w[6], w[7]);
#pragma unroll
        for (int cb = 0; cb < 4; ++cb) acc[cb] = MFMA32(ws, vf[cb], acc[cb]);
    }
    asm volatile("s_waitcnt lgkmcnt(0)" ::: "memory"); __syncthreads();
    LAS unsigned char* stg = lds + wave * 8192;
    LAS float* st = (LAS float*)stg;
    float ss = 0.f;
#pragma unroll
    for (int cb = 0; cb < 4; ++cb) {
        const float gain = gains[cb];
#pragma unroll
        for (int r = 0; r < 16; ++r) st[((r & 3) + 8 * (r >> 2) + 4 * hi) * 36 + c] = gain * acc[cb][r];
        asm volatile("s_waitcnt lgkmcnt(0)" ::: "memory");
        const int col = g * 128 + cb * 32 + half * 16;
        const u32x4 u0 = uq[cb][0], u1 = uq[cb][1];
        float mx[16];
#pragma unroll
        for (int j = 0; j < 4; ++j) { const f32x4 mv = *(const LAS f32x4*)(st + row * 36 + half * 16 + 4 * j); mx[4 * j] = mv[0] + bt; mx[4 * j + 1] = mv[1] + bt; mx[4 * j + 2] = mv[2] + bt; mx[4 * j + 3] = mv[3] + bt; }
        asm volatile("s_waitcnt lgkmcnt(0)" ::: "memory");
        u32x4 y0, y1;
#pragma unroll
        for (int j = 0; j < 4; ++j) {
            const float ua = __uint_as_float(u0[j] << 16), ub = __uint_as_float(u0[j] & 0xffff0000u), uc = __uint_as_float(u1[j] << 16), ud = __uint_as_float(u1[j] & 0xffff0000u);
            const unsigned w0 = pk2h(ua * mx[2 * j], ub * mx[2 * j + 1]), w1 = pk2h(uc * mx[8 + 2 * j], ud * mx[8 + 2 * j + 1]);
            y0[j] = w0; y1[j] = w1;
            const float f0 = __uint_as_float(w0 << 16), f1 = __uint_as_float(w0 & 0xffff0000u), f2 = __uint_as_float(w1 << 16), f3 = __uint_as_float(w1 & 0xffff0000u);
            ss += (f0 * f0 + f1 * f1) + (f2 * f2 + f3 * f3);
        }
        *(GAS u32x4*)(P.b(OFF_Y) + tok * DM + col) = y0; *(GAS u32x4*)(P.b(OFF_Y) + tok * DM + col + 8) = y1;
    }
    ss += sx<1>(ss);
    if (half == 0) P.f(OFF_SSA)[((size_t)tok0 + t) * 4 + g] = ss;
}
__device__ __forceinline__ void gmlp_wave_unit(const GP& P, const gfl* v_norm, const gfl* b_sp, int bc, int g, int tblk, LAS unsigned char* stg, int lane) {
    const int c = lane & 31, hi = lane >> 5, tok0 = bc * 128, l = P.l;
    const gbf* Wp = P.b(OFF_WS + l * SZ_WS) + ((size_t)g * CHUNK + tblk * 32 + c) * CHUNK + 8 * hi;
    const gbf* Vp = P.b(OFF_VGT) + ((size_t)g * 128 + c) * T + tok0 + 8 * hi;
    f32x16 acc[4];
#pragma unroll
    for (int cb = 0; cb < 4; ++cb)
#pragma unroll
        for (int r = 0; r < 16; ++r) acc[cb][r] = 0.f;
    const int nks = 2 * (tblk + 1);
    bf16x8 vf[4], vnx[4], wf, wnx;
#pragma unroll
    for (int cb = 0; cb < 4; ++cb) vf[cb] = *(const GAS bf16x8*)(Vp + (size_t)cb * 32 * T);
    wf = *(const GAS bf16x8*)(Wp);
    for (int ks = 0; ks < nks; ++ks) {
        const int kn_ = (ks + 1 < nks) ? ks + 1 : ks;
#pragma unroll
        for (int cb = 0; cb < 4; ++cb) vnx[cb] = *(const GAS bf16x8*)(Vp + (size_t)cb * 32 * T + 16 * kn_);
        wnx = *(const GAS bf16x8*)(Wp + 16 * kn_);
        float ssq[8];
#pragma unroll
        for (int j = 0; j < 8; ++j) { ssq[j] = 0.f;
#pragma unroll
            for (int cb = 0; cb < 4; ++cb) { const float f = bf2f((bf16_t)vf[cb][j]); ssq[j] += f * f; } }
#pragma unroll
        for (int j = 0; j < 8; ++j) { ssq[j] += sx<1>(ssq[j]); ssq[j] += sx<2>(ssq[j]); ssq[j] += sx<4>(ssq[j]); ssq[j] += sx<8>(ssq[j]); ssq[j] += sx<16>(ssq[j]); }
        float w[8];
#pragma unroll
        for (int j = 0; j < 8; ++j) w[j] = bf2f((bf16_t)wf[j]) * rsqrtf(ssq[j] * (1.0f / 128.0f) + EPS);
        const bf16x8 ws = pack8(w[0], w[1], w[2], w[3], w[4], w[5], w[6], w[7]);
#pragma unroll
        for (int cb = 0; cb < 4; ++cb) acc[cb] = MFMA32(ws, vf[cb], acc[cb]);
#pragma unroll
        for (int cb = 0; cb < 4; ++cb) vf[cb] = vnx[cb];
        wf = wnx;
    }
    LAS float* st = (LAS float*)stg;
    const int row = lane >> 1, half = lane & 1, t = tblk * 32 + row;
    const float bt = b_sp[(size_t)l * AG * CHUNK + g * CHUNK + t];
    float ss = 0.f;
#pragma unroll
    for (int cb = 0; cb < 4; ++cb) {
        const float gain = v_norm[(size_t)l * AW + g * 128 + cb * 32 + c];
#pragma unroll
        for (int r = 0; r < 16; ++r) st[((r & 3) + 8 * (r >> 2) + 4 * hi) * 36 + c] = gain * acc[cb][r];
        asm volatile("s_waitcnt lgkmcnt(0)" ::: "memory");
        const size_t tok = (size_t)tok0 + t; const int col = g * 128 + cb * 32 + half * 16;
        const u32x4 u0 = *(const GAS u32x4*)(P.b(OFF_U) + tok * 512 + col), u1 = *(const GAS u32x4*)(P.b(OFF_U) + tok * 512 + col + 8);
        float mx[16];
#pragma unroll
        for (int j = 0; j < 4; ++j) { const f32x4 mv = *(const LAS f32x4*)(st + row * 36 + half * 16 + 4 * j); mx[4 * j] = mv[0] + bt; mx[4 * j + 1] = mv[1] + bt; mx[4 * j + 2] = mv[2] + bt; mx[4 * j + 3] = mv[3] + bt; }
        asm volatile("s_waitcnt lgkmcnt(0)" ::: "memory");
        u32x4 y0, y1;
#pragma unroll
        for (int j = 0; j < 4; ++j) {
            const float ua = __uint_as_float(u0[j] << 16), ub = __uint_as_float(u0[j] & 0xffff0000u), uc = __uint_as_float(u1[j] << 16), ud = __uint_as_float(u1[j] & 0xffff0000u);
            const unsigned w0 = pk2h(ua * mx[2 * j], ub * mx[2 * j + 1]), w1 = pk2h(uc * mx[8 + 2 * j], ud * mx[8 + 2 * j + 1]);
            y0[j] = w0; y1[j] = w1;
            const float f0 = __uint_as_float(w0 << 16), f1 = __uint_as_float(w0 & 0xffff0000u), f2 = __uint_as_float(w1 << 16), f3 = __uint_as_float(w1 & 0xffff0000u);
            ss += (f0 * f0 + f1 * f1) + (f2 * f2 + f3 * f3);
        }
        *(GAS u32x4*)(P.b(OFF_Y) + tok * DM + col) = y0; *(GAS u32x4*)(P.b(OFF_Y) + tok * DM + col + 8) = y1;
    }
    ss += sx<1>(ss);
    if (half == 0) P.f(OFF_SSA)[((size_t)tok0 + t) * 4 + g] = ss;
}
__device__ __forceinline__ void xattn_block(const GP& P, int tokgrp, int hh, LAS unsigned char* lds, int tid, int wave, int lane) {
    const int c = lane & 31, hi = lane >> 5, tok0 = tokgrp * 256 + wave * 32, b = (tokgrp * 256) / SEQ, l = P.l;
    const int pic = (c & ~12) | ((c & 4) << 1) | ((c & 8) >> 1);
    const GAS char* Qb = (const GAS char*)(P.b(OFF_QX) + (size_t)(tokgrp * 256) * DM + hh * 256);
    const unsigned qoff = (unsigned)((wave * 32 + c) * DM + 8 * hi) * 2u;
    const GAS char* Kg = (const GAS char*)(P.b(OFF_KX) + ((size_t)l * MT + b * MEML) * DM + hh * 256);
    const GAS char* Vg = (const GAS char*)(P.b(OFF_VXT) + ((size_t)l * DM + hh * 256) * MT + b * MEML);
    const unsigned koff = (unsigned)((tid >> 3) * DM + (((tid & 7) ^ ((tid >> 4) & 7)) * 8)) * 2u, voff = (unsigned)((tid >> 5) * MT + (((tid & 31) ^ ((tid >> 5) & 15)) * 8)) * 2u;
#define XA_DMA(st) do { LAS unsigned char* sl_ = lds + ((st) % 3) * 32768 + wave * 1024; \
        if ((st) < 4) { const GAS char* bs = Kg + (size_t)(st) * 128 + koff; _Pragma("unroll") for (int i = 0; i < 4; ++i) __builtin_amdgcn_global_load_lds((const GAS unsigned*)(bs + (size_t)i * (64 * DM * 2)), (LAS unsigned*)(sl_ + i * 8192), 16, 0, 0); } \
        else { const GAS char* bs = Vg + (size_t)((st) - 4) * (64 * MT * 2) + voff; _Pragma("unroll") for (int i = 0; i < 4; ++i) __builtin_amdgcn_global_load_lds((const GAS unsigned*)(bs + (size_t)i * (16 * MT * 2)), (LAS unsigned*)(sl_ + i * 8192), 16, 0, 0); } } while (0)
#define XA_LOADQ(st, q) do { const GAS char* bs = Qb + (size_t)(st) * 128; _Pragma("unroll") for (int s = 0; s < 4; ++s) q[s] = *(const GAS bf16x8*)(bs + s * 32 + qoff); } while (0)
#define XA_SYNC do { asm volatile("s_waitcnt vmcnt(8)" ::: "memory"); __builtin_amdgcn_s_barrier(); asm volatile("" ::: "memory"); } while (0)
    int kaddr[4];
#pragma unroll
    for (int s = 0; s < 4; ++s) kaddr[s] = pic * 128 + (((2 * s + hi) ^ ((pic >> 1) & 7)) << 4);
    f32x16 x[8];
#pragma unroll
    for (int mb = 0; mb < 8; ++mb)
#pragma unroll
        for (int r = 0; r < 16; ++r) x[mb][r] = 0.f;
    bf16x8 qa[4], qb[4];
    XA_DMA(0); XA_DMA(1); XA_LOADQ(0, qa);
#pragma unroll 1
    for (int st2 = 0; st2 < 4; st2 += 2) {
        { XA_SYNC; XA_DMA(st2 + 2); XA_LOADQ(st2 + 1, qb);
          const LAS unsigned char* buf = lds + (st2 % 3) * 32768;
#pragma unroll
          for (int s = 0; s < 4; ++s)
#pragma unroll
              for (int mb = 0; mb < 8; ++mb) { const bf16x8 kf = *(const LAS bf16x8*)(buf + kaddr[s] + mb * 4096); x[mb] = MFMA32(kf, qa[s], x[mb]); } }
        { XA_SYNC; XA_DMA(st2 + 3); if (st2 == 0) XA_LOADQ(2, qa);
          const LAS unsigned char* buf = lds + ((st2 + 1) % 3) * 32768;
#pragma unroll
          for (int s = 0; s < 4; ++s)
#pragma unroll
              for (int mb = 0; mb < 8; ++mb) { const bf16x8 kf = *(const LAS bf16x8*)(buf + kaddr[s] + mb * 4096); x[mb] = MFMA32(kf, qb[s], x[mb]); } }
    }
    float m = -INFINITY;
#pragma unroll
    for (int mb = 0; mb < 8; ++mb)
#pragma unroll
        for (int r = 0; r < 16; ++r) m = fmaxf(m, x[mb][r]);
    m = fmaxf(m, sx<32>(m));
    float sum = 0.f;
#pragma unroll
    for (int mb = 0; mb < 8; ++mb)
#pragma unroll
        for (int r = 0; r < 16; ++r) { x[mb][r] = __builtin_amdgcn_exp2f(x[mb][r] - m); sum += x[mb][r]; }
    sum += sx<32>(sum);
    const float inv = 1.0f / sum;
    bf16x8 pa[8][2];
#pragma unroll
    for (int mb = 0; mb < 8; ++mb)
#pragma unroll
        for (int s = 0; s < 2; ++s)
            pa[mb][s] = pack8(x[mb][8 * s] * inv, x[mb][8 * s + 1] * inv, x[mb][8 * s + 2] * inv, x[mb][8 * s + 3] * inv, x[mb][8 * s + 4] * inv, x[mb][8 * s + 5] * inv, x[mb][8 * s + 6] * inv, x[mb][8 * s + 7] * inv);
    LAS bf16_t* stg = (LAS bf16_t*)(lds + 98304 + wave * 4096);
    int vaddr[8]; { int c2 = c, h2 = hi; asm volatile("" : "+v"(c2), "+v"(h2));
#pragma unroll
        for (int q = 0; q < 8; ++q) vaddr[q] = c2 * 512 + ((((q >> 1) * 4 + (q & 1) * 2 + h2) ^ (c2 & 15)) << 4); }
#pragma unroll 1
    for (int st = 4; st < 8; ++st) {
        XA_SYNC; if (st < 6) XA_DMA(st + 2);
        const LAS unsigned char* buf = lds + (st % 3) * 32768;
        f32x16 o0, o1;
#pragma unroll
        for (int r = 0; r < 16; ++r) { o0[r] = 0.f; o1[r] = 0.f; }
#pragma unroll
        for (int mb = 0; mb < 8; ++mb)
#pragma unroll
            for (int s = 0; s < 2; ++s) { const int va = vaddr[(mb & 3) * 2 + s] + (mb >> 2) * 256;
                const bf16x8 v0 = *(const LAS bf16x8*)(buf + va), v1 = *(const LAS bf16x8*)(buf + va + 32 * 512);
                o0 = MFMA32(pa[mb][s], v0, o0); o1 = MFMA32(pa[mb][s], v1, o1); }
#pragma unroll
        for (int r = 0; r < 16; ++r) { const int row = (r & 3) + 8 * (r >> 2) + 4 * hi; stg[row * 64 + c] = f2bfh(o0[r]); stg[row * 64 + 32 + c] = f2bfh(o1[r]); }
        asm volatile("s_waitcnt lgkmcnt(0)" ::: "memory");
        { GAS char* ob = (GAS char*)(P.b(OFF_OX) + (size_t)tok0 * DM + hh * 256 + (st - 4) * 64);
#pragma unroll
        for (int i = 0; i < 4; ++i) { const int row = i * 8 + (lane >> 3), ch = lane & 7; const u32x4 v = *(const LAS u32x4*)(stg + row * 64 + ch * 8);
            st16_wt(ob + (unsigned)(row * DM + ch * 8) * 2u, v); } }
        asm volatile("s_waitcnt lgkmcnt(0)" ::: "memory");
    }
#undef XA_DMA
#undef XA_LOADQ
#undef XA_SYNC
}
__device__ __forceinline__ void router_block(const GP& P, const gfl* b_group, const gfl* b_router, int tokblk0, LAS unsigned char* ldsbase, int wave, int lane) {
    const int c = lane & 31, hi = lane >> 5, tok0 = (tokblk0 + (wave >> 2)) * 32, kq = wave & 3, l = P.l;
    const gbf* Xp = P.b(OFF_XB) + ((size_t)tok0 + c) * DM + kq * 256 + 8 * hi;
    const gbf* Wp = P.b(OFF_WR + l * SZ_WR) + (size_t)c * DM + kq * 256 + 8 * hi;
    f32x16 d0, d1;
#pragma unroll
    for (int r = 0; r < 16; ++r) { d0[r] = 0.f; d1[r] = 0.f; }
#pragma unroll 8
    for (int s = 0; s < 16; ++s) {
        const bf16x8 a = *(const GAS bf16x8*)(Xp + 16 * s), w0 = *(const GAS bf16x8*)(Wp + 16 * s), w1 = *(const GAS bf16x8*)(Wp + (size_t)32 * DM + 16 * s);
        d0 = MFMA32(a, w0, d0); d1 = MFMA32(a, w1, d1);
    }
    LAS float* st = (LAS float*)(ldsbase + wave * 8192);
#pragma unroll
    for (int r = 0; r < 16; ++r) { const int row = (r & 3) + 8 * (r >> 2) + 4 * hi; st[row * 40 + c] = d0[r]; if (c < 4) st[row * 40 + 32 + c] = d1[r]; }
    __syncthreads();
    if (kq == 0 && lane < 32) {
        const LAS float* s0 = st + lane * 40; const LAS float* s1 = s0 + 2048; const LAS float* s2 = s0 + 4096; const LAS float* s3 = s0 + 6144;
        const int tok = tok0 + lane; const float rs = rsqrtf(rsum16(P.f(OFF_SSX), tok) * (1.0f / 1024.0f) + EPS);
        float gl[4];
#pragma unroll
        for (int i = 0; i < 4; ++i) gl[i] = ((s0[32 + i] + s1[32 + i]) + (s2[32 + i] + s3[32 + i])) * rs + b_group[l * NG + i];
        int gs = 0; float gm = gl[0];
#pragma unroll
        for (int i = 1; i < 4; ++i) if (gl[i] > gm) { gm = gl[i]; gs = i; }
        float den = 0.f;
#pragma unroll
        for (int i = 0; i < 4; ++i) den += __expf(gl[i] - gm);
        const float pg = 1.0f / den;
        float v1 = -INFINITY, v2 = -INFINITY; int i1 = 0, i2 = 0;
#pragma unroll
        for (int i = 0; i < 8; ++i) { const int n = gs * 8 + i; const float e = ((s0[n] + s1[n]) + (s2[n] + s3[n])) * rs + b_router[l * NE + n];
            if (e > v1) { v2 = v1; i2 = i1; v1 = e; i1 = i; } else if (e > v2) { v2 = e; i2 = i; } }
        const float w1 = 1.0f / (1.0f + __expf(v2 - v1)), w2 = 1.0f - w1;
        const int e1 = gs * 8 + i1, e2 = gs * 8 + i2;
        const int rep = (tok0 >> 5) & 7; int* cnt = (int*)(P.i(OFF_CTL) + CW_CNTP + l * 64 * 8 * 32);
        const int p1 = atomicAdd(cnt + (e1 * 8 + rep) * 32, 1), p2 = atomicAdd(cnt + ((32 + e2) * 8 + rep) * 32, 1);
        P.i(OFF_PERM)[(size_t)(e1 * 8 + rep) * (T / 8) + p1] = tok; P.i(OFF_PERM)[(size_t)((32 + e2) * 8 + rep) * (T / 8) + p2] = tok;
        P.f(OFF_GATE)[(size_t)tok * 2] = pg * w1; P.f(OFF_GATE)[(size_t)tok * 2 + 1] = pg * w2;
    }
}

__device__ __forceinline__ void router_block_w(const GP& P, const gfl* b_group, const gfl* b_router, int tokblk0, LAS unsigned char* lds, int tid, int wave, int lane) {
    const int c = lane & 31, hi = lane >> 5, tok0 = (tokblk0 + (wave >> 2)) * 32, kq = wave & 3, l = P.l;
    { const GAS char* wsrc = (const GAS char*)P.b(OFF_WR + l * SZ_WR);
#pragma unroll
      for (int i = 0; i < 10; ++i) { const int row = i * 4 + (tid >> 7), cs = tid & 127;
          __builtin_amdgcn_global_load_lds((const GAS unsigned*)(wsrc + row * 2048 + ((cs ^ (row & 15)) << 4)), (LAS unsigned*)(lds + i * 8192 + wave * 1024), 16, 0, 0); } }
    const gbf* Xp = P.b(OFF_XB) + ((size_t)tok0 + c) * DM + kq * 256 + 8 * hi;
    const GAS f32x4* ssp_ = (const GAS f32x4*)(P.f(OFF_SSX) + (unsigned)(tok0 + c) * 16); const f32x4 sq0_ = ssp_[0], sq1_ = ssp_[1], sq2_ = ssp_[2], sq3_ = ssp_[3];
    float bg_h[4];
#pragma unroll
    for (int i = 0; i < 4; ++i) bg_h[i] = b_group[l * NG + i];
    bf16x8 xa[16];
#pragma unroll
    for (int s = 0; s < 16; ++s) xa[s] = *(const GAS bf16x8*)(Xp + 16 * s);
    f32x16 d0, d1;
#pragma unroll
    for (int r = 0; r < 16; ++r) { d0[r] = 0.f; d1[r] = 0.f; }
    asm volatile("s_waitcnt vmcnt(0)" ::: "memory"); __builtin_amdgcn_s_barrier(); asm volatile("" ::: "memory");
#pragma unroll
    for (int s = 0; s < 16; ++s) { const int ch = kq * 32 + 2 * s + hi;
        const bf16x8 w0 = *(const LAS bf16x8*)(lds + c * 2048 + ((ch ^ (c & 15)) << 4)), w1 = *(const LAS bf16x8*)(lds + (c + 32) * 2048 + ((ch ^ (c & 15)) << 4));
        d0 = MFMA32(xa[s], w0, d0); d1 = MFMA32(xa[s], w1, d1); }
    asm volatile("s_waitcnt lgkmcnt(0)" ::: "memory"); __syncthreads();
    LAS float* st = (LAS float*)(lds + wave * 8192);
#pragma unroll
    for (int r = 0; r < 16; ++r) { const int row = (r & 3) + 8 * (r >> 2) + 4 * hi; st[row * 40 + c] = d0[r]; if (c < 4) st[row * 40 + 32 + c] = d1[r]; }
    __syncthreads();
    if (kq == 0 && lane < 32) {
        const LAS float* s0 = st + lane * 40; const LAS float* s1 = s0 + 2048; const LAS float* s2 = s0 + 4096; const LAS float* s3 = s0 + 6144;
        const int tok = tok0 + lane; const float rs = rsqrtf(((((sq0_[0] + sq0_[1]) + (sq0_[2] + sq0_[3])) + ((sq1_[0] + sq1_[1]) + (sq1_[2] + sq1_[3]))) + (((sq2_[0] + sq2_[1]) + (sq2_[2] + sq2_[3])) + ((sq3_[0] + sq3_[1]) + (sq3_[2] + sq3_[3])))) * (1.0f / 1024.0f) + EPS);
        float gl[4];
#pragma unroll
        for (int i = 0; i < 4; ++i) gl[i] = ((s0[32 + i] + s1[32 + i]) + (s2[32 + i] + s3[32 + i])) * rs + bg_h[i];
        int gs = 0; float gm = gl[0];
#pragma unroll
        for (int i = 1; i < 4; ++i) if (gl[i] > gm) { gm = gl[i]; gs = i; }
        float den = 0.f;
#pragma unroll
        for (int i = 0; i < 4; ++i) den += __expf(gl[i] - gm);
        const float pg = 1.0f / den;
        float v1 = -INFINITY, v2 = -INFINITY; int i1 = 0, i2 = 0;
#pragma unroll
        for (int i = 0; i < 8; ++i) { const int n = gs * 8 + i; const float e = ((s0[n] + s1[n]) + (s2[n] + s3[n])) * rs + b_router[l * NE + n];
            if (e > v1) { v2 = v1; i2 = i1; v1 = e; i1 = i; } else if (e > v2) { v2 = e; i2 = i; } }
        const float w1 = 1.0f / (1.0f + __expf(v2 - v1)), w2 = 1.0f - w1;
        const int e1 = gs * 8 + i1, e2 = gs * 8 + i2;
        const int rep = (tok0 >> 5) & 7; int* cnt = (int*)(P.i(OFF_CTL) + CW_CNTP + l * 64 * 8 * 32);
        const int p1 = atomicAdd(cnt + (e1 * 8 + rep) * 32, 1), p2 = atomicAdd(cnt + ((32 + e2) * 8 + rep) * 32, 1);
        P.i(OFF_PERM)[(size_t)(e1 * 8 + rep) * (T / 8) + p1] = tok; P.i(OFF_PERM)[(size_t)((32 + e2) * 8 + rep) * (T / 8) + p2] = tok;
        P.f(OFF_GATE)[(size_t)tok * 2] = pg * w1; P.f(OFF_GATE)[(size_t)tok * 2 + 1] = pg * w2;
    }
}

typedef const __attribute__((address_space(4))) MArgs* cargs_t;
constexpr int TI_PER_LAYER = 640 + 256 + 1024 + 3 * 4096;
constexpr int BG_KW = 6, BG_K1 = 4, BG_K2 = 2;
constexpr int BG_R0 = 1920, BG_WIN = 96 * 8 * BG_KW, BG_DYN = 6144, BG_N = BG_WIN + BG_DYN;
constexpr int CW_BGC = 12288;
struct CvtDesc { const gfl* s; gbf* d; const gfl* g1; const gfl* g2; int ksplit, K, src_ld, kt, nt, G, GS, GO; float scale; };
__device__ __forceinline__ CvtDesc cvt_desc(const GP& P, cargs_t a, int l, int r) {
    const int HG = 1 << 30;
    const gfl* s; gbf* d; const gfl* g1 = nullptr; const gfl* g2 = nullptr; int ksplit = DM, K = DM, src_ld, kt, nt, G = HG, GS = 0, GO = 0; float scale = 1.f;
    if (r < 640) { const int grp = r / 128, q = r % 128; kt = q / 8; nt = q % 8; src_ld = INW; g1 = (const gfl*)a->in[2] + l * DM; g2 = g1;
        s = (const gfl*)a->in[3] + (size_t)l * DM * INW + grp * 512; d = P.b(OFF_WIN + l * SZ_WIN);
        GO = (grp == 0) ? 0 : (grp == 1) ? 1536 : (grp == 2) ? 512 : (grp == 3) ? 1024 : 2048; if (grp == 2) scale = QSCALE; }
    else if (r < 896) { const int q = r - 640; kt = q / 16; nt = q % 16; src_ld = DM; s = (const gfl*)a->in[9] + (size_t)l * DM * DM; d = P.b(OFF_WOUT + l * SZ_SQ); g1 = (const gfl*)a->in[7] + l * 512; g2 = (const gfl*)a->in[8] + l * 512; ksplit = 512; }
    else if (r < 1920) { const int m = (r - 896) / 256, q = (r - 896) % 256; kt = q / 16; nt = q % 16; src_ld = DM;
        if (m == 0) { s = (const gfl*)a->in[12] + (size_t)l * DM * DM; d = P.b(OFF_WXQ + l * SZ_SQ); g1 = (const gfl*)a->in[10] + l * DM; scale = XSCALE; }
        else if (m == 1) { s = (const gfl*)a->in[13] + (size_t)l * DM * DM; d = P.b(OFF_WXK + l * SZ_SQ); g1 = (const gfl*)a->in[11] + l * DM; }
        else if (m == 2) { s = (const gfl*)a->in[14] + (size_t)l * DM * DM; d = P.b(OFF_WXV + l * SZ_SQ); g1 = (const gfl*)a->in[11] + l * DM; }
        else { s = (const gfl*)a->in[15] + (size_t)l * DM * DM; d = P.b(OFF_WXO + l * SZ_SQ); }
        g2 = g1; }
    else { const int q0 = r - 1920, m = q0 / 4096, e = (q0 % 4096) / 128, q = q0 % 128;
        if (m < 2) { nt = (q & 3) | (((q >> 3) & 1) << 2); kt = ((q >> 2) & 1) | ((q >> 4) << 1); src_ld = DE;     s = (const gfl*)(m == 0 ? a->in[21] : a->in[22]) + ((size_t)l * NE + e) * DM * DE; d = P.b(OFF_W13 + ((size_t)l * NE + e) * SZ_W13); g1 = (const gfl*)a->in[16] + l * DM; g2 = g1; G = 128; GS = 256; GO = m * 128; }
        else { K = DE; nt = (q & 3) | (((q >> 3) & 3) << 2); kt = ((q >> 2) & 1) | ((q >> 5) << 1); src_ld = DM; s = (const gfl*)a->in[23] + ((size_t)l * NE + e) * DE * DM; d = P.b(OFF_W2 + ((size_t)l * NE + e) * SZ_W2); } }
    CvtDesc D; D.s = s; D.d = d; D.g1 = g1; D.g2 = g2; D.ksplit = ksplit; D.K = K; D.src_ld = src_ld; D.kt = kt; D.nt = nt; D.G = G; D.GS = GS; D.GO = GO; D.scale = scale; return D;
}
__device__ __forceinline__ void cvt_load(const CvtDesc& D, f32x4 (&v)[16], float (&ga)[16], int lane) {
    const int kr = lane >> 4, n4 = (lane & 15) * 4;
    const gfl* sp = D.s + (size_t)(D.kt * 64 + kr) * D.src_ld + D.nt * 64 + n4;
#pragma unroll
    for (int i = 0; i < 16; ++i) v[i] = __builtin_nontemporal_load((const GAS f32x4*)(sp + (size_t)(4 * i) * D.src_ld));
    { const gfl* g1 = D.g1; const gfl* g2 = D.g2; const int ksplit = D.ksplit, kt = D.kt;
#pragma unroll
      for (int i = 0; i < 16; ++i) { const int k = kt * 64 + 4 * i + kr; const gfl* gp = g1 ? ((k < ksplit) ? g1 + k : g2 + (k - ksplit)) : D.s; ga[i] = *gp; } }
}
__device__ __forceinline__ void cvt_finish(const CvtDesc& D, const f32x4 (&v)[16], const float (&ga)[16], LAS unsigned char* stg, int lane) {
    gbf* d = D.d; const int K = D.K, kt = D.kt, nt = D.nt, G = D.G, GS = D.GS, GO = D.GO; const float scale = D.scale; const bool hasg = D.g1 != nullptr;
    const int kr = lane >> 4, n4 = (lane & 15) * 4;
#pragma unroll
    for (int i = 0; i < 16; ++i) { const int k = 4 * i + kr; const float g_ = hasg ? scale * ga[i] : scale; u32x2 w; w.x = pk2h(v[i][0] * g_, v[i][1] * g_); w.y = pk2h(v[i][2] * g_, v[i][3] * g_);
        *(LAS u32x2*)(stg + k * 128 + ((n4 * 2) ^ ((k >> 3) << 3))) = w; }
    asm volatile("s_waitcnt lgkmcnt(0)" ::: "memory");
#pragma unroll
    for (int j = 0; j < 8; ++j) {
        const int chunk = j * 64 + lane, n = chunk >> 3, kc = chunk & 7;
        unsigned short e[8];
#pragma unroll
        for (int q = 0; q < 8; ++q) e[q] = *(const LAS unsigned short*)(stg + (8 * kc + q) * 128 + ((n * 2) ^ (kc << 3)));
        u32x4 w; w.x = e[0] | ((unsigned)e[1] << 16); w.y = e[2] | ((unsigned)e[3] << 16); w.z = e[4] | ((unsigned)e[5] << 16); w.w = e[6] | ((unsigned)e[7] << 16);
        const int ng = nt * 64 + n, lg = (G == 128) ? 7 : 30, drow = (ng >> lg) * GS + GO + (ng & (G - 1));
        __builtin_nontemporal_store(w, (GAS u32x4*)(d + (size_t)drow * K + kt * 64 + 8 * kc));
    }
    asm volatile("s_waitcnt lgkmcnt(0)" ::: "memory");
}
__device__ __forceinline__ void cvt_tile_wave(const GP& P, cargs_t a, int l, int r, LAS unsigned char* stg, int lane) {
    const CvtDesc D = cvt_desc(P, a, l, r); f32x4 v[16]; float ga[16]; cvt_load(D, v, ga, lane); cvt_finish(D, v, ga, stg, lane);
}
__device__ __forceinline__ void prologue_phase(const Frame& F, cargs_t a) {
    const gfl* x = (const gfl*)a->in[0]; const gfl* mem = (const gfl*)a->in[1]; const gfl* w_sp = (const gfl*)a->in[5]; const gfl* norm_moe = (const gfl*)a->in[16];
    const gfl* w_group = (const gfl*)a->in[17]; const gfl* w_router = (const gfl*)a->in[19];
    const GP& P = F.P;
    const int gw = F.vcu * 8 + F.wave, NW_ = F.G * 8, lane = F.lane;
    LAS unsigned char* cstg = F.lds + 65536 + F.wave * 8192;
    for (int it = gw; it < NL * TI_PER_LAYER; it += NW_) { const int l_ = it / TI_PER_LAYER, r_ = it % TI_PER_LAYER;
        if (F.G == 256 && r_ >= BG_R0 && r_ < BG_R0 + (l_ >= 1 ? BG_N : BG_WIN)) continue;
        cvt_tile_wave(P, a, l_, r_, cstg, lane); }
    const int gt = F.vcu * 512 + F.tid, NT_ = F.G * 512;
    for (int idx = gt; idx < NL * 64 * DM; idx += NT_) { const int k = idx % DM, n = (idx / DM) % 64, l = idx / (64 * DM); float v = 0.f;
        if (n < 32) v = w_router[((size_t)l * DM + k) * NE + n]; else if (n < 36) v = w_group[((size_t)l * DM + k) * NG + (n - 32)];
        P.b(OFF_WR)[idx] = f2bfh(v * norm_moe[l * DM + k]); }
    for (int idx = gt; idx < NL * AG * CHUNK * CHUNK; idx += NT_) { const int s_ = idx % CHUNK, t_ = (idx / CHUNK) % CHUNK; P.b(OFF_WS)[idx] = (s_ <= t_) ? f2bfh(w_sp[idx]) : (bf16_t)0; }
    for (int row0 = gw; row0 < T + MT; row0 += 2 * NW_) {
        const bool ok1 = row0 + NW_ < T + MT; const int rowk[2] = {row0, ok1 ? row0 + NW_ : row0};
        f32x4 vv[2][4];
#pragma unroll
        for (int k = 0; k < 2; ++k) { const bool ism = rowk[k] >= T; const int rr = ism ? rowk[k] - T : rowk[k]; const gfl* src = ism ? mem : x;
#pragma unroll
            for (int j = 0; j < 4; ++j) vv[k][j] = __builtin_nontemporal_load((const GAS f32x4*)(src + (size_t)rr * DM + j * 256 + lane * 4)); }
#pragma unroll
        for (int k = 0; k < 2; ++k) if (k == 0 || ok1) {
            const bool ism = rowk[k] >= T; const int rr = ism ? rowk[k] - T : rowk[k]; gbf* dst = ism ? P.b(OFF_MB) : P.b(OFF_XB); float tot = 0.f;
#pragma unroll
            for (int j = 0; j < 4; ++j) {
                const f32x4 v = vv[k][j];
                u32x2 w; w.x = pk2h(v[0], v[1]); w.y = pk2h(v[2], v[3]); *(GAS u32x2*)(dst + (size_t)rr * DM + j * 256 + lane * 4) = w;
                float s = (v[0] * v[0] + v[1] * v[1]) + (v[2] * v[2] + v[3] * v[3]);
                s += sx<1>(s); s += sx<2>(s); s += sx<4>(s); s += sx<8>(s);
                if (!ism && (lane & 15) == 0) P.f(OFF_SSX)[(size_t)rr * 16 + j * 4 + (lane >> 4)] = s;
                s += sx<16>(s); s += sx<32>(s); tot += s;
            }
            if (ism && lane == 0) P.f(OFF_SSM)[rr] = tot;
        }
    }
}


template <bool GATHER> __device__ __forceinline__ void moe_phase(const Frame& F, const GP& P, int type, const bool reuse) {
    LAS int* seg = (LAS int*)(F.lds + L_SEG);
    const int sg_lo = 0, sg_hi = 64, l = P.l;
    const gint* cnt = P.i(OFF_CTL) + CW_CNTP + l * 64 * 8 * 32;
    const bool ru = reuse && !GATHER && ((const LAS int*)seg)[128 + 64] * 4 <= 4 * F.G;
    if (!ru && F.tid < 64) {
        int c = 0;
#pragma unroll
        for (int rp = 0; rp < 8; ++rp) { seg[512 + 8 * F.tid + rp] = c; c += cnt[(F.tid * 8 + rp) * 32]; } int rb = (c + 255) & ~255, tb = (c + 255) >> 8; const int rb0 = rb, tb0 = tb;
#pragma unroll
        for (int o = 1; o < 64; o <<= 1) { const int r2 = __shfl_up(rb, o), t2 = __shfl_up(tb, o); if (F.tid >= o) { rb += r2; tb += t2; } }
        seg[F.tid] = c; seg[64 + F.tid] = rb - rb0; seg[128 + F.tid] = tb - tb0; if (F.tid == 63) seg[128 + 64] = tb;
    }
    __syncthreads();
    int bxl = blockIdx.x; asm volatile("" : "+s"(bxl));
    LAS int* tl = (LAS int*)(F.lds + L_TOKL);
    const int nwg = seg[128 + 64] * 4;
    for (int ibase = 0; ibase * F.G + bxl < nwg; ibase += 4) {
        if (!ru && F.tid < 64) {
            const int lo = seg[128 + F.tid] * 4, hi = seg[128 + F.tid + 1] * 4;
#pragma unroll
            for (int i = 0; i < 4; ++i) { const int L = (ibase + i) * F.G + bxl;
                if (L >= nwg) { if (F.tid == 0) seg[256 + 4 * i] = -1; }
                else { const int w = xcd_remap(L, nwg); if (w >= lo && w < hi) { const int nts = (hi - lo) >> 2, r = w - lo; seg[256 + 4 * i] = F.tid; seg[256 + 4 * i + 1] = r % nts; seg[256 + 4 * i + 2] = r / nts; } } }
        }
        __syncthreads();
        if (!ru) {
            int tv[4];
#pragma unroll
            for (int i = 0; i < 4; ++i) { const int sg0 = seg[256 + 4 * i], sg = sg0 > 0 ? sg0 : 0; const int n = seg[sg]; int r = seg[256 + 4 * i + 1] * 256 + (F.tid & 255); r = r < n ? r : n - 1; r = r > 0 ? r : 0;
                int rp = 0;
#pragma unroll
                for (int q = 1; q < 8; ++q) rp += (seg[512 + 8 * sg + q] <= r) ? 1 : 0;
                int idx = (sg * 8 + rp) * (T / 8) + (r - seg[512 + 8 * sg + rp]); idx = (sg0 >= 0 && idx >= 0) ? idx : 0;
                tv[i] = P.i(OFF_PERM)[idx]; }
#pragma unroll
            for (int i = 0; i < 4; ++i) if (!ru && seg[256 + 4 * i] >= 0 && F.tid < 256) tl[i * 256 + F.tid] = tv[i];
        }
        __syncthreads();
        MoeSched S{P, type, F.G, bxl, sg_lo, sg_hi, seg, ibase};
        if (GATHER) { Epi<false, 0x80u> E{P, F.lds}; g8::gemm_phase<true>(F.lds, DM, S, E, F.tid); }
        else { Epi<false, 0x100u> E{P, F.lds}; g8::gemm_phase<false>(F.lds, DE, S, E, F.tid); }
        __syncthreads();
    }
}

constexpr int N_PHASES = 42;
#ifndef CT_MASK
#define CT_MASK 0xFFF
#endif
#define CT(t) (((CT_MASK) >> (t)) & 1)
__global__ void __launch_bounds__(NWAVES * 64, 2) mega(MArgs a) {
    extern __shared__ __attribute__((aligned(16))) unsigned char lds_raw[];
    Frame F; F.lds = (LAS unsigned char*)lds_raw;
    F.tid = threadIdx.x; F.lane = F.tid & 63; F.wave = __builtin_amdgcn_readfirstlane(F.tid >> 6); const int wave_s = F.wave;
    F.G = gridDim.x; { const int bx = blockIdx.x; F.vcu = (F.G % 8 == 0) ? (bx % 8) * (F.G / 8) + bx / 8 : bx; }
    F.P.ws = (GAS unsigned char*)a.ws; F.P.l = 0;
    volatile LAS unsigned* MISC = (volatile LAS unsigned*)(F.lds + L_MISC);
    if (F.tid < 64) MISC[F.tid] = 0u;
    __syncthreads();
    XcdBarrier bar = xcd_barrier_post((unsigned*)(a.ws + OFF_CTL) + CW_BAR + a.li * XCD_BAR_WORDS, MISC + 8);
#ifdef PROBE_PAD
    unsigned long long tacc_ = 0ull;
#endif
    for (int ph = a.ph_lo; ph < a.ph_hi; ++ph) {
        if (gridDim.x == 256 && ph >= 1 && ph < N_PHASES - 1 && (ph - 1) % 10 == 4) continue;
#ifdef PROBE_PAD
        const unsigned long long tph0_ = __builtin_amdgcn_s_memrealtime();
#endif
        { int ln_ = (int)__builtin_amdgcn_mbcnt_hi(~0u, __builtin_amdgcn_mbcnt_lo(~0u, 0u)); asm volatile("" : "+v"(ln_)); int wv_ = wave_s; asm volatile("" : "+s"(wv_));
          F.lane = ln_; F.wave = wv_; F.tid = wv_ * 64 + ln_; }
        int bxl = blockIdx.x, gl_ = gridDim.x; asm volatile("" : "+s"(bxl), "+s"(gl_));
        F.G = gl_; F.vcu = (gl_ % 8 == 0) ? (bxl % 8) * (gl_ / 8) + bxl / 8 : bxl;
        LAS unsigned char* wstg = F.lds + F.wave * 8192;
        cargs_t ap = (cargs_t)__builtin_amdgcn_kernarg_segment_ptr(); asm volatile("" : "+s"(ap));
        F.P.ws = (GAS unsigned char*)ap->ws;
        if (ph == 0) { if (CT(0)) prologue_phase(F, ap); }
        else if (ph == N_PHASES - 1) { if (false) {
            const int gw = F.vcu * 8 + F.wave, NW_ = F.G * 8, lane = F.lane; const GP& P = F.P;
            for (int row = gw; row < T; row += NW_) { const float rs = rsqrtf(rsum16(P.f(OFF_SSX), row) * (1.0f / 1024.0f) + EPS);
#pragma unroll
                for (int j = 0; j < 4; ++j) { const u32x2 xv = *(const GAS u32x2*)(P.b(OFF_XB) + (size_t)row * DM + j * 256 + lane * 4); const f32x4 g = *(const GAS f32x4*)((const gfl*)ap->in[24] + j * 256 + lane * 4);
                    f32x4 v; v[0] = __uint_as_float(xv.x << 16); v[1] = __uint_as_float(xv.x & 0xffff0000u); v[2] = __uint_as_float(xv.y << 16); v[3] = __uint_as_float(xv.y & 0xffff0000u);
                    *(GAS f32x4*)((gfl*)ap->out + (size_t)row * DM + j * 256 + lane * 4) = v * rs * g; } } }
        } else {
            const int l = (ph - 1) / 10, j = (ph - 1) % 10; F.P.l = l; const GP P = F.P;
            if (CT(1) && (j == 0 || j == 3 || j == 5)) {
                { int t_ = F.tid; asm volatile("" : "+v"(t_)); F.tid = t_; F.lane = t_ & 63; }
                DenseSched S{P, j == 0 ? 1 : (j == 3 ? 4 : 6), F.G, bxl}; Epi<false, 0x6Fu> E{P, F.lds};
                g8::gemm_phase<false>(F.lds, DM, S, E, F.tid);
                if (j == 3 && F.G == 256) {
                    g8::Unit u4; S.next(0, u4);
                    asm volatile("s_waitcnt vmcnt(0)" ::: "memory"); __syncthreads();
                    xattn_block(P, u4.q0 >> 8, u4.p0 >> 8, F.lds, F.tid, F.wave, F.lane);
                }
            } else if (CT(3) && j == 2) {
                { int t_ = F.tid; asm volatile("" : "+v"(t_)); F.tid = t_; F.lane = t_ & 63; }
                DenseSched S{P, 3, F.G, bxl}; Epi<true, 0x10u> E{P, F.lds};
                g8::gemm_phase<false>(F.lds, DM, S, E, F.tid);
            } else if (CT(2) && j == 1) {
                { int t_ = F.tid; asm volatile("" : "+v"(t_)); F.tid = t_; F.lane = t_ & 63; }
                const int bh = F.vcu >> 3, sub = F.vcu & 7;
                if (F.G == 256) {
                    const int gu = F.vcu * 8 + F.wave;
                    gmlp_block(P, (const gfl*)ap->in[4], (const gfl*)ap->in[6], F.vcu, F.lds, F.tid, F.wave, F.lane);
                    attn_block(P, bh >> 3, bh & 7, sub, F.lds, F.tid, F.wave, F.lane);
                } else {
                    for (int uu = F.vcu * 8 + F.wave; uu < 4096; uu += F.G * 8) attn_wave_unit(P, uu >> 10, (uu >> 7) & 7, uu & 127, wstg, F.lane);
                    for (int gu = F.vcu * 8 + F.wave; gu < 2048; gu += F.G * 8) gmlp_wave_unit(P, (const gfl*)ap->in[4], (const gfl*)ap->in[6], gu >> 4, (gu >> 2) & 3, gu & 3, wstg, F.lane);
                }
            } else if (CT(5) && j == 4) {
                if (F.G != 256) for (int uu = F.vcu; uu < 256; uu += F.G) xattn_block(P, uu >> 2, uu & 3, F.lds, F.tid, F.wave, F.lane);
            } else if (CT(7) && j == 6) {
                { int t_ = F.tid; asm volatile("" : "+v"(t_)); F.tid = t_; F.lane = t_ & 63; }
                if (F.G == 256) { g8::Unit ur; DenseSched Sr{P, 6, F.G, bxl}; Sr.next(0, ur);
                    router_block_w(P, (const gfl*)ap->in[18], (const gfl*)ap->in[20], (ur.q0 >> 5) + (ur.p0 >> 8) * 2, F.lds, F.tid, F.wave, F.lane); __syncthreads(); }
                else for (int tb = F.vcu * 2; tb < 512; tb += F.G * 2) { router_block(P, (const gfl*)ap->in[18], (const gfl*)ap->in[20], tb, F.lds, F.wave, F.lane); __syncthreads(); }
            } else if (CT(8) && j == 9) {
                { int t_ = F.tid; asm volatile("" : "+v"(t_)); F.tid = t_; F.lane = t_ & 63; }
                const int gw = F.vcu * 8 + F.wave, NW_ = F.G * 8, lane = F.lane;
                for (int row0 = gw; row0 + NW_ < T; row0 += 2 * NW_) {
                    u32x4 xv[2][2], ya[2][2], yb[2][2];
#pragma unroll
                    for (int k = 0; k < 2; ++k) { const int row = row0 + k * NW_; {
#pragma unroll
                        for (int hf = 0; hf < 2; ++hf) { const unsigned cl = hf * 512 + lane * 8, o = (unsigned)row * DM + cl;
                            xv[k][hf] = *(const GAS u32x4*)(P.b(OFF_XB) + o); ya[k][hf] = *(const GAS u32x4*)(P.b(OFF_YM) + (size_t)row * 2 * DM + cl); yb[k][hf] = *(const GAS u32x4*)(P.b(OFF_YM) + (size_t)row * 2 * DM + DM + cl); } } }
#pragma unroll
                    for (int k = 0; k < 2; ++k) { const int row = row0 + k * NW_; {
                        u32x4 w[2]; float sh[2] = {0.f, 0.f};
#pragma unroll
                        for (int hf = 0; hf < 2; ++hf)
#pragma unroll
                            for (int e = 0; e < 4; ++e) { float& s = sh[hf];
                                const float lo = __uint_as_float(xv[k][hf][e] << 16) + __uint_as_float(ya[k][hf][e] << 16) + __uint_as_float(yb[k][hf][e] << 16);
                                const float hi2 = __uint_as_float(xv[k][hf][e] & 0xffff0000u) + __uint_as_float(ya[k][hf][e] & 0xffff0000u) + __uint_as_float(yb[k][hf][e] & 0xffff0000u);
                                const unsigned pw = pk2h(lo, hi2); w[hf][e] = pw;
                                const float rl = __uint_as_float(pw << 16), rh = __uint_as_float(pw & 0xffff0000u); s += rl * rl + rh * rh;
                            }
#pragma unroll
                        for (int hf = 0; hf < 2; ++hf) { float t = sh[hf]; t += sx<1>(t); t += sx<2>(t); t += sx<4>(t); sh[hf] = t; }
                        if (l < NL - 1) {
                            *(GAS u32x4*)(P.b(OFF_XB) + (unsigned)row * DM + lane * 8) = w[0]; *(GAS u32x4*)(P.b(OFF_XB) + (unsigned)row * DM + 512 + lane * 8) = w[1];
                            if ((lane & 7) == 0) { P.f(OFF_SSX)[(size_t)row * 16 + (lane >> 3)] = sh[0]; P.f(OFF_SSX)[(size_t)row * 16 + 8 + (lane >> 3)] = sh[1]; }
                        } else {
                            float s = sh[0] + sh[1]; s += sx<8>(s); s += sx<16>(s); s += sx<32>(s);
                            const float rs = rsqrtf(s * (1.0f / 1024.0f) + EPS);
#pragma unroll
                            for (int q4 = 0; q4 < 4; ++q4) { const int cq = (q4 >> 1) * 512 + lane * 8 + (q4 & 1) * 4; const f32x4 g = *(const GAS f32x4*)((const gfl*)ap->in[24] + cq); const unsigned w0 = w[q4 >> 1][(q4 & 1) * 2], w1 = w[q4 >> 1][(q4 & 1) * 2 + 1];
                                f32x4 v; v[0] = __uint_as_float(w0 << 16); v[1] = __uint_as_float(w0 & 0xffff0000u); v[2] = __uint_as_float(w1 << 16); v[3] = __uint_as_float(w1 & 0xffff0000u);
                                *(GAS f32x4*)((gfl*)ap->out + (size_t)row * DM + cq) = v * rs * g; }
                        } } }
                }
            } else if (CT(8) && j == 7) { { int t_ = F.tid; asm volatile("" : "+v"(t_)); F.tid = t_; F.lane = t_ & 63; }     moe_phase<true>(F, P, 8, false); }
            else if (CT(8) && j == 8) { { int t_ = F.tid; asm volatile("" : "+v"(t_)); F.tid = t_; F.lane = t_ & 63; }     moe_phase<false>(F, P, 9, ph > ap->ph_lo); }
        }
        if (ph >= 1 && ph <= 40 && gridDim.x == 256) {
            const int l_ = (ph - 1) / 10, j_ = (ph - 1) % 10; int bx3 = blockIdx.x; asm volatile("" : "+s"(bx3));
            int mode = 0, nb = 0, lt_ = l_ + 1;
            if (j_ == 0 && bx3 >= 160) { mode = 1; nb = BG_KW / 2; lt_ = l_; }
            else if ((j_ == 7 || j_ == 8) && l_ < NL - 1) { const int nwg_ = ((const LAS int*)(F.lds + L_SEG))[128 + 64] * 4, nmax = (nwg_ + 255) >> 8, nmine = (bx3 < nwg_) ? ((nwg_ - 1 - bx3) >> 8) + 1 : 0;
                if (nmine < nmax) { mode = 2; nb = (j_ == 7) ? BG_K1 / 2 : BG_K2 / 2; } }
            if (mode) {
                int ln2 = (int)__builtin_amdgcn_mbcnt_hi(~0u, __builtin_amdgcn_mbcnt_lo(~0u, 0u)); asm volatile("" : "+v"(ln2));
                int* bgc = (int*)(ap->ws + OFF_CTL) + CW_BGC + lt_;
                __syncthreads();
#pragma unroll 1
                for (;;) {
                    int base = 0;
                    if (mode >= 2) {
                        if (wave_s == 0 && ln2 == 0) { int b_ = (mode == 3) ? __hip_atomic_load(bgc, __ATOMIC_RELAXED, __HIP_MEMORY_SCOPE_AGENT) : 0; if (mode == 2 || b_ < BG_DYN) b_ = atomicAdd(bgc, 16 * nb); MISC[48] = (unsigned)b_; }
                        __syncthreads(); base = (int)MISC[48]; __syncthreads();
                        if (base >= BG_DYN) break; }
#pragma unroll 1
                    for (int b = 0; b < nb; ++b) {
                        int r0, r1;
                        if (mode == 1) { r0 = BG_R0 + (bx3 - 160) * 8 + wave_s + (2 * b) * (96 * 8); r1 = r0 + 96 * 8; }
                        else { const int t = base + 16 * b; if (t >= BG_DYN) break; r0 = BG_R0 + BG_WIN + t + wave_s; r1 = r0 + 8; }
                        const CvtDesc Da = cvt_desc(F.P, ap, lt_, r0), Db = cvt_desc(F.P, ap, lt_, r1);
                        f32x4 va[16], vb[16]; float gaa[16], gab[16]; cvt_load(Da, va, gaa, ln2); cvt_load(Db, vb, gab, ln2);
                        cvt_finish(Da, va, gaa, F.lds + wave_s * 8192, ln2); cvt_finish(Db, vb, gab, F.lds + wave_s * 8192, ln2); }
                    if (mode == 1 && l_ >= 1) { mode = 3; nb = 1; continue; }
                    if (mode != 3) break;
                } }
        }
        if (ph + 1 < a.ph_hi) { const int ln3 = (int)__builtin_amdgcn_mbcnt_hi(~0u, __builtin_amdgcn_mbcnt_lo(~0u, 0u));
            const int jb = (ph >= 1 && ph < N_PHASES - 1) ? (ph - 1) % 10 : -1;
            int bx2 = blockIdx.x, g2_ = gridDim.x; asm volatile("" : "+s"(bx2), "+s"(g2_));
            if (g2_ == 256 && (jb == 2 || jb == 3 || jb == 5)) {
                const int w2_ = xcd_remap(bx2, 256), pm_ = (w2_ / 32) * 8 + (w2_ % 8), st_ = (jb == 2) ? 0 : (jb == 3) ? 1 : 2;
                team_barrier((unsigned*)(ap->ws + OFF_CTL) + CW_TEAM + ((((ph - 1) / 10) * 3 + st_) * 64 + pm_) * 32, wave_s == 0 && ln3 == 0);
            } else xcd_barrier(bar, wave_s == 0 && ln3 == 0); }
#ifdef PROBE_PAD
        if ((a.pad & 1) && ph + 1 < a.ph_hi) xcd_barrier(bar, wave_s == 0 && (int)__builtin_amdgcn_mbcnt_hi(~0u, __builtin_amdgcn_mbcnt_lo(~0u, 0u)) == 0);
        { const int pty_ = (ph == 0) ? 0 : (ph == N_PHASES - 1) ? 11 : 1 + (ph - 1) % 10; if (pty_ + 1 == (a.pad >> 8)) tacc_ += __builtin_amdgcn_s_memrealtime() - tph0_; }
#endif
    }
#ifdef PROBE_PAD
    if ((a.pad >> 8) && blockIdx.x == 0) { const unsigned long long t0_ = __builtin_amdgcn_s_memrealtime(); while (__builtin_amdgcn_s_memrealtime() - t0_ < tacc_) __builtin_amdgcn_s_sleep(8); }
#endif
}

#ifndef FAST_MASK
#define FAST_MASK 0xFFF
#endif
extern "C" void kernel_launch(void* const* d_in, const int* in_sizes, int n_in, void* d_out, int out_size, void* d_ws, size_t ws_size, hipStream_t stream) {
    if (n_in != 25 || ws_size < WS_NEED || out_size != T * DM) { fprintf(stderr, "kernel_launch: unexpected shapes (n_in %d, ws %zu need %zu, out %d)\n", n_in, ws_size, (size_t)WS_NEED, out_size); return; }
    static int grid = 0;
    if (grid == 0) {
        int dev = 0, cus = 0;
        if (hipGetDevice(&dev) != hipSuccess || hipDeviceGetAttribute(&cus, hipDeviceAttributeMultiprocessorCount, dev) != hipSuccess) cus = 0;
        if (hipFuncSetAttribute((const void*)mega, hipFuncAttributeMaxDynamicSharedMemorySize, LDS_BYTES) != hipSuccess) cus = 0;
        (void)hipGetLastError();
        grid = (cus == 256) ? 256 : -1;
        if (grid < 0) fprintf(stderr, "kernel_launch: the persistent kernel needs a 256-CU device (got %d); using the per-stage kernels\n", cus);
    }
    const unsigned fast = (grid > 0) ? (unsigned)FAST_MASK : 0u;
    const float* x = (const float*)d_in[0]; const float* mem = (const float*)d_in[1]; const float* norm_mix = (const float*)d_in[2]; const float* w_in = (const float*)d_in[3];
    const float* v_norm = (const float*)d_in[4]; const float* w_sp = (const float*)d_in[5]; const float* b_sp = (const float*)d_in[6]; const float* on_a = (const float*)d_in[7];
    const float* on_b = (const float*)d_in[8]; const float* w_out = (const float*)d_in[9]; const float* norm_cross = (const float*)d_in[10]; const float* norm_mem = (const float*)d_in[11];
    const float* w_xq = (const float*)d_in[12]; const float* w_xk = (const float*)d_in[13]; const float* w_xv = (const float*)d_in[14]; const float* w_xo = (const float*)d_in[15];
    const float* norm_moe = (const float*)d_in[16]; const float* w_group = (const float*)d_in[17]; const float* b_group = (const float*)d_in[18]; const float* w_router = (const float*)d_in[19];
    const float* b_router = (const float*)d_in[20]; const float* w1 = (const float*)d_in[21]; const float* w3 = (const float*)d_in[22]; const float* w2 = (const float*)d_in[23]; const float* norm_final = (const float*)d_in[24];
    unsigned char* ws = (unsigned char*)d_ws;
    (void)hipMemsetAsync(ws + OFF_CTL, 0, 1 * MiB, stream);
    auto B = [&](size_t off) { return (bf16_t*)(ws + off); };
    Ptrs P; P.ws = ws; P.x_in = x; P.out = (float*)d_out; P.l = 0;
    MArgs a{}; for (int i = 0; i < 25; ++i) a.in[i] = (const float*)d_in[i]; a.out = (float*)d_out; a.ws = ws;
#ifdef PROBE_PAD
    a.pad = PROBE_PAD;
#endif
    int pend_lo = -1, n_mega = 0;
    auto flush = [&](int hi) { if (pend_lo < 0) return; a.ph_lo = pend_lo; a.ph_hi = hi; a.li = n_mega++; hipLaunchKernelGGL(mega, dim3(grid), dim3(NWAVES * 64), LDS_BYTES, stream, a); pend_lo = -1; };
    for (int ph = 0; ph < N_PHASES; ++ph) {
        const int type = (ph == 0) ? 0 : (ph == N_PHASES - 1) ? 11 : 1 + (ph - 1) % 10, l = (ph == 0 || ph == N_PHASES - 1) ? 0 : (ph - 1) / 10;
        if ((fast >> type) & 1u) { if (pend_lo < 0) pend_lo = ph;
#ifdef REPEAT_TYPE
            if (type == REPEAT_TYPE) { flush(ph + 1); pend_lo = ph; }
#endif
            continue; }
        flush(ph);
        P.l = l;
        switch (type) {
        case 0: {
            const int HUGE_G = 1 << 30; const long s_in = (long)DM * INW, d_inw = (long)INW * DM, s_sq = (long)DM * DM;
            k_transpose<<<dim3(16 * 8, 1, NL), 256, 0, stream>>>(w_in + 0, B(OFF_WIN), norm_mix, nullptr, DM, 1.f, DM, 512, INW, 0, s_in, 0, d_inw, DM, HUGE_G, 0, 0);
            k_transpose<<<dim3(16 * 8, 1, NL), 256, 0, stream>>>(w_in + 512, B(OFF_WIN), norm_mix, nullptr, DM, 1.f, DM, 512, INW, 0, s_in, 0, d_inw, DM, HUGE_G, 0, 1536);
            k_transpose<<<dim3(16 * 8, 1, NL), 256, 0, stream>>>(w_in + 1024, B(OFF_WIN), norm_mix, nullptr, DM, QSCALE, DM, 512, INW, 0, s_in, 0, d_inw, DM, HUGE_G, 0, 512);
            k_transpose<<<dim3(16 * 8, 1, NL), 256, 0, stream>>>(w_in + 1536, B(OFF_WIN), norm_mix, nullptr, DM, 1.f, DM, 512, INW, 0, s_in, 0, d_inw, DM, HUGE_G, 0, 1024);
            k_transpose<<<dim3(16 * 8, 1, NL), 256, 0, stream>>>(w_in + 2048, B(OFF_WIN), norm_mix, nullptr, DM, 1.f, DM, 512, INW, 0, s_in, 0, d_inw, DM, HUGE_G, 0, 2048);
            k_transpose<<<dim3(16 * 16, 1, NL), 256, 0, stream>>>(w_out, B(OFF_WOUT), on_a, on_b, 512, 1.f, DM, DM, DM, 0, s_sq, 0, s_sq, 512, HUGE_G, 0, 0);
            k_transpose<<<dim3(16 * 16, 1, NL), 256, 0, stream>>>(w_xq, B(OFF_WXQ), norm_cross, nullptr, DM, XSCALE, DM, DM, DM, 0, s_sq, 0, s_sq, DM, HUGE_G, 0, 0);
            k_transpose<<<dim3(16 * 16, 1, NL), 256, 0, stream>>>(w_xk, B(OFF_WXK), norm_mem, nullptr, DM, 1.f, DM, DM, DM, 0, s_sq, 0, s_sq, DM, HUGE_G, 0, 0);
            k_transpose<<<dim3(16 * 16, 1, NL), 256, 0, stream>>>(w_xv, B(OFF_WXV), norm_mem, nullptr, DM, 1.f, DM, DM, DM, 0, s_sq, 0, s_sq, DM, HUGE_G, 0, 0);
            k_transpose<<<dim3(16 * 16, 1, NL), 256, 0, stream>>>(w_xo, B(OFF_WXO), nullptr, nullptr, DM, 1.f, DM, DM, DM, 0, s_sq, 0, s_sq, DM, HUGE_G, 0, 0);
            k_transpose<<<dim3(16 * 8, NE, NL), 256, 0, stream>>>(w1, B(OFF_W13), norm_moe, nullptr, DM, 1.f, DM, DE, DE, (long)DM * DE, (long)NE * DM * DE, (long)1024 * DM, (long)NE * 1024 * DM, DM, 128, 256, 0);
            k_transpose<<<dim3(16 * 8, NE, NL), 256, 0, stream>>>(w3, B(OFF_W13), norm_moe, nullptr, DM, 1.f, DM, DE, DE, (long)DM * DE, (long)NE * DM * DE, (long)1024 * DM, (long)NE * 1024 * DM, DM, 128, 256, 128);
            k_transpose<<<dim3(8 * 16, NE, NL), 256, 0, stream>>>(w2, B(OFF_W2), nullptr, nullptr, DE, 1.f, DE, DM, DM, (long)DE * DM, (long)NE * DE * DM, (long)DM * DE, (long)NE * DM * DE, DM, HUGE_G, 0, 0);
            k_prep_router<<<NL * 64 * DM / 256, 256, 0, stream>>>(w_router, w_group, norm_moe, B(OFF_WR));
            k_prep_spatial<<<NL * AG * CHUNK * CHUNK / 256, 256, 0, stream>>>(w_sp, B(OFF_WS));
            k_prep_rows<<<T / 4, 256, 0, stream>>>(x, B(OFF_XB), (float*)(ws + OFF_SSX), nullptr, T);
            k_prep_rows<<<MT / 4, 256, 0, stream>>>(mem, B(OFF_MB), nullptr, (float*)(ws + OFF_SSM), MT);
        } break;
        case 1:
            if (l == 0) { k_sgemm<ProbMemK><<<dim3(4 * 16, NL), 256, 0, stream>>>(ProbMemK{P}); k_sgemm<ProbMemVT><<<dim3(4 * 16, NL), 256, 0, stream>>>(ProbMemVT{P}); }
            k_sgemm<ProbIn><<<6 * 256, 256, 0, stream>>>(ProbIn{P}); k_sgemm<ProbInT><<<64 * 16, 256, 0, stream>>>(ProbInT{P}); break;
        case 2: k_attn_naive<<<T * SBH / 256, 256, 0, stream>>>(P); k_gmlp_naive<<<(T / CHUNK) * AG, 256, 0, stream>>>(P, v_norm, b_sp); break;
        case 3: k_sgemm<ProbOut><<<4 * 256, 256, 0, stream>>>(ProbOut{P}); break;
        case 4: k_sgemm<ProbXq><<<4 * 256, 256, 0, stream>>>(ProbXq{P}); break;
        case 5: k_xattn_naive<<<(T / 16) * XH, 256, 0, stream>>>(P); break;
        case 6: k_sgemm<ProbXo><<<4 * 256, 256, 0, stream>>>(ProbXo{P}); break;
        case 7: k_router_naive<<<T / 4, 256, 0, stream>>>(P, b_group, b_router); break;
        case 8: k_sgemm<ProbMoe1><<<4 * (2 * T / 64 + 64), 256, 0, stream>>>(ProbMoe1{P}); break;
        case 9: k_sgemm<ProbMoe2<0>><<<4 * (T / 64 + 32), 256, 0, stream>>>(ProbMoe2<0>{P}); break;
        case 10: k_sgemm<ProbMoe2<1>><<<4 * (T / 64 + 32), 256, 0, stream>>>(ProbMoe2<1>{P}); break;
        default: k_final<<<T / 4, 256, 0, stream>>>(P, norm_final); break;
        }
    }
    flush((fast >> 11) & 1u ? N_PHASES - 1 : N_PHASES);
}
```
